# Optimizing an MI355X kernel written in HIP

```python
import jax, jax.numpy as jnp
from jax import lax
import numpy as np

D_MODEL = 2048
BATCH = 1
SEQ = 16384
DEPTH = 1

LRU_WIDTH = D_MODEL
LRU_BLOCKS = 16
LRU_BLOCK_DIM = LRU_WIDTH // LRU_BLOCKS
LRU_C = 8.0
CONV_WIDTH = 4
CONV_LEFT = 2
N_HEADS = 16
N_KV_HEADS = 4
HEAD_DIM = 128
GROUP = N_HEADS // N_KV_HEADS
ATTN_WIDTH = N_HEADS * HEAD_DIM
KV_WIDTH = N_KV_HEADS * HEAD_DIM
WINDOW = 128
BLOCK = 128
ROPE_THETA = 500000.0
ROT_DIM = HEAD_DIM // 4
NORM_EPS = 1e-6
IN_SPLITS = (LRU_WIDTH, LRU_WIDTH, ATTN_WIDTH, KV_WIDTH, KV_WIDTH, ATTN_WIDTH, D_MODEL, D_MODEL)
IN_WIDTH = sum(IN_SPLITS)

kernel_name = 'hybrid_rglru_swa_gqa_encoder_block'


def rms_norm(x, w):
    xf = x.astype(jnp.float32)
    y = xf * lax.rsqrt(jnp.mean(xf * xf, axis=-1, keepdims=True) + NORM_EPS)
    return (y * w.astype(jnp.float32)).astype(x.dtype)


def centred_depthwise_conv(u, w, b):
    s = u.shape[1]
    up = jnp.pad(u, ((0, 0), (CONV_LEFT, CONV_WIDTH - 1 - CONV_LEFT), (0, 0)))
    y = b
    for tap in range(CONV_WIDTH):
        y = y + up[:, tap:tap + s] * w[tap]
    return y


def _linear_combine(e1, e2):
    a1, b1 = e1
    a2, b2 = e2
    return a1 * a2, a2 * b1 + b2


def rg_lru(u, w_r, b_r, w_i, b_i, lam, reverse):
    bsz, s, _ = u.shape
    ub = u.reshape(bsz, s, LRU_BLOCKS, LRU_BLOCK_DIM)
    gate_r = jax.nn.sigmoid(jnp.einsum('bsni,nij->bsnj', ub, w_r).reshape(bsz, s, LRU_WIDTH) + b_r)
    gate_i = jax.nn.sigmoid(jnp.einsum('bsni,nij->bsnj', ub, w_i).reshape(bsz, s, LRU_WIDTH) + b_i)
    log_a = -LRU_C * gate_r.astype(jnp.float32) * jax.nn.softplus(-lam.astype(jnp.float32))
    a = jnp.exp(log_a)
    in_scale = jnp.sqrt(-jnp.expm1(2.0 * log_a))
    b = in_scale * (gate_i * u).astype(jnp.float32)
    _, h = lax.associative_scan(_linear_combine, (a, b), axis=1, reverse=reverse)
    return h


def partial_rope(t, cos, sin):
    half = ROT_DIM // 2
    tf = t[..., :ROT_DIM].astype(jnp.float32)
    t1, t2 = tf[..., :half], tf[..., half:]
    c = cos[None, :, None, :]
    sn = sin[None, :, None, :]
    rot = jnp.concatenate([t1 * c - t2 * sn, t2 * c + t1 * sn], axis=-1).astype(t.dtype)
    return jnp.concatenate([rot, t[..., ROT_DIM:]], axis=-1)


def windowed_gqa(q, k, v, sink):
    bsz, s = q.shape[:2]
    nb = s // BLOCK
    qb = q.reshape(bsz, nb, BLOCK, N_KV_HEADS, GROUP, HEAD_DIM)

    def band(t):
        tp = jnp.pad(t, ((0, 0), (BLOCK, BLOCK), (0, 0), (0, 0)))
        tp = tp.reshape(bsz, nb + 2, BLOCK, N_KV_HEADS, HEAD_DIM)
        return jnp.concatenate([tp[:, :-2], tp[:, 1:-1], tp[:, 2:]], axis=2)

    kw, vw = band(k), band(v)
    scores = jnp.einsum('bnqkgd,bnskd->bnkgqs', qb, kw).astype(jnp.float32) * (HEAD_DIM ** -0.5)
    q_idx = jnp.arange(BLOCK)[:, None]
    s_idx = jnp.arange(3 * BLOCK)[None, :]
    band_ok = jnp.abs(s_idx - BLOCK - q_idx) <= WINDOW
    key_pos = (jnp.arange(nb)[:, None] - 1) * BLOCK + jnp.arange(3 * BLOCK)[None, :]
    in_range = (key_pos >= 0) & (key_pos < s)
    mask = band_ok[None] & in_range[:, None, :]
    scores = jnp.where(mask[None, :, None, None], scores, -1e30)
    sink_l = sink.astype(jnp.float32).reshape(1, 1, N_KV_HEADS, GROUP, 1, 1)
    m = jnp.maximum(scores.max(axis=-1, keepdims=True), sink_l)
    e = jnp.exp(scores - m)
    p = e / (e.sum(axis=-1, keepdims=True) + jnp.exp(sink_l - m))
    out = jnp.einsum('bnkgqs,bnskd->bnqkgd', p.astype(v.dtype), vw)
    return out.reshape(bsz, s, ATTN_WIDTH)


def setup_inputs(seed: int = 0) -> dict:
    key = jax.random.key(seed)
    ks = jax.random.split(key, 16)

    def nrm(k, shape, fan_in):
        return jax.random.normal(k, shape, jnp.float32) * (fan_in ** -0.5)

    L = DEPTH
    x = jax.random.normal(ks[0], (BATCH, SEQ, D_MODEL), jnp.float32)
    norm_pre_w = 1.0 + 0.02 * jax.random.normal(ks[1], (L, D_MODEL), jnp.float32)
    w_in = nrm(ks[2], (L, D_MODEL, IN_WIDTH), D_MODEL)
    conv_w = nrm(ks[3], (L, CONV_WIDTH, LRU_WIDTH), CONV_WIDTH)
    conv_b = 0.01 * jax.random.normal(ks[4], (L, LRU_WIDTH), jnp.float32)
    lru_w_r = nrm(ks[5], (L, 2, LRU_BLOCKS, LRU_BLOCK_DIM, LRU_BLOCK_DIM), LRU_BLOCK_DIM)
    lru_b_r = 0.01 * jax.random.normal(ks[6], (L, 2, LRU_WIDTH), jnp.float32)
    lru_w_i = nrm(ks[7], (L, 2, LRU_BLOCKS, LRU_BLOCK_DIM, LRU_BLOCK_DIM), LRU_BLOCK_DIM)
    lru_b_i = 0.01 * jax.random.normal(ks[8], (L, 2, LRU_WIDTH), jnp.float32)
    a_c = jax.random.uniform(ks[9], (L, 2, LRU_WIDTH), jnp.float32, minval=0.9, maxval=0.999)
    sig = a_c ** (1.0 / LRU_C)
    lru_lambda = jnp.log(sig) - jnp.log1p(-sig)
    attn_sink = jax.random.normal(ks[10], (L, N_HEADS), jnp.float32)
    w_proj_a = nrm(ks[11], (L, LRU_WIDTH, D_MODEL), LRU_WIDTH)
    w_proj_b = nrm(ks[12], (L, ATTN_WIDTH, D_MODEL), ATTN_WIDTH)
    w_out = nrm(ks[13], (L, D_MODEL, D_MODEL), D_MODEL)
    norm_post_w = 1.0 + 0.02 * jax.random.normal(ks[14], (L, D_MODEL), jnp.float32)
    return {'x': x, 'norm_pre_w': norm_pre_w, 'w_in': w_in, 'conv_w': conv_w, 'conv_b': conv_b,
            'lru_w_r': lru_w_r, 'lru_b_r': lru_b_r, 'lru_w_i': lru_w_i, 'lru_b_i': lru_b_i,
            'lru_lambda': lru_lambda, 'attn_sink': attn_sink, 'w_proj_a': w_proj_a,
            'w_proj_b': w_proj_b, 'w_out': w_out, 'norm_post_w': norm_post_w}


def reference(x, norm_pre_w, w_in, conv_w, conv_b, lru_w_r, lru_b_r, lru_w_i, lru_b_i,
              lru_lambda, attn_sink, w_proj_a, w_proj_b, w_out, norm_post_w):
    bsz, s, _ = x.shape
    pos = jnp.arange(s, dtype=jnp.float32)
    inv_freq = ROPE_THETA ** (-jnp.arange(0, ROT_DIM, 2, dtype=jnp.float32) / ROT_DIM)
    ang = pos[:, None] * inv_freq[None, :]
    cos, sin = jnp.cos(ang), jnp.sin(ang)
    split_at = np.cumsum(IN_SPLITS)[:-1].tolist()
    for l in range(DEPTH):
        xn = rms_norm(x, norm_pre_w[l])
        z = xn @ w_in[l]
        u_lru, g_lru, q, k, v, g_attn, m_lru, m_attn = jnp.split(z, split_at, axis=-1)
        u = centred_depthwise_conv(u_lru, conv_w[l], conv_b[l])
        h = (rg_lru(u, lru_w_r[l, 0], lru_b_r[l, 0], lru_w_i[l, 0], lru_b_i[l, 0], lru_lambda[l, 0], False)
             + rg_lru(u, lru_w_r[l, 1], lru_b_r[l, 1], lru_w_i[l, 1], lru_b_i[l, 1], lru_lambda[l, 1], True))
        y_a = h.astype(x.dtype) * jax.nn.silu(g_lru)
        q = partial_rope(q.reshape(bsz, s, N_HEADS, HEAD_DIM), cos, sin)
        k = partial_rope(k.reshape(bsz, s, N_KV_HEADS, HEAD_DIM), cos, sin)
        v = v.reshape(bsz, s, N_KV_HEADS, HEAD_DIM)
        y_b = windowed_gqa(q, k, v, attn_sink[l]) * jax.nn.silu(g_attn)
        merged = (jax.nn.sigmoid(m_lru) * (y_a @ w_proj_a[l])
                  + jax.nn.sigmoid(m_attn) * (y_b @ w_proj_b[l]))
        x = x + rms_norm(merged @ w_out[l], norm_post_w[l])
    return x
```

```cpp
#include <hip/hip_runtime.h>
#include <hip/hip_cooperative_groups.h>
#include <cstdio>
#include <cstdint>
#include <cmath>
namespace cg = cooperative_groups;

#ifndef MK_SINGLE
#define MK_SINGLE 1
#endif

#define LAS __attribute__((address_space(3)))
#define DI __device__ __forceinline__
typedef unsigned short bf16_t;
typedef short bf16x8 __attribute__((ext_vector_type(8)));
typedef short s16x4 __attribute__((ext_vector_type(4)));
typedef float f32x2 __attribute__((ext_vector_type(2)));
typedef float f32x4 __attribute__((ext_vector_type(4)));
typedef float f32x16 __attribute__((ext_vector_type(16)));
typedef unsigned u32x2 __attribute__((ext_vector_type(2)));
typedef unsigned u32x4 __attribute__((ext_vector_type(4)));

constexpr int S = 16384, DM = 2048, NIN = 13312;
constexpr float EPS = 1e-6f;
constexpr float LOG2E = 1.4426950408889634f;
constexpr size_t MiB = (size_t)1 << 20;
constexpr size_t WS_ZU = 0, WS_MERGED = 0;
constexpr size_t WS_ZG = 64 * MiB;
constexpr size_t WS_ZQKV = 128 * MiB;
constexpr size_t WS_ZGA = 224 * MiB;
constexpr size_t WS_ZM = 288 * MiB, WS_OUT2 = 288 * MiB;
constexpr size_t WS_WAT = 416 * MiB, WS_WBT = 424 * MiB, WS_WOT = 432 * MiB;
constexpr size_t WS_ROPE = 440 * MiB;
constexpr size_t WS_AGG = 442 * MiB;
constexpr size_t WS_SSQ = 446 * MiB;
constexpr size_t WS_LWT = 448 * MiB;
constexpr size_t WS_CAR = 450 * MiB;
constexpr size_t WS_BAR = 452 * MiB;
constexpr size_t WS_END = 453 * MiB;
constexpr size_t DO_XN = 0, DO_WINT = 64 * MiB;
constexpr size_t DO_ACF = 0, DO_ACB = 64 * MiB;
#ifndef PROBE_SPLIT
#define PROBE_SPLIT 0
#endif
constexpr size_t WS_YB = PROBE_SPLIT ? WS_ZU : WS_ZGA;
constexpr size_t WS_MRG = PROBE_SPLIT ? WS_ZQKV : WS_MERGED;
constexpr int LDS_BAR_ST = 137216;
constexpr int LDS_BYTES = 137232;

struct Params {
    const float* in[15];
    float* out; unsigned char* ws;
    float inv_freq[16];
    int ph_lo, ph_hi, mix_mask, pad_;
};

DI unsigned cvtpk(float lo, float hi) { unsigned r; asm volatile("v_cvt_pk_bf16_f32 %0, %1, %2" : "=v"(r) : "v"(lo), "v"(hi)); return r; }
DI float bf2f(unsigned short b) { return __uint_as_float(((unsigned)b) << 16); }
DI float bflo(unsigned w) { return __uint_as_float(w << 16); }
DI float bfhi(unsigned w) { return __uint_as_float(w & 0xffff0000u); }
DI unsigned short f2bf(float f) { return (unsigned short)(cvtpk(f, f) & 0xffffu); }
DI float ex2(float x) { return __builtin_amdgcn_exp2f(x); }
DI float rcpf_(float x) { return __builtin_amdgcn_rcpf(x); }
DI float sigm(float x) { return rcpf_(1.f + ex2(-x * LOG2E)); }
DI float wave_sum(float v) {
#pragma unroll
    for (int o = 32; o >= 1; o >>= 1) v += __shfl_xor(v, o);
    return v;
}

namespace pg8 {
constexpr int BM = 256, BK = 64, HALF = 128, HTB = HALF * BK * 2, STAGE_BYTES = 8 * HTB, NXCD = 8, WGM = 8;
DI int lds_byte(int r, int c) { const int st = (r >> 4) * 2 + (c >> 5), rr = r & 15, cc = c & 31, ob = rr * 64 + cc * 2; return st * 1024 + (ob ^ (((ob >> 9) & 1) << 5)); }
DI void stage_rc(int b, int& R, int& C) { const int st = b / 1024, sb = b % 1024, swz = sb ^ (((sb >> 9) & 1) << 5); R = (st >> 1) * 16 + swz / 64; C = (st & 1) * 32 + (swz % 64) / 2; }
DI int perm32(int rho) { const int n = rho >> 4, i = rho & 15; return 8 * (i >> 2) + 4 * n + (i & 3); }
struct Unit { int pm, pn; };
struct Gemm { const bf16_t* A0; const bf16_t* A1; const bf16_t* B0; const bf16_t* B1; int lda, ldb, M, N, K, ksplit; };
struct StaticOrder {
    int nM, nN, nwg, G, c;
    DI void init(int M, int N, int G_, int c_) { nM = M / BM; nN = N / BM; nwg = nM * nN; G = G_; c = c_; }
    DI bool next(int i, Unit& u) const {
        const long L = (long)i * G + c; if (L >= nwg) return false;
        int wgid = (int)L; { const int q = nwg / NXCD, r = nwg % NXCD, xcd = wgid % NXCD, off = wgid / NXCD; wgid = (xcd < r ? xcd * (q + 1) : r * (q + 1) + (xcd - r) * q) + off; }
        const int nig = WGM * nN, gid = wgid / nig, fm = gid * WGM, gsz = (nM - fm) < WGM ? (nM - fm) : WGM;
        u.pm = fm + ((wgid % nig) % gsz); u.pn = (wgid % nig) / gsz; return true;
    }
};

template <class Epi>
DI void gemm_phase(LAS unsigned char* lds, const Gemm g, const StaticOrder& S_, const Epi& E) {
    const int tid = threadIdx.x, wid = __builtin_amdgcn_readfirstlane(tid >> 6), lane = tid & 63, wr = wid >> 2, wc = wid & 3, fr = lane & 15, fq = lane >> 4;
    const int K = g.K, nt = K / BK, ksplit = g.ksplit;
    unsigned voffA[2], voffB[2];
#pragma unroll
    for (int i = 0; i < 2; ++i) { int R, C; stage_rc(tid * 16 + i * 8192, R, C); const int Rb = Epi::PERM ? ((R & ~31) + perm32(R & 31)) : R;
        voffA[i] = (unsigned)(R * g.lda + C) * 2u; voffB[i] = (unsigned)(Rb * g.ldb + C) * 2u; }
    const size_t kstep = (size_t)(BK * 2);
    const size_t hstepA = (size_t)HALF * g.lda * 2, hstepB = (size_t)HALF * g.ldb * 2;
    const size_t tstepA = 2 * hstepA, tstepB = 2 * hstepB;
    const unsigned ldsw = (unsigned)wid * 1024u;
    const int aoff = lds_byte(wr * 64 + fr, fq * 8), boff = lds_byte(wc * 32 + fr, fq * 8);
#define PG8_SA(b, h) (((b) * 2 + (h)) * HTB)
#define PG8_SB(b, h) ((4 + (b) * 2 + (h)) * HTB)
#define PG8_STAGE(bufoff, gbase, voff) do { _Pragma("unroll") for (int _i = 0; _i < 2; ++_i) \
        __builtin_amdgcn_global_load_lds((const unsigned*)((const char*)(gbase) + (voff)[_i]), (LAS unsigned*)(lds + (bufoff) + ldsw + _i * 8192), 16, 0, 0); } while (0)
#define PG8_LDA(dst, b, h) do { _Pragma("unroll") for (int m = 0; m < 4; ++m) _Pragma("unroll") for (int k = 0; k < 2; ++k) dst[m][k] = *(const LAS bf16x8*)(lds + PG8_SA(b, h) + aoff + m * 2048 + k * 1024); } while (0)
#define PG8_LDB(dst, b, h) do { _Pragma("unroll") for (int n = 0; n < 2; ++n) _Pragma("unroll") for (int k = 0; k < 2; ++k) dst[n][k] = *(const LAS bf16x8*)(lds + PG8_SB(b, h) + boff + n * 2048 + k * 1024); } while (0)
#define PG8_MMA(ai, bj, At, Bt) do { __builtin_amdgcn_s_setprio(1); _Pragma("unroll") for (int m = 0; m < 4; ++m) _Pragma("unroll") for (int n = 0; n < 2; ++n) _Pragma("unroll") for (int k = 0; k < 2; ++k) \
        acc[ai][bj][m][n] = __builtin_amdgcn_mfma_f32_16x16x32_bf16(Bt[n][k], At[m][k], acc[ai][bj][m][n], 0, 0, 0); __builtin_amdgcn_s_setprio(0); } while (0)
#define PG8_WAIT_V(n) asm volatile("s_waitcnt vmcnt(" #n ")" ::: "memory")
#define PG8_WAIT_L(n) asm volatile("s_waitcnt lgkmcnt(" #n ")" ::: "memory")
#define PG8_BAR __builtin_amdgcn_s_barrier()
#define PG8_SCHED __builtin_amdgcn_sched_barrier(0)
    Unit cur, nxt; int ui = 0;
    if (!S_.next(0, cur)) return;
    f32x4 acc[2][2][4][2];
#pragma unroll
    for (int a = 0; a < 2; ++a)
#pragma unroll
        for (int b = 0; b < 2; ++b)
#pragma unroll
            for (int m = 0; m < 4; ++m)
#pragma unroll
                for (int n = 0; n < 2; ++n) acc[a][b][m][n] = (f32x4){0.f, 0.f, 0.f, 0.f};
    bf16x8 At[4][2], B0[2][2], B1[2][2];
    const char* cA0 = (const char*)g.A0 + (size_t)cur.pm * tstepA; const char* cA1 = (const char*)g.A1 + (size_t)cur.pm * tstepA;
    const char* cB0 = (const char*)g.B0 + (size_t)cur.pn * tstepB; const char* cB1 = (const char*)g.B1 + (size_t)cur.pn * tstepB;
    PG8_STAGE(PG8_SB(0, 0), cB0, voffB); PG8_STAGE(PG8_SA(0, 0), cA0, voffA); PG8_STAGE(PG8_SB(0, 1), cB0 + hstepB, voffB); PG8_STAGE(PG8_SA(0, 1), cA0 + hstepA, voffA);
    if (wr == 1) PG8_BAR;
    PG8_WAIT_V(4); PG8_BAR;
    PG8_STAGE(PG8_SB(1, 0), cB0 + kstep, voffB); PG8_STAGE(PG8_SA(1, 0), cA0 + kstep, voffA); PG8_STAGE(PG8_SB(1, 1), cB0 + hstepB + kstep, voffB);
    PG8_WAIT_V(6); PG8_BAR;
    for (;;) {
        const bool has_next = S_.next(ui + 1, nxt);
        const char* nA0 = has_next ? (const char*)g.A0 + (size_t)nxt.pm * tstepA : cA0; const char* nB0 = has_next ? (const char*)g.B0 + (size_t)nxt.pn * tstepB : cB0;
        for (int hf = 0; hf < (Epi::MID ? 2 : 1); ++hf) {
        const int tb = Epi::MID ? hf * ksplit : 0, te = Epi::MID ? (hf + 1) * ksplit : nt;
        for (int t = tb; t < te; t += 2) {
            const bool last = (t == nt - 2);
            const bool hA = (t >= ksplit), hB = (t + 2 >= ksplit);
            const char* a1 = (hA ? cA1 : cA0) + (size_t)(t + 1) * kstep;
            const char* a2 = last ? nA0 : (hB ? cA1 : cA0) + (size_t)(t + 2) * kstep; const char* b2 = last ? nB0 : (hB ? cB1 : cB0) + (size_t)(t + 2) * kstep;
            const char* a3 = a2 + kstep; const char* b3 = b2 + kstep;
            PG8_LDB(B0, 0, 0); PG8_SCHED; PG8_LDA(At, 0, 0); PG8_STAGE(PG8_SA(1, 1), a1 + hstepA, voffA);
            PG8_WAIT_L(8); PG8_BAR; PG8_WAIT_L(0); PG8_MMA(0, 0, At, B0); PG8_BAR; PG8_SCHED;
            PG8_LDB(B1, 0, 1); PG8_STAGE(PG8_SB(0, 0), b2, voffB);
            PG8_BAR; PG8_WAIT_L(0); PG8_MMA(0, 1, At, B1); PG8_BAR;
            PG8_LDA(At, 0, 1); PG8_STAGE(PG8_SA(0, 0), a2, voffA);
            PG8_BAR; PG8_WAIT_L(0); PG8_MMA(1, 0, At, B0); PG8_BAR; PG8_SCHED;
            PG8_STAGE(PG8_SB(0, 1), b2 + hstepB, voffB);
            PG8_WAIT_V(6); PG8_BAR; PG8_MMA(1, 1, At, B1); PG8_BAR;
            PG8_LDB(B0, 1, 0); PG8_SCHED; PG8_LDA(At, 1, 0); PG8_STAGE(PG8_SA(0, 1), a2 + hstepA, voffA);
            PG8_WAIT_L(8); PG8_BAR; PG8_WAIT_L(0); PG8_MMA(0, 0, At, B0); PG8_BAR; PG8_SCHED;
            PG8_LDB(B1, 1, 1); PG8_STAGE(PG8_SB(1, 0), b3, voffB);
            PG8_BAR; PG8_WAIT_L(0); PG8_MMA(0, 1, At, B1); PG8_BAR;
            PG8_LDA(At, 1, 1); PG8_STAGE(PG8_SA(1, 0), a3, voffA);
            PG8_BAR; PG8_WAIT_L(0); PG8_MMA(1, 0, At, B0); PG8_BAR; PG8_SCHED;
            PG8_STAGE(PG8_SB(1, 1), b3 + hstepB, voffB);
            PG8_WAIT_V(6); PG8_BAR; PG8_MMA(1, 1, At, B1); PG8_BAR;
        }
        if constexpr (Epi::MID) { if (hf == 0) E.mid(acc, cur, wr, wc, fr, fq); }
        }
        E(acc, cur, wr, wc, fr, fq);
        if (!has_next) break;
#pragma unroll
        for (int a = 0; a < 2; ++a)
#pragma unroll
            for (int b = 0; b < 2; ++b)
#pragma unroll
                for (int m = 0; m < 4; ++m)
#pragma unroll
                    for (int n = 0; n < 2; ++n) acc[a][b][m][n] = (f32x4){0.f, 0.f, 0.f, 0.f};
        cur = nxt; ++ui;
        cA0 = (const char*)g.A0 + (size_t)cur.pm * tstepA; cA1 = (const char*)g.A1 + (size_t)cur.pm * tstepA;
        cB0 = (const char*)g.B0 + (size_t)cur.pn * tstepB; cB1 = (const char*)g.B1 + (size_t)cur.pn * tstepB;
    }
    PG8_WAIT_V(0);
    if (wr == 0) PG8_BAR;
    PG8_BAR;
#undef PG8_SA
#undef PG8_SB
#undef PG8_STAGE
#undef PG8_LDA
#undef PG8_LDB
#undef PG8_MMA
#undef PG8_WAIT_V
#undef PG8_WAIT_L
#undef PG8_BAR
#undef PG8_SCHED
}
}

struct EpiZ {
    static constexpr bool PERM = true, MID = false;
    unsigned char* ws;
    DI void operator()(const f32x4 (&acc)[2][2][4][2], const pg8::Unit& u, int wr, int wc, int fr, int fq) const {
        const int pn = u.pn; bf16_t* base; int ld, colt;
        if (pn < 8) { base = (bf16_t*)(ws + WS_ZU) + (size_t)pn * S * 256; ld = 256; colt = 0; }
        else if (pn < 16) { base = (bf16_t*)(ws + WS_ZG); ld = 2048; colt = (pn - 8) * 256; }
        else if (pn < 28) { base = (bf16_t*)(ws + WS_ZQKV); ld = 3072; colt = (pn - 16) * 256; }
        else if (pn < 36) { base = (bf16_t*)(ws + WS_ZGA); ld = 2048; colt = (pn - 28) * 256; }
        else { base = (bf16_t*)(ws + WS_ZM) + (size_t)(pn - 36) * S * 256; ld = 256; colt = 0; }
        const bool rope = (pn >= 16 && pn < 26 && wc == 0);
        const int row0 = u.pm * 256 + wr * 64 + fr, col0 = colt + wc * 32 + 8 * fq;
        if (rope) {
            const float* cosT = (const float*)(ws + WS_ROPE) + (size_t)row0 * 16 + 4 * fq; const float* sinT = cosT + (size_t)S * 16;
            f32x4 cs[8], sn[8];
#pragma unroll
            for (int k = 0; k < 8; ++k) { cs[k] = *(const f32x4*)(cosT + ((k >> 2) * 128 + (k & 3) * 16) * 16); sn[k] = *(const f32x4*)(sinT + ((k >> 2) * 128 + (k & 3) * 16) * 16); }
#pragma unroll
            for (int ai = 0; ai < 2; ++ai)
#pragma unroll
                for (int m = 0; m < 4; ++m) {
                    const int row = row0 + ai * 128 + m * 16; const f32x4 c4 = cs[ai * 4 + m], s4 = sn[ai * 4 + m];
#pragma unroll
                    for (int bj = 0; bj < 2; ++bj) {
                        const f32x4 v0 = acc[ai][bj][m][0], v1 = acc[ai][bj][m][1]; f32x4 w0, w1;
                        w0[0] = v0[0] * c4[0] - v0[1] * s4[0]; w0[1] = v0[1] * c4[0] + v0[0] * s4[0];
                        w0[2] = v0[2] * c4[1] - v0[3] * s4[1]; w0[3] = v0[3] * c4[1] + v0[2] * s4[1];
                        w1[0] = v1[0] * c4[2] - v1[1] * s4[2]; w1[1] = v1[1] * c4[2] + v1[0] * s4[2];
                        w1[2] = v1[2] * c4[3] - v1[3] * s4[3]; w1[3] = v1[3] * c4[3] + v1[2] * s4[3];
                        u32x4 w = {cvtpk(w0[0], w0[1]), cvtpk(w0[2], w0[3]), cvtpk(w1[0], w1[1]), cvtpk(w1[2], w1[3])};
                        __builtin_nontemporal_store(w, (u32x4*)(base + (size_t)row * ld + col0 + bj * 128));
                    }
                }
        } else {
#pragma unroll
            for (int ai = 0; ai < 2; ++ai)
#pragma unroll
                for (int m = 0; m < 4; ++m) {
                    const int row = row0 + ai * 128 + m * 16;
#pragma unroll
                    for (int bj = 0; bj < 2; ++bj) {
                        const f32x4 v0 = acc[ai][bj][m][0], v1 = acc[ai][bj][m][1];
                        u32x4 w = {cvtpk(v0[0], v0[1]), cvtpk(v0[2], v0[3]), cvtpk(v1[0], v1[1]), cvtpk(v1[2], v1[3])};
                        __builtin_nontemporal_store(w, (u32x4*)(base + (size_t)row * ld + col0 + bj * 128));
                    }
                }
        }
    }
};
DI u32x4 ldg128(const void* base, unsigned boff) { return *(const u32x4*)((const char*)base + boff); }
DI void stg128(void* base, unsigned boff, u32x4 v) { *(u32x4*)((char*)base + boff) = v; }
template <int STEP> struct EpiMerge {
    static constexpr bool PERM = true, MID = false;
    unsigned char* ws; unsigned char* tbuf;
    DI void operator()(const f32x4 (&acc)[2][2][4][2], const pg8::Unit& u, int wr, int wc, int fr, int fq) const {
        const unsigned char* zm = ws + WS_ZM; unsigned char* mg = ws + WS_MRG;
        const unsigned r0_ = (unsigned)(u.pm * 256 + wr * 64 + fr), c0_ = (unsigned)(u.pn * 256 + wc * 32 + 8 * fq);
#pragma unroll
        for (int ai = 0; ai < 2; ++ai)
#pragma unroll
            for (int m = 0; m < 4; ++m) {
                const unsigned row = r0_ + ai * 128 + m * 16;
#pragma unroll
                for (int bj = 0; bj < 2; ++bj) {
                    const unsigned col = c0_ + bj * 128;
                    const u32x4 g = ldg128(zm, row * 8192u + (STEP ? 4096u : 0u) + col * 2u);
                    float v[8];
#pragma unroll
                    for (int i = 0; i < 4; ++i) {
                        v[2 * i] = acc[ai][bj][m][i >> 1][(i & 1) * 2] * sigm(bflo(g[i]));
                        v[2 * i + 1] = acc[ai][bj][m][i >> 1][(i & 1) * 2 + 1] * sigm(bfhi(g[i]));
                    }
                    const unsigned tb = row * 8192u + col * 4u;
                    if (STEP == 0) {
                        stg128(tbuf, tb, __builtin_bit_cast(u32x4, (f32x4){v[0], v[1], v[2], v[3]}));
                        stg128(tbuf, tb + 16u, __builtin_bit_cast(u32x4, (f32x4){v[4], v[5], v[6], v[7]}));
                    } else {
                        const f32x4 t0 = __builtin_bit_cast(f32x4, ldg128(tbuf, tb)), t1 = __builtin_bit_cast(f32x4, ldg128(tbuf, tb + 16u));
                        u32x4 w = {cvtpk(v[0] + t0[0], v[1] + t0[1]), cvtpk(v[2] + t0[2], v[3] + t0[3]), cvtpk(v[4] + t1[0], v[5] + t1[1]), cvtpk(v[6] + t1[2], v[7] + t1[3])};
                        stg128(mg, row * 4096u + col * 2u, w);
                    }
                }
                asm volatile("" ::: "memory");
            }
    }
};

struct EpiMergeMid {
    static constexpr bool PERM = true, MID = true;
    unsigned char* ws;
    DI void mid(f32x4 (&acc)[2][2][4][2], const pg8::Unit& u, int wr, int wc, int fr, int fq) const {
        const unsigned char* zm = ws + WS_ZM;
        unsigned b0_ = (unsigned)u.pn * (unsigned)(S * 512) + (unsigned)(u.pm * 256 + wr * 64 + fr) * 512u + (unsigned)(wc * 32 + 8 * fq) * 2u;
        asm volatile("" : "+v"(b0_));
#pragma unroll
        for (int ai = 0; ai < 2; ++ai) {
            u32x4 g1[4][2], g2[4][2];
#pragma unroll
            for (int m = 0; m < 4; ++m)
#pragma unroll
                for (int bj = 0; bj < 2; ++bj) { const unsigned bo = b0_ + (unsigned)(ai * 128 + m * 16) * 512u + bj * 256u; g1[m][bj] = ldg128(zm, bo); g2[m][bj] = ldg128(zm, bo + (unsigned)(8 * S * 512)); }
#pragma unroll
            for (int m = 0; m < 4; ++m)
#pragma unroll
                for (int bj = 0; bj < 2; ++bj)
#pragma unroll
                    for (int i = 0; i < 4; ++i) {
                        const float a0 = bflo(g1[m][bj][i]), a1 = bfhi(g1[m][bj][i]), c0 = bflo(g2[m][bj][i]), c1 = bfhi(g2[m][bj][i]);
                        const float r0 = (1.f + ex2(-c0 * LOG2E)) * rcpf_(1.f + ex2(-a0 * LOG2E));
                        const float r1 = (1.f + ex2(-c1 * LOG2E)) * rcpf_(1.f + ex2(-a1 * LOG2E));
                        acc[ai][bj][m][i >> 1][(i & 1) * 2] *= r0; acc[ai][bj][m][i >> 1][(i & 1) * 2 + 1] *= r1;
                    }
            asm volatile("" ::: "memory"); __builtin_amdgcn_sched_barrier(0);
        }
    }
    DI void operator()(const f32x4 (&acc)[2][2][4][2], const pg8::Unit& u, int wr, int wc, int fr, int fq) const {
        const unsigned char* zm = ws + WS_ZM; unsigned char* mg = ws + WS_MRG;
        unsigned r0_ = (unsigned)(u.pm * 256 + wr * 64 + fr), c0_ = (unsigned)(u.pn * 256 + wc * 32 + 8 * fq) * 2u;
        asm volatile("" : "+v"(r0_), "+v"(c0_));
        u32x4 g2[2][4][2];
#pragma unroll
        for (int ai = 0; ai < 2; ++ai)
#pragma unroll
            for (int m = 0; m < 4; ++m)
#pragma unroll
                for (int bj = 0; bj < 2; ++bj) g2[ai][m][bj] = ldg128(zm, (unsigned)(8 + u.pn) * (unsigned)(S * 512) + (r0_ + ai * 128 + m * 16) * 512u + (c0_ - (unsigned)u.pn * 512u) + bj * 256u);
#pragma unroll
        for (int ai = 0; ai < 2; ++ai)
#pragma unroll
            for (int m = 0; m < 4; ++m) {
                const unsigned row = r0_ + ai * 128 + m * 16;
#pragma unroll
                for (int bj = 0; bj < 2; ++bj) {
                    float v[8];
#pragma unroll
                    for (int i = 0; i < 4; ++i) {
                        v[2 * i] = acc[ai][bj][m][i >> 1][(i & 1) * 2] * sigm(bflo(g2[ai][m][bj][i]));
                        v[2 * i + 1] = acc[ai][bj][m][i >> 1][(i & 1) * 2 + 1] * sigm(bfhi(g2[ai][m][bj][i]));
                    }
                    u32x4 w = {cvtpk(v[0], v[1]), cvtpk(v[2], v[3]), cvtpk(v[4], v[5]), cvtpk(v[6], v[7])};
                    stg128(mg, row * 4096u + c0_ + bj * 256u, w);
                }
            }
    }
};
struct EpiOut {
    static constexpr bool PERM = true, MID = false;
    unsigned char* ws;
    DI void operator()(const f32x4 (&acc)[2][2][4][2], const pg8::Unit& u, int wr, int wc, int fr, int fq) const {
        unsigned char* o2 = ws + WS_OUT2; float* ssq = (float*)(ws + WS_SSQ);
        const unsigned r0_ = (unsigned)(u.pm * 256 + wr * 64 + fr), c0_ = (unsigned)(u.pn * 256 + wc * 32 + 8 * fq) * 2u;
#pragma unroll
        for (int ai = 0; ai < 2; ++ai)
#pragma unroll
            for (int m = 0; m < 4; ++m) {
                const unsigned row = r0_ + ai * 128 + m * 16; float s = 0.f;
#pragma unroll
                for (int bj = 0; bj < 2; ++bj) {
                    const f32x4 v0 = acc[ai][bj][m][0], v1 = acc[ai][bj][m][1];
                    s += v0[0] * v0[0] + v0[1] * v0[1] + v0[2] * v0[2] + v0[3] * v0[3] + v1[0] * v1[0] + v1[1] * v1[1] + v1[2] * v1[2] + v1[3] * v1[3];
                    u32x4 w = {cvtpk(v0[0], v0[1]), cvtpk(v0[2], v0[3]), cvtpk(v1[0], v1[1]), cvtpk(v1[2], v1[3])};
                    stg128(o2, row * 4096u + c0_ + bj * 256u, w);
                }
                s += __shfl_xor(s, 16); s += __shfl_xor(s, 32);
                if (fq == 0) ssq[(size_t)row * 32 + u.pn * 4 + wc] = s;
            }
    }
};

struct TJob { const float* src; bf16_t* dst; int ld_src, ld_dst, k0, n0, perm, pad_; };
DI void tr_load(const TJob& j, f32x4& v0, f32x4& v1) {
    const int t = threadIdx.x, kl = t >> 4, nl = (t & 15) * 4;
    v0 = *(const f32x4*)(j.src + (size_t)(j.k0 + kl) * j.ld_src + j.n0 + nl);
    v1 = *(const f32x4*)(j.src + (size_t)(j.k0 + kl + 32) * j.ld_src + j.n0 + nl);
}
DI void tr_store(const TJob& j, const f32x4 v0, const f32x4 v1, float* sT) {
    const int t = threadIdx.x;
    { const int kl = t >> 4, nl = (t & 15) * 4;
      sT[kl * 65 + nl] = v0[0]; sT[kl * 65 + nl + 1] = v0[1]; sT[kl * 65 + nl + 2] = v0[2]; sT[kl * 65 + nl + 3] = v0[3];
      sT[(kl + 32) * 65 + nl] = v1[0]; sT[(kl + 32) * 65 + nl + 1] = v1[1]; sT[(kl + 32) * 65 + nl + 2] = v1[2]; sT[(kl + 32) * 65 + nl + 3] = v1[3]; }
    __syncthreads();
    { const int nl = t >> 3, kc = (t & 7) * 8; int ns = nl;
      if (j.perm && nl < 32) ns = (nl & 1) ? 16 + (nl >> 1) : (nl >> 1);
      float q[8];
#pragma unroll
      for (int i = 0; i < 8; ++i) q[i] = sT[(kc + i) * 65 + ns];
      u32x4 w = {cvtpk(q[0], q[1]), cvtpk(q[2], q[3]), cvtpk(q[4], q[5]), cvtpk(q[6], q[7])};
      *(u32x4*)(j.dst + (size_t)(j.n0 + nl) * j.ld_dst + j.k0 + kc) = w; }
    __syncthreads();
}
DI TJob win_job(const Params& p, int j) {
    TJob r; const int nt = j >> 5, kt = j & 31, n0 = nt * 64;
    r.src = p.in[2]; r.dst = (bf16_t*)((unsigned char*)p.out + DO_WINT); r.ld_src = NIN; r.ld_dst = DM; r.k0 = kt * 64; r.n0 = n0;
    r.perm = (n0 >= 4096 && n0 < 6656 && (n0 & 127) == 0) ? 1 : 0; r.pad_ = 0; return r;
}
DI TJob small_job(const Params& p, int j) {
    TJob r; constexpr int J_SQ = 32 * 32;
    if (j < 3 * J_SQ) { const int which = j >> 10, q = j & 1023, nt = q >> 5, kt = q & 31;
        r.src = p.in[11 + which]; r.dst = (bf16_t*)(p.ws + (which == 0 ? WS_WAT : which == 1 ? WS_WBT : WS_WOT)); r.ld_src = DM; r.ld_dst = DM; r.k0 = kt * 64; r.n0 = nt * 64; }
    else { const int jj = j - 3 * J_SQ, gate = jj >> 7, q = jj & 127, blk = q >> 2, sub = q & 3, d = blk >> 4, nb = blk & 15;
        r.src = p.in[gate == 0 ? 5 : 7] + (size_t)blk * 16384; r.dst = (bf16_t*)(p.ws + WS_LWT) + (size_t)((d * 2 + gate) * 16 + nb) * 16384;
        r.ld_src = 128; r.ld_dst = 128; r.k0 = (sub >> 1) * 64; r.n0 = (sub & 1) * 64; }
    r.perm = 0; r.pad_ = 0; return r;
}
DI void phase_prep(const Params& p, unsigned char* shm) {
    const int tid = threadIdx.x, wid = tid >> 6, lane = tid & 63;
    bf16_t* xn = (bf16_t*)((unsigned char*)p.out + DO_XN);
    {
        const float* x = p.in[0]; const float* nw = p.in[1];
        f32x4 w[8];
#pragma unroll
        for (int i = 0; i < 8; ++i) w[i] = *(const f32x4*)(nw + i * 256 + lane * 4);
        for (int row = (blockIdx.x * 8 + wid) * 2; row < S; row += gridDim.x * 16) {
            f32x4 v[2][8];
#pragma unroll
            for (int r = 0; r < 2; ++r)
#pragma unroll
                for (int i = 0; i < 8; ++i) v[r][i] = __builtin_nontemporal_load((const f32x4*)(x + (size_t)(row + r) * DM + i * 256 + lane * 4));
#pragma unroll
            for (int r = 0; r < 2; ++r) {
                float ss = 0.f;
#pragma unroll
                for (int i = 0; i < 8; ++i) ss += v[r][i][0] * v[r][i][0] + v[r][i][1] * v[r][i][1] + v[r][i][2] * v[r][i][2] + v[r][i][3] * v[r][i][3];
                ss = wave_sum(ss);
                const float rs = rsqrtf(ss * (1.f / DM) + EPS);
#pragma unroll
                for (int i = 0; i < 8; ++i) {
                    u32x2 o = {cvtpk(v[r][i][0] * rs * w[i][0], v[r][i][1] * rs * w[i][1]), cvtpk(v[r][i][2] * rs * w[i][2], v[r][i][3] * rs * w[i][3])};
                    *(u32x2*)(xn + (size_t)(row + r) * DM + i * 256 + lane * 4) = o; }
            }
        }
    }
    {
        float* cosT = (float*)(p.ws + WS_ROPE); float* sinT = cosT + (size_t)S * 16;
        for (int i = blockIdx.x * 512 + tid; i < S * 16; i += gridDim.x * 512) {
            const int pos = i >> 4, j = i & 15;
            const float ang = (float)pos * p.inv_freq[j];
            const double rev = (double)ang * 0.15915494309189535; const float fr = (float)(rev - rint(rev));
            cosT[i] = __builtin_amdgcn_cosf(fr); sinT[i] = __builtin_amdgcn_sinf(fr);
        }
    }
    {
        float* sT = (float*)shm; constexpr int NG = 208 * 8;
        const float* src = p.in[2]; bf16_t* dst = (bf16_t*)((unsigned char*)p.out + DO_WINT);
        const int t = threadIdx.x, kl = t >> 4, nl4 = (t & 15) * 4, onl = t >> 3, okc = (t & 7) * 8;
        int g = blockIdx.x;
        if (g < NG) {
            f32x4 v[8];
#pragma unroll
            for (int q = 0; q < 8; ++q) v[q] = __builtin_nontemporal_load((const f32x4*)(src + (size_t)((g & 7) * 256 + q * 32 + kl) * NIN + (g >> 3) * 64 + nl4));
            for (;;) {
                const int gn = g + (int)gridDim.x; const bool more = gn < NG; const int gl = more ? gn : g;
                f32x4 vn[8];
#pragma unroll
                for (int q = 0; q < 8; ++q) vn[q] = __builtin_nontemporal_load((const f32x4*)(src + (size_t)((gl & 7) * 256 + q * 32 + kl) * NIN + (gl >> 3) * 64 + nl4));
#pragma unroll
                for (int q = 0; q < 8; ++q) { float* d = sT + (q * 32 + kl) * 65 + nl4; d[0] = v[q][0]; d[1] = v[q][1]; d[2] = v[q][2]; d[3] = v[q][3]; }
                __syncthreads();
                { const int n0 = (g >> 3) * 64, k0 = (g & 7) * 256; int ns = onl;
                  if (n0 >= 4096 && n0 < 6656 && (n0 & 127) == 0 && onl < 32) ns = (onl & 1) ? 16 + (onl >> 1) : (onl >> 1);
#pragma unroll
                  for (int q = 0; q < 4; ++q) { float f[8];
#pragma unroll
                      for (int i = 0; i < 8; ++i) f[i] = sT[(q * 64 + okc + i) * 65 + ns];
                      *(u32x4*)(dst + (size_t)(n0 + onl) * DM + k0 + q * 64 + okc) = (u32x4){cvtpk(f[0], f[1]), cvtpk(f[2], f[3]), cvtpk(f[4], f[5]), cvtpk(f[6], f[7])}; } }
                __syncthreads();
                if (!more) break;
#pragma unroll
                for (int q = 0; q < 8; ++q) v[q] = vn[q];
                g = gn;
            }
        }
    }
}
DI void prep_small_weights(const Params& p, unsigned char* shm, int idx, int stride) {
    float* sT = (float*)shm; constexpr int NJ = 3 * 1024 + 256;
    int j = idx;
    if (j < NJ) {
        TJob cur = small_job(p, j); f32x4 v0, v1; tr_load(cur, v0, v1);
        for (;;) {
            const int jn = j + stride; const bool more = jn < NJ;
            const TJob nxt = small_job(p, more ? jn : j); f32x4 n0, n1; tr_load(nxt, n0, n1);
            tr_store(cur, v0, v1, sT);
            if (!more) break;
            cur = nxt; v0 = n0; v1 = n1; j = jn;
        }
    }
}

DI void lru_copy_out(const bf16_t* OS, bf16_t* dst_tile, int t) {
    const int row = t >> 2, seg = (t & 3) * 32;
#pragma unroll
    for (int k = 0; k < 4; ++k) { const u32x4 v = *(const u32x4*)(OS + row * 136 + seg + k * 8); *(u32x4*)(dst_tile + (size_t)row * 2048 + seg + k * 8) = v; }
}
DI void lru_tile(const Params& p, unsigned char* shm, int c, int nb) {
    int tid = threadIdx.x; asm volatile("" : "+v"(tid));
    const int wid = __builtin_amdgcn_readfirstlane(tid >> 6), lane = tid & 63;
    constexpr int LDU = 136;
    bf16_t* UB = (bf16_t*)shm;
    bf16_t* SG = (bf16_t*)(shm + 34816);
    bf16_t* OS = (bf16_t*)(shm + 2 * 34816);
    f32x2* AG = (f32x2*)(shm + 3 * 34816) + wid * 512;
    const bf16_t* ZU = (const bf16_t*)(p.ws + WS_ZU);
    bf16_t* ZGt = (bf16_t*)(p.ws + WS_ZG) + (size_t)c * 128 * 2048 + nb * 128;
    {
        const int cgp = tid & 15, rg = tid >> 4, ch = nb * 128 + cgp * 8;
        const float* cw = p.in[3]; const float* cb = p.in[4];
        float w[4][8], bias[8];
#pragma unroll
        for (int tp = 0; tp < 4; ++tp) { const f32x4 a = *(const f32x4*)(cw + tp * 2048 + ch), b = *(const f32x4*)(cw + tp * 2048 + ch + 4);
            w[tp][0] = a[0]; w[tp][1] = a[1]; w[tp][2] = a[2]; w[tp][3] = a[3]; w[tp][4] = b[0]; w[tp][5] = b[1]; w[tp][6] = b[2]; w[tp][7] = b[3]; }
        { const f32x4 a = *(const f32x4*)(cb + ch), b = *(const f32x4*)(cb + ch + 4);
            bias[0] = a[0]; bias[1] = a[1]; bias[2] = a[2]; bias[3] = a[3]; bias[4] = b[0]; bias[5] = b[1]; bias[6] = b[2]; bias[7] = b[3]; }
        float xr[7][8];
#pragma unroll
        for (int k = 0; k < 7; ++k) { const int t = c * 128 + rg * 4 - 2 + k;
            u32x4 v = {0u, 0u, 0u, 0u};
            if (t >= 0 && t < S) v = *(const u32x4*)(ZU + (size_t)(nb >> 1) * S * 256 + (size_t)t * 256 + (nb & 1) * 128 + cgp * 8);
#pragma unroll
            for (int i = 0; i < 4; ++i) { xr[k][2 * i] = bflo(v[i]); xr[k][2 * i + 1] = bfhi(v[i]); } }
#pragma unroll
        for (int o = 0; o < 4; ++o) { float u8[8];
#pragma unroll
            for (int i = 0; i < 8; ++i) { float a = bias[i];
#pragma unroll
                for (int tp = 0; tp < 4; ++tp) a += xr[o + tp][i] * w[tp][i];
                u8[i] = a; }
            *(u32x4*)(UB + (rg * 4 + o) * LDU + cgp * 8) = (u32x4){cvtpk(u8[0], u8[1]), cvtpk(u8[2], u8[3]), cvtpk(u8[4], u8[5]), cvtpk(u8[6], u8[7])};
        }
        __builtin_amdgcn_sched_barrier(0);
        u32x4 gv[4];
#pragma unroll
        for (int o = 0; o < 4; ++o) gv[o] = __builtin_nontemporal_load((const u32x4*)(ZGt + (size_t)(rg * 4 + o) * 2048 + cgp * 8));
#pragma unroll
        for (int o = 0; o < 4; ++o) {
            float sgl[8];
#pragma unroll
            for (int i = 0; i < 4; ++i) { const float g0 = bflo(gv[o][i]), g1 = bfhi(gv[o][i]); sgl[2 * i] = g0 * sigm(g0); sgl[2 * i + 1] = g1 * sigm(g1); }
            *(u32x4*)(SG + (rg * 4 + o) * LDU + cgp * 8) = (u32x4){cvtpk(sgl[0], sgl[1]), cvtpk(sgl[2], sgl[3]), cvtpk(sgl[4], sgl[5]), cvtpk(sgl[6], sgl[7])};
        }
    }
    __syncthreads();
    const int col = lane & 15, q = lane >> 4;
    const int chl = wid * 16 + col, chg = nb * 128 + chl;
    float hsum[8][4];
    f32x2* AGG = (f32x2*)(p.ws + WS_AGG);
    const bf16_t* LWT = (const bf16_t*)(p.ws + WS_LWT);
#pragma unroll
    for (int d = 0; d < 2; ++d) {
        f32x4 acc[2][8];
#pragma unroll
        for (int a = 0; a < 2; ++a)
#pragma unroll
            for (int b = 0; b < 8; ++b) acc[a][b] = (f32x4){0.f, 0.f, 0.f, 0.f};
        bf16x8 bfr[4][2];
#pragma unroll
        for (int s = 0; s < 4; ++s)
#pragma unroll
            for (int gt = 0; gt < 2; ++gt) bfr[s][gt] = *(const bf16x8*)(LWT + ((size_t)((d * 2 + gt) * 16 + nb) * 128 + chl) * 128 + s * 32 + q * 8);
        const float br = p.in[6][d * 2048 + chg], bi = p.in[8][d * 2048 + chg], lam = p.in[9][d * 2048 + chg];
#pragma unroll
        for (int s = 0; s < 4; ++s) {
#pragma unroll
            for (int rt = 0; rt < 8; ++rt) {
                const bf16x8 af = *(const bf16x8*)(UB + (rt * 16 + col) * LDU + s * 32 + q * 8);
#pragma unroll
                for (int gt = 0; gt < 2; ++gt) acc[gt][rt] = __builtin_amdgcn_mfma_f32_16x16x32_bf16(af, bfr[s][gt], acc[gt][rt], 0, 0, 0);
            }
            __builtin_amdgcn_sched_barrier(0);
        }
        const float sp = log1pf(expf(-lam));
        const float cdec = -8.f * sp * LOG2E;
        const f32x2 nl2 = {-LOG2E, -LOG2E}, nbr2 = {-br * LOG2E, -br * LOG2E}, nbi2 = {-bi * LOG2E, -bi * LOG2E}, cd2 = {cdec, cdec}, one2 = {1.f, 1.f};
        float hl[8][4], pc[8][4];
#pragma unroll
        for (int rt = 0; rt < 8; ++rt) {
            float av[4], bv[4];
#pragma unroll
            for (int jp = 0; jp < 2; ++jp) {
                const f32x2 xr = {acc[0][rt][2 * jp], acc[0][rt][2 * jp + 1]}, xi = {acc[1][rt][2 * jp], acc[1][rt][2 * jp + 1]};
                f32x2 er = xr * nl2 + nbr2, ei = xi * nl2 + nbi2;
                er = (f32x2){ex2(er[0]), ex2(er[1])} + one2; ei = (f32x2){ex2(ei[0]), ex2(ei[1])} + one2;
                const f32x2 r = {rcpf_(er[0]), rcpf_(er[1])}, ig = {rcpf_(ei[0]), rcpf_(ei[1])};
                const f32x2 la = r * cd2;
                const f32x2 a = {ex2(la[0]), ex2(la[1])};
                const f32x2 om = one2 - a * a;
                const f32x2 sc = {__builtin_amdgcn_sqrtf(om[0]), __builtin_amdgcn_sqrtf(om[1])};
                const f32x2 u2 = {bf2f(UB[(rt * 16 + 4 * q + 2 * jp) * LDU + chl]), bf2f(UB[(rt * 16 + 4 * q + 2 * jp + 1) * LDU + chl])};
                const f32x2 b2 = sc * ig * u2;
                av[2 * jp] = a[0]; av[2 * jp + 1] = a[1]; bv[2 * jp] = b2[0]; bv[2 * jp + 1] = b2[1];
            }
            float h = 0.f, P = 1.f;
            if (d == 0) {
#pragma unroll
                for (int j = 0; j < 4; ++j) { h = fmaf(av[j], h, bv[j]); P *= av[j]; hl[rt][j] = h; pc[rt][j] = P; }
            } else {
#pragma unroll
                for (int j = 3; j >= 0; --j) { h = fmaf(av[j], h, bv[j]); P *= av[j]; hl[rt][j] = h; pc[rt][j] = P; }
            }
            AG[(rt * 4 + q) * 16 + col] = (f32x2){P, h};
            __builtin_amdgcn_sched_barrier(0);
        }
        asm volatile("s_waitcnt lgkmcnt(0)" ::: "memory");
        float carry[8], pref[8]; float cin = 0.f, pa = 1.f;
#pragma unroll
        for (int gi = 0; gi < 32; ++gi) {
            const int G = d == 0 ? gi : 31 - gi; const int rt = G >> 2, qq = G & 3;
            const f32x2 ah = AG[G * 16 + col];
            if (qq == q) { carry[rt] = cin; pref[rt] = pa; }
            cin = fmaf(ah[0], cin, ah[1]); pa *= ah[0];
        }
        if (q == 0) AGG[((size_t)d * 128 + c) * 2048 + chg] = (f32x2){pa, cin};
        __syncthreads();
#pragma unroll
        for (int rt = 0; rt < 8; ++rt) {
            const f32x2 cr2 = {carry[rt], carry[rt]}, pf2 = {pref[rt], pref[rt]};
#pragma unroll
            for (int jp = 0; jp < 2; ++jp) {
                const int lo = (rt * 16 + 4 * q + 2 * jp) * LDU + chl;
                const f32x2 sg2 = {bf2f(SG[lo]), bf2f(SG[lo + LDU])};
                const f32x2 pc2 = {pc[rt][2 * jp], pc[rt][2 * jp + 1]}, hl2 = {hl[rt][2 * jp], hl[rt][2 * jp + 1]};
                const f32x2 hf = pc2 * cr2 + hl2, ov = pc2 * pf2 * sg2;
                const unsigned w = cvtpk(ov[0], ov[1]);
                OS[lo] = (unsigned short)(w & 0xffffu); OS[lo + LDU] = (unsigned short)(w >> 16);
                if (d == 0) { hsum[rt][2 * jp] = hf[0]; hsum[rt][2 * jp + 1] = hf[1]; }
                else { const f32x2 hs = ((f32x2){hsum[rt][2 * jp], hsum[rt][2 * jp + 1]} + hf) * sg2; hsum[rt][2 * jp] = hs[0]; hsum[rt][2 * jp + 1] = hs[1]; }
            }
            __builtin_amdgcn_sched_barrier(0);
        }
        __syncthreads();
        lru_copy_out(OS, (bf16_t*)((unsigned char*)p.out + (d == 0 ? DO_ACF : DO_ACB)) + (size_t)c * 128 * 2048 + nb * 128, tid);
        __builtin_amdgcn_sched_barrier(0);
    }
    __syncthreads();
#pragma unroll
    for (int rt = 0; rt < 8; ++rt)
#pragma unroll
        for (int jp = 0; jp < 2; ++jp) { const int lo = (rt * 16 + 4 * q + 2 * jp) * LDU + chl; const unsigned w = cvtpk(hsum[rt][2 * jp], hsum[rt][2 * jp + 1]);
            OS[lo] = (unsigned short)(w & 0xffffu); OS[lo + LDU] = (unsigned short)(w >> 16); }
    __syncthreads();
    lru_copy_out(OS, ZGt, tid);
}

namespace att {
constexpr float SCALE = 0.088388347648318440f, THR = 8.f;
constexpr int SHM_V = 64 * 128 * 2, SHM_K = SHM_V, LDK = 3072;
#define KSWZ(row, colB) ((row) * 256 + ((colB) ^ (((row) & 7) << 4)))
#define SBAR() __builtin_amdgcn_sched_barrier(0)
DI int crow(int r, int hi) { return (r & 3) + 8 * (r >> 2) + 4 * hi; }
DI void maskT(f32x16& p0, f32x16& p1, int kt, int qw, int r32, int hi) {
    if ((kt - qw - 31 < -128) || (kt + 63 - qw > 128)) {
        const int db = kt - (qw + r32) + 4 * hi;
#pragma unroll
        for (int r = 0; r < 16; ++r) { const int d = db + (r & 3) + 8 * (r >> 2);
            p0[r] = (d >= -128 && d <= 128) ? p0[r] : -1e30f; p1[r] = (d + 32 >= -128 && d + 32 <= 128) ? p1[r] : -1e30f; }
    }
}
DI void partialSM(f32x16& p0, f32x16& p1, float& m_reg, float& mn, float& alpha) {
    constexpr float C = SCALE * 1.4426950408889634f;
    float pmax = p0[0];
#pragma unroll
    for (int r = 1; r < 16; ++r) pmax = fmaxf(pmax, p0[r]);
#pragma unroll
    for (int r = 0; r < 16; ++r) pmax = fmaxf(pmax, p1[r]);
    { auto rr = __builtin_amdgcn_permlane32_swap(__float_as_uint(pmax), __float_as_uint(pmax), false, false);
      pmax = fmaxf(__uint_as_float(rr[0]), __uint_as_float(rr[1])); }
    if (__builtin_expect(__all(pmax - m_reg <= THR / SCALE), 1)) { mn = m_reg; alpha = 1.f; }
    else { mn = fmaxf(m_reg, pmax); alpha = __builtin_amdgcn_exp2f((m_reg - mn) * C); m_reg = mn; }
    const float mnC = -mn * C;
#pragma unroll
    for (int r = 0; r < 16; ++r) p0[r] = fmaf(p0[r], C, mnC);
#pragma unroll
    for (int r = 0; r < 16; ++r) p1[r] = fmaf(p1[r], C, mnC);
#pragma unroll
    for (int r = 0; r < 16; ++r) p0[r] = __builtin_amdgcn_exp2f(p0[r]);
}
DI void finishSM(f32x16& p0, f32x16& p1, float alpha, float& l_reg, bf16x8& pa0, bf16x8& pa1, bf16x8& pa2, bf16x8& pa3) {
#pragma unroll
    for (int r = 0; r < 16; ++r) p1[r] = __builtin_amdgcn_exp2f(p1[r]);
    float ps = 0;
#pragma unroll
    for (int r = 0; r < 16; ++r) ps += p0[r];
#pragma unroll
    for (int r = 0; r < 16; ++r) ps += p1[r];
    { auto rr = __builtin_amdgcn_permlane32_swap(__float_as_uint(ps), __float_as_uint(ps), false, false);
      ps = __uint_as_float(rr[0]) + __uint_as_float(rr[1]); }
    l_reg = l_reg * alpha + ps;
#define PK4(P, BASE, OUT) do { unsigned a0 = cvtpk(P[BASE + 0], P[BASE + 1]), a1 = cvtpk(P[BASE + 2], P[BASE + 3]);   \
    unsigned b0 = cvtpk(P[BASE + 4], P[BASE + 5]), b1 = cvtpk(P[BASE + 6], P[BASE + 7]);                              \
    auto r0 = __builtin_amdgcn_permlane32_swap(a0, b0, false, false); auto r1 = __builtin_amdgcn_permlane32_swap(a1, b1, false, false); \
    u32x4 w = {r0[0], r1[0], r0[1], r1[1]}; OUT = __builtin_bit_cast(bf16x8, w); } while (0)
    PK4(p0, 0, pa0); PK4(p0, 8, pa1); PK4(p1, 0, pa2); PK4(p1, 8, pa3);
#undef PK4
}
DI void qkt(f32x16& p0, f32x16& p1, const char* Ks, const bf16x8* qr, int r32, int hi) {
#pragma unroll
    for (int i = 0; i < 16; ++i) { p0[i] = 0.f; p1[i] = 0.f; }
#pragma unroll
    for (int d0 = 0; d0 < 8; ++d0) { const int cb = (d0 * 16 + hi * 8) * 2;
        const bf16x8 b0 = *reinterpret_cast<const bf16x8*>(Ks + KSWZ(r32, cb));
        const bf16x8 b1 = *reinterpret_cast<const bf16x8*>(Ks + KSWZ(32 + r32, cb));
        p0 = __builtin_amdgcn_mfma_f32_32x32x16_bf16(b0, qr[d0], p0, 0, 0, 0);
        p1 = __builtin_amdgcn_mfma_f32_32x32x16_bf16(b1, qr[d0], p1, 0, 0, 0); }
}
DI int v_st(int k, int c) { const int kk = (k & ~0xC) | ((k & 4) << 1) | ((k & 8) >> 1); return ((kk >> 3) * 4 + (c >> 5)) * 512 + ((kk & 7) * 32 + (c & 31)) * 2; }
DI int v_rd_base(int lane) { return ((lane & 3) << 3) | (((lane >> 2) & 3) << 6) | (((lane >> 4) & 1) << 5) | (((lane >> 5) & 1) << 8); }
constexpr int v_rd_off(int d0, int ks, int half) { return d0 * 512 + ks * 4096 + half * 2048; }
template <int OFF> DI s16x4 tr_read(int vb) {
    s16x4 r; asm volatile("ds_read_b64_tr_b16 %0, %1 offset:%2" : "=&v"(r) : "v"(vb), "i"(OFF) : "memory"); return r;
}
template <int D0> DI void pv_one(f32x16& od, int vb, bf16x8 pa0, bf16x8 pa1, bf16x8 pa2, bf16x8 pa3) {
    const s16x4 l0 = tr_read<v_rd_off(D0, 0, 0)>(vb), h0 = tr_read<v_rd_off(D0, 0, 1)>(vb), l1 = tr_read<v_rd_off(D0, 1, 0)>(vb), h1 = tr_read<v_rd_off(D0, 1, 1)>(vb);
    const s16x4 l2 = tr_read<v_rd_off(D0, 2, 0)>(vb), h2 = tr_read<v_rd_off(D0, 2, 1)>(vb), l3 = tr_read<v_rd_off(D0, 3, 0)>(vb), h3 = tr_read<v_rd_off(D0, 3, 1)>(vb);
    asm volatile("s_waitcnt lgkmcnt(0)" ::: "memory"); SBAR();
#define PK(L, H) (bf16x8){L[0], L[1], L[2], L[3], H[0], H[1], H[2], H[3]}
    od = __builtin_amdgcn_mfma_f32_32x32x16_bf16(pa0, PK(l0, h0), od, 0, 0, 0);
    od = __builtin_amdgcn_mfma_f32_32x32x16_bf16(pa1, PK(l1, h1), od, 0, 0, 0);
    od = __builtin_amdgcn_mfma_f32_32x32x16_bf16(pa2, PK(l2, h2), od, 0, 0, 0);
    od = __builtin_amdgcn_mfma_f32_32x32x16_bf16(pa3, PK(l3, h3), od, 0, 0, 0);
#undef PK
}
DI void pv_d0(f32x16* o, int vb, bf16x8 pa0, bf16x8 pa1, bf16x8 pa2, bf16x8 pa3) {
    pv_one<0>(o[0], vb, pa0, pa1, pa2, pa3); pv_one<1>(o[1], vb, pa0, pa1, pa2, pa3); pv_one<2>(o[2], vb, pa0, pa1, pa2, pa3); pv_one<3>(o[3], vb, pa0, pa1, pa2, pa3);
}
DI void attn_item(const bf16_t* __restrict__ Qw_, const bf16_t* __restrict__ Kh, const bf16_t* __restrict__ Vh, const bf16_t* Gw, bf16_t* Ow,
                  int NT, int kt0, int qw, float sinkv, char* lds) {
    const int tid = threadIdx.x, wid = __builtin_amdgcn_readfirstlane(tid >> 6), lane = tid & 63, r32 = lane & 31, hi = lane >> 5;
    char* V_lds = lds; char* K_lds = lds + 2 * SHM_V;
    float* wsp = (float*)(lds + 2 * SHM_V + 2 * SHM_K) + wid * 64; float* li_l = wsp; float* al_l = wsp + 32;
    float m_reg = sinkv * (1.f / SCALE), l_reg = 1.f; f32x16 o[4]; bf16x8 qr[8];
#pragma unroll
    for (int d = 0; d < 4; ++d)
#pragma unroll
        for (int r = 0; r < 16; ++r) o[d][r] = 0.f;
    const bf16_t* Qw = Qw_ + (size_t)r32 * LDK + hi * 8;
#pragma unroll
    for (int d0 = 0; d0 < 8; ++d0) qr[d0] = *(const bf16x8*)(Qw + d0 * 16);
    const int sr = tid >> 4, sc = (tid & 15) * 8, vst0 = v_st(sr, sc), vst1 = v_st(32 + sr, sc);
    const int vb0 = (int)(uintptr_t)V_lds + v_rd_base(lane);
    struct { bf16x8 vs0, vs1, ks0, ks1; } sr_[2];
#define SLOAD(i, k0) do { sr_[i].vs0 = *(const bf16x8*)(&Vh[(size_t)((k0) + sr) * LDK + sc]); sr_[i].vs1 = *(const bf16x8*)(&Vh[(size_t)((k0) + 32 + sr) * LDK + sc]); \
    sr_[i].ks0 = *(const bf16x8*)(&Kh[(size_t)((k0) + sr) * LDK + sc]); sr_[i].ks1 = *(const bf16x8*)(&Kh[(size_t)((k0) + 32 + sr) * LDK + sc]); } while (0)
#define SWRITE(b, i) do { *(bf16x8*)(V_lds + (b) * SHM_V + vst0) = sr_[i].vs0;          \
    *(bf16x8*)(V_lds + (b) * SHM_V + vst1) = sr_[i].vs1; const int kc = sc * 2;               \
    *(bf16x8*)(K_lds + (b) * SHM_K + KSWZ(sr, kc)) = sr_[i].ks0;                       \
    *(bf16x8*)(K_lds + (b) * SHM_K + KSWZ(32 + sr, kc)) = sr_[i].ks1; } while (0)
#define SWAIT() asm volatile("s_waitcnt vmcnt(4)" ::: "memory")
#define RESC(a) do { if (__any((a) < 1.f)) { if (hi == 0) al_l[r32] = (a); asm volatile("s_waitcnt lgkmcnt(0)" ::: "memory"); \
    _Pragma("unroll") for (int d = 0; d < 4; ++d) _Pragma("unroll") for (int r = 0; r < 16; ++r) o[d][r] *= al_l[crow(r, hi)]; } } while (0)
    f32x16 pA0, pA1, pB0, pB1; float mnA, mnB, alA, alB; bf16x8 pa0, pa1, pa2, pa3;
    constexpr int SE = 0, SO = 1;
    SLOAD(SE, 0); asm volatile("s_waitcnt vmcnt(0)" ::: "memory"); SWRITE(0, SE); __syncthreads();
    qkt(pA0, pA1, K_lds, qr, r32, hi); maskT(pA0, pA1, kt0, qw, r32, hi); partialSM(pA0, pA1, m_reg, mnA, alA);
    SLOAD(SO, 64); if (2 < NT) SLOAD(SE, 128);
    SWAIT(); SWRITE(1, SO); __syncthreads();
    for (int j = 1; j + 1 < NT; j += 2) {
        SBAR(); qkt(pB0, pB1, K_lds + SHM_K, qr, r32, hi);
        finishSM(pA0, pA1, alA, l_reg, pa0, pa1, pa2, pa3); SBAR();
        SLOAD(SO, (j + 2) * 64); SBAR();
        pv_d0(o, vb0, pa0, pa1, pa2, pa3); maskT(pB0, pB1, kt0 + 64 * j, qw, r32, hi); partialSM(pB0, pB1, m_reg, mnB, alB);
        __syncthreads(); SWAIT(); SWRITE(0, SE);
        RESC(alB); __syncthreads();
        SBAR(); qkt(pA0, pA1, K_lds, qr, r32, hi);
        finishSM(pB0, pB1, alB, l_reg, pa0, pa1, pa2, pa3); SBAR();
        if (j + 3 < NT) SLOAD(SE, (j + 3) * 64); SBAR();
        pv_d0(o, vb0 + SHM_V, pa0, pa1, pa2, pa3); maskT(pA0, pA1, kt0 + 64 * (j + 1), qw, r32, hi); partialSM(pA0, pA1, m_reg, mnA, alA);
        __syncthreads(); SWAIT(); SWRITE(1, SO);
        RESC(alA); __syncthreads();
    }
    SBAR(); qkt(pB0, pB1, K_lds + SHM_K, qr, r32, hi);
    finishSM(pA0, pA1, alA, l_reg, pa0, pa1, pa2, pa3); SBAR();
    pv_d0(o, vb0, pa0, pa1, pa2, pa3); maskT(pB0, pB1, kt0 + 64 * (NT - 1), qw, r32, hi); partialSM(pB0, pB1, m_reg, mnB, alB);
    __syncthreads(); RESC(alB);
    finishSM(pB0, pB1, alB, l_reg, pa0, pa1, pa2, pa3); SBAR();
    pv_d0(o, vb0 + SHM_V, pa0, pa1, pa2, pa3);
    int lane2 = threadIdx.x & 63; asm volatile("" : "+v"(lane2));
    const int ec = lane2 & 15, er = lane2 >> 4;
    if (hi == 0) li_l[r32] = l_reg; asm volatile("s_waitcnt lgkmcnt(0)" ::: "memory");
    bf16_t* OT = (bf16_t*)(lds + 67584 + wid * 8704);
#pragma unroll
    for (int r = 0; r < 16; ++r) { const int orow = crow(r, hi); const float rl = __builtin_amdgcn_rcpf(li_l[orow]);
#pragma unroll
        for (int d0 = 0; d0 < 4; ++d0) OT[orow * 136 + d0 * 32 + r32] = f2bf(o[d0][r] * rl); }
    __builtin_amdgcn_sched_barrier(0);
    u32x4 gv[8];
#pragma unroll
    for (int k = 0; k < 8; ++k) gv[k] = __builtin_nontemporal_load((const u32x4*)(Gw + (size_t)(er + 4 * k) * 2048 + ec * 8));
    asm volatile("s_waitcnt lgkmcnt(0)" ::: "memory");
#pragma unroll
    for (int k = 0; k < 8; ++k) {
        const u32x4 ov = *(const u32x4*)(OT + (er + 4 * k) * 136 + ec * 8); u32x4 w;
#pragma unroll
        for (int i = 0; i < 4; ++i) { const float g0 = bflo(gv[k][i]), g1 = bfhi(gv[k][i]); w[i] = cvtpk(bflo(ov[i]) * g0 * sigm(g0), bfhi(ov[i]) * g1 * sigm(g1)); }
        *(u32x4*)(Ow + (size_t)(er + 4 * k) * 2048 + ec * 8) = w;
    }
#undef SLOAD
#undef SWRITE
#undef SWAIT
#undef RESC
}
}

DI void phase_lru(const Params& p, unsigned char* shm) {
    for (int it = blockIdx.x; it < 2048; it += gridDim.x) lru_tile(p, shm, it >> 4, it & 15);
    __syncthreads();
}
DI void phase_att(const Params& p, unsigned char* shm) {
    const int wid = __builtin_amdgcn_readfirstlane(threadIdx.x >> 6);
    const bf16_t* Z = (const bf16_t*)(p.ws + WS_ZQKV); const bf16_t* GA = (const bf16_t*)(p.ws + WS_ZGA); bf16_t* YB = (bf16_t*)(p.ws + WS_YB);
    for (int it = blockIdx.x; it < 1024; it += gridDim.x) {
        const int hp = it & 1, g = (it >> 1) & 3, n = it >> 3;
        const int head = g * 4 + hp * 2 + (wid >> 2), qw = 32 * (wid & 3);
        const int kfirst = n == 0 ? 0 : (n - 1) * 128, NT = (n == 0 || n == 127) ? 4 : 6, kt0 = kfirst - n * 128;
        __syncthreads();
        const size_t go = (size_t)(n * 128 + qw) * 2048 + head * 128;
        att::attn_item(Z + (size_t)(n * 128 + qw) * 3072 + head * 128, Z + (size_t)kfirst * 3072 + 2048 + g * 128, Z + (size_t)kfirst * 3072 + 2560 + g * 128,
                       GA + go, YB + go, NT, kt0, qw, p.in[10][head], (char*)shm);
    }
    __syncthreads();
}
DI void phase_mixers(const Params& p, unsigned char* shm) { if (p.mix_mask & 1) phase_lru(p, shm); if (p.mix_mask & 2) phase_att(p, shm); }

DI void phase_carry(const Params& p) {
    const int tid = threadIdx.x;
    if (tid >= 64) return;
    const f32x2* AGG = (const f32x2*)(p.ws + WS_AGG); float* CAR = (float*)(p.ws + WS_CAR);
    for (int w = blockIdx.x; w < 64; w += gridDim.x) {
        const int id = w * 64 + tid, d = id >> 11, ch = id & 2047;
        const f32x2* ag = AGG + (size_t)d * 128 * 2048 + ch; float* car = CAR + (size_t)d * 128 * 2048 + ch;
        float cin = 0.f;
        for (int b = 0; b < 4; ++b) {
            f32x2 v[32];
#pragma unroll
            for (int u = 0; u < 32; ++u) { const int k = b * 32 + u, cc = d == 0 ? k : 127 - k; v[u] = ag[(size_t)cc * 2048]; }
#pragma unroll
            for (int u = 0; u < 32; ++u) { const int k = b * 32 + u, cc = d == 0 ? k : 127 - k; car[(size_t)cc * 2048] = cin; cin = fmaf(v[u][0], cin, v[u][1]); }
        }
    }
}
DI void phase_fixup(const Params& p) {
    const int tid = threadIdx.x, ch = tid * 4;
    const float* CAR = (const float*)(p.ws + WS_CAR);
    bf16_t* ZG = (bf16_t*)(p.ws + WS_ZG);
    const bf16_t* ACF = (const bf16_t*)((unsigned char*)p.out + DO_ACF); const bf16_t* ACB = (const bf16_t*)((unsigned char*)p.out + DO_ACB);
    for (int it = blockIdx.x; it < 512; it += gridDim.x) {
        const int c = it >> 2, rq = it & 3;
        const f32x4 cf = *(const f32x4*)(CAR + (size_t)c * 2048 + ch), cb = *(const f32x4*)(CAR + (size_t)(128 + c) * 2048 + ch);
#pragma unroll 8
        for (int i = 0; i < 32; ++i) {
            const size_t off = (size_t)(c * 128 + rq * 32 + i) * 2048 + ch;
            const u32x2 h = __builtin_nontemporal_load((const u32x2*)(ZG + off)), f = __builtin_nontemporal_load((const u32x2*)(ACF + off)), b = __builtin_nontemporal_load((const u32x2*)(ACB + off));
            const float y0 = bflo(h[0]) + bflo(f[0]) * cf[0] + bflo(b[0]) * cb[0], y1 = bfhi(h[0]) + bfhi(f[0]) * cf[1] + bfhi(b[0]) * cb[1];
            const float y2 = bflo(h[1]) + bflo(f[1]) * cf[2] + bflo(b[1]) * cb[2], y3 = bfhi(h[1]) + bfhi(f[1]) * cf[3] + bfhi(b[1]) * cb[3];
            *(u32x2*)(ZG + off) = (u32x2){cvtpk(y0, y1), cvtpk(y2, y3)};
        }
    }
}

DI void phase_final(const Params& p) {
    const int tid = threadIdx.x, wid = tid >> 6, lane = tid & 63;
    const float* x = p.in[0]; const float* nw = p.in[14]; const bf16_t* o2 = (const bf16_t*)(p.ws + WS_OUT2); const float* ssq = (const float*)(p.ws + WS_SSQ);
    f32x4 w[8];
#pragma unroll
    for (int i = 0; i < 8; ++i) w[i] = *(const f32x4*)(nw + i * 256 + lane * 4);
    for (int row = (blockIdx.x * 8 + wid) * 2; row < S; row += gridDim.x * 16) {
        f32x4 xv[2][8]; u32x2 yv[2][8]; float sq[2];
#pragma unroll
        for (int r = 0; r < 2; ++r) {
            sq[r] = lane < 32 ? ssq[(size_t)(row + r) * 32 + lane] : 0.f;
#pragma unroll
            for (int i = 0; i < 8; ++i) { const size_t off = (size_t)(row + r) * DM + i * 256 + lane * 4; xv[r][i] = __builtin_nontemporal_load((const f32x4*)(x + off)); yv[r][i] = __builtin_nontemporal_load((const u32x2*)(o2 + off)); }
        }
#pragma unroll
        for (int r = 0; r < 2; ++r) {
            const float rs = rsqrtf(wave_sum(sq[r]) * (1.f / DM) + EPS);
#pragma unroll
            for (int i = 0; i < 8; ++i) { const size_t off = (size_t)(row + r) * DM + i * 256 + lane * 4;
                const f32x4 ov = {xv[r][i][0] + bflo(yv[r][i][0]) * rs * w[i][0], xv[r][i][1] + bfhi(yv[r][i][0]) * rs * w[i][1],
                                  xv[r][i][2] + bflo(yv[r][i][1]) * rs * w[i][2], xv[r][i][3] + bfhi(yv[r][i][1]) * rs * w[i][3]};
                __builtin_nontemporal_store(ov, (f32x4*)(p.out + off)); }
        }
    }
}

#define XB_TMO      128
#define XB_XCNT(j)  (256  + 64 * (j))
#define XB_XSUB(j)  (1280 + 64 * (j))
#define XB_XGEN(j)  (2304 + 64 * (j))
#define XB_TOP      3328
#define XB_TOPGEN   3392
#define XCD_BAR_WORDS 3456
#define XB_SPIN_CAP (1u << 18)

__device__ __forceinline__ unsigned xb_ld(unsigned* p)              { return __hip_atomic_load(p, __ATOMIC_RELAXED, __HIP_MEMORY_SCOPE_AGENT); }
__device__ __forceinline__ unsigned xb_add(unsigned* p, unsigned v) { return __hip_atomic_fetch_add(p, v, __ATOMIC_RELAXED, __HIP_MEMORY_SCOPE_AGENT); }
__device__ __forceinline__ unsigned xb_xcc_id() { return (unsigned)__builtin_amdgcn_s_getreg((3 << 11) | 20) & 0xFu; }
#define XB_SPIN(cond, bar) do { unsigned _sp = 0; while (cond) { __builtin_amdgcn_s_sleep(1); \
    if ((++_sp & 255u) == 0u) { if (xb_ld(&(bar)[XB_TMO])) break; if (_sp > XB_SPIN_CAP) { atomicAdd(&(bar)[XB_TMO], 1u); break; } } } } while (0)

struct XcdBarrier {
    unsigned* bar; unsigned x;
    volatile LAS unsigned* st;
};

__device__ __forceinline__ XcdBarrier xcd_barrier_post(unsigned* bar, volatile LAS unsigned* st) {
    XcdBarrier b; b.bar = bar; b.x = xb_xcc_id(); b.st = st;
    if (threadIdx.x == 0) (void)xb_add(&bar[XB_XCNT(b.x)], 1u);
    return b;
}
__device__ __forceinline__ void xcd_barrier_complete(unsigned* bar, unsigned x, unsigned& nloc, unsigned& nx) {
    const unsigned G = gridDim.x * gridDim.y * gridDim.z;
    unsigned sum, cnt, mine, sp = 0u;
    for (;;) {
        sum = 0u; cnt = 0u; mine = 0u;
#pragma unroll
        for (unsigned j = 0; j < 16; ++j) { const unsigned c = xb_ld(&bar[XB_XCNT(j)]); sum += c; cnt += (c > 0u) ? 1u : 0u; mine = (j == x) ? c : mine; }
        if (sum == G) break;
        __builtin_amdgcn_s_sleep(1);
        if ((++sp & 255u) == 0u) { if (xb_ld(&bar[XB_TMO])) break; if (sp > XB_SPIN_CAP) { atomicAdd(&bar[XB_TMO], 1u); break; } }
    }
    nloc = mine > 0u ? mine : 1u; nx = cnt > 0u ? cnt : 1u;
}

__device__ __forceinline__ void xcd_barrier(const XcdBarrier& b) {
    asm volatile("s_waitcnt vmcnt(0)" ::: "memory");
    __syncthreads();
    if (threadIdx.x == 0) {
        unsigned* bar = b.bar;
        __builtin_amdgcn_s_waitcnt(0);
        unsigned nloc = b.st[0], nx = b.st[1];
        if (nloc == 0u) { xcd_barrier_complete(bar, b.x, nloc, nx); b.st[0] = nloc; b.st[1] = nx; }
        const unsigned old = xb_add(&bar[XB_XSUB(b.x)], 1u);
        const unsigned gen = old / nloc;
        if (old + 1u == (gen + 1u) * nloc) {
            __builtin_amdgcn_fence(__ATOMIC_RELEASE, "agent");
            asm volatile("s_waitcnt vmcnt(0)" ::: "memory");
            const unsigned og = xb_add(&bar[XB_TOP], 1u);
            const unsigned tg = og / nx;
            if (og + 1u == (tg + 1u) * nx) xb_add(&bar[XB_TOPGEN], 1u);
            else XB_SPIN(xb_ld(&bar[XB_TOPGEN]) == tg, bar);
            __builtin_amdgcn_fence(__ATOMIC_ACQUIRE, "agent");
            xb_add(&bar[XB_XGEN(b.x)], 1u);
            asm volatile("s_waitcnt vmcnt(0)" ::: "memory");
        } else {
            XB_SPIN(xb_ld(&bar[XB_XGEN(b.x)]) == gen, bar);
            __builtin_amdgcn_fence(__ATOMIC_ACQUIRE, "agent");
            asm volatile("s_waitcnt vmcnt(0)" ::: "memory");
        }
    }
    __syncthreads();
}

__global__ void __launch_bounds__(512, 2) mega(Params p) {
    extern __shared__ __attribute__((aligned(16))) unsigned char shm[];
    cg::grid_group grid = cg::this_grid();
    volatile LAS unsigned* bst = (volatile LAS unsigned*)((LAS unsigned char*)shm + LDS_BAR_ST);
    if (threadIdx.x < 4) bst[threadIdx.x] = 0u;
    __syncthreads();
    XcdBarrier xbar; xbar.bar = (unsigned*)(p.ws + WS_BAR); xbar.x = 0; xbar.st = bst;
    if (p.ph_hi - p.ph_lo > 1) xbar = xcd_barrier_post((unsigned*)(p.ws + WS_BAR), bst);
    if (p.ph_lo > 64) grid.sync();
#ifndef PHMASK
#define PHMASK 0xff
#endif
#define PH(i) (((PHMASK >> (i)) & 1) && p.ph_lo <= (i) && (i) < p.ph_hi)
#define SEAM(i) do { if (p.ph_lo <= (i) && (i) + 1 < p.ph_hi) xcd_barrier(xbar); } while (0)
    if (PH(0)) phase_prep(p, shm);
    SEAM(0);
    if (PH(1)) {
        pg8::Gemm g; g.A0 = (const bf16_t*)((unsigned char*)p.out + DO_XN); g.A1 = g.A0; g.B0 = (const bf16_t*)((unsigned char*)p.out + DO_WINT); g.B1 = g.B0;
        g.lda = DM; g.ldb = DM; g.M = S; g.N = NIN; g.K = DM; g.ksplit = DM / 64;
        pg8::StaticOrder so; so.init(g.M, g.N, (int)gridDim.x, (int)blockIdx.x);
        EpiZ e; e.ws = p.ws;
        if (gridDim.x >= 16 && (gridDim.x & 15) == 0) { if ((blockIdx.x >> 3) & 1) prep_small_weights(p, shm, (int)((blockIdx.x >> 4) * 8 + (blockIdx.x & 7)), (int)(gridDim.x / 2)); }
        else prep_small_weights(p, shm, (int)blockIdx.x, (int)gridDim.x);
        pg8::gemm_phase<EpiZ>((LAS unsigned char*)shm, g, so, e);
    }
    SEAM(1);
#if PROBE_SPLIT
    if (PH(2)) phase_lru(p, shm);
    if (p.ph_lo == 8) phase_att(p, shm);
#else
    if (PH(2)) phase_mixers(p, shm);
#endif
    SEAM(2);
    if (PH(3)) phase_carry(p);
    SEAM(3);
    if (PH(4)) phase_fixup(p);
    SEAM(4);
    if (PH(5)) {
        pg8::Gemm g; g.A0 = (const bf16_t*)(p.ws + WS_ZG); g.A1 = (const bf16_t*)(p.ws + WS_YB) - 2048; g.B0 = (const bf16_t*)(p.ws + WS_WAT); g.B1 = (const bf16_t*)(p.ws + WS_WBT) - 2048;
        g.lda = DM; g.ldb = DM; g.M = S; g.N = DM; g.K = 2 * DM; g.ksplit = DM / 64;
        pg8::StaticOrder so; so.init(g.M, g.N, (int)gridDim.x, (int)blockIdx.x);
        EpiMergeMid e; e.ws = p.ws;
        pg8::gemm_phase<EpiMergeMid>((LAS unsigned char*)shm, g, so, e);
    }
    SEAM(5);
    if (PH(6)) {
        pg8::Gemm g; g.A0 = (const bf16_t*)(p.ws + WS_MRG); g.A1 = g.A0; g.B0 = (const bf16_t*)(p.ws + WS_WOT); g.B1 = g.B0;
        g.lda = DM; g.ldb = DM; g.M = S; g.N = DM; g.K = DM; g.ksplit = DM / 64;
        pg8::StaticOrder so; so.init(g.M, g.N, (int)gridDim.x, (int)blockIdx.x);
        EpiOut e; e.ws = p.ws;
        pg8::gemm_phase<EpiOut>((LAS unsigned char*)shm, g, so, e);
    }
    SEAM(6);
    if (PH(7)) phase_final(p);
}

extern "C" void kernel_launch(void* const* d_in, const int* in_sizes, int n_in, void* d_out, int out_size, void* d_ws, size_t ws_size, hipStream_t stream) {
    static int grid = 0;
    if (grid == 0) {
        if (n_in != 15 || in_sizes[0] != S * DM || out_size != S * DM || ws_size < WS_END) {
            fprintf(stderr, "kernel_launch: unexpected shapes (n_in %d, in0 %d, out %d, ws %zu; need ws >= %zu)\n", n_in, n_in > 0 ? in_sizes[0] : -1, out_size, ws_size, (size_t)WS_END); grid = -1; return; }
        int dev = 0, cus = 0, per_cu = 0;
        (void)hipGetDevice(&dev); (void)hipDeviceGetAttribute(&cus, hipDeviceAttributeMultiprocessorCount, dev);
        if (hipFuncSetAttribute((const void*)mega, hipFuncAttributeMaxDynamicSharedMemorySize, LDS_BYTES) != hipSuccess) { fprintf(stderr, "kernel_launch: hipFuncSetAttribute failed\n"); grid = -1; return; }
        if (hipOccupancyMaxActiveBlocksPerMultiprocessor(&per_cu, (const void*)mega, 512, LDS_BYTES) != hipSuccess || per_cu < 1) { fprintf(stderr, "kernel_launch: occupancy query gave %d\n", per_cu); per_cu = 1; }
        (void)hipGetLastError();
        grid = cus * per_cu;
    }
    if (grid < 0) return;
    Params p{};
    for (int i = 0; i < 15; ++i) p.in[i] = (const float*)d_in[i];
    p.out = (float*)d_out; p.ws = (unsigned char*)d_ws;
    for (int j = 0; j < 16; ++j) p.inv_freq[j] = (float)pow(500000.0, -(double)j / 16.0);
    p.mix_mask = 3;
#if MK_SINGLE
    p.ph_lo = 0; p.ph_hi = 8;
    if (hipMemsetAsync((unsigned char*)d_ws + WS_BAR, 0, XCD_BAR_WORDS * sizeof(unsigned), stream) != hipSuccess) { fprintf(stderr, "kernel_launch: memset of barrier words failed\n"); return; }
    void* args[] = {&p};
    hipError_t e = hipLaunchCooperativeKernel((const void*)mega, dim3(grid), dim3(512), args, LDS_BYTES, stream);
    if (e != hipSuccess) fprintf(stderr, "kernel_launch: cooperative launch failed: %s (grid %d)\n", hipGetErrorString(e), grid);
#else
#ifndef REPMASK
#define REPMASK 0
#endif
#ifndef HALFMASK
#define HALFMASK 0
#endif
    static const int lph[9] = {0, 1, 2, 2, 3, 4, 5, 6, 7}; static const int lmix[9] = {3, 3, 1, 2, 3, 3, 3, 3, 3};
    for (int li = 0; li < 9; ++li) {
        p.ph_lo = lph[li]; p.ph_hi = lph[li] + 1; p.mix_mask = lmix[li];
#ifndef REPMASK
#define REPMASK 0
#endif
        for (int rep = 0; rep < (((REPMASK >> li) & 1) ? 2 : 1); ++rep)
        hipLaunchKernelGGL(mega, dim3(((HALFMASK >> li) & 1) ? grid / 2 : grid), dim3(512), LDS_BYTES, stream, p);
    }
#endif
}
```

```cpp
#include <hip/hip_runtime.h>
#include <hip/hip_cooperative_groups.h>
#include <cstdio>
#include <cstdint>
#include <cmath>
namespace cg = cooperative_groups;

#ifndef MK_SINGLE
#define MK_SINGLE 1
#endif

#define LAS __attribute__((address_space(3)))
#define DI __device__ __forceinline__
typedef unsigned short bf16_t;
typedef short bf16x8 __attribute__((ext_vector_type(8)));
typedef short s16x4 __attribute__((ext_vector_type(4)));
typedef float f32x2 __attribute__((ext_vector_type(2)));
typedef float f32x4 __attribute__((ext_vector_type(4)));
typedef float f32x16 __attribute__((ext_vector_type(16)));
typedef unsigned u32x2 __attribute__((ext_vector_type(2)));
typedef unsigned u32x4 __attribute__((ext_vector_type(4)));

constexpr int S = 16384, DM = 2048, NIN = 13312;
constexpr float EPS = 1e-6f;
constexpr float LOG2E = 1.4426950408889634f;
constexpr size_t MiB = (size_t)1 << 20;
constexpr size_t WS_ZU = 0, WS_MERGED = 0;
constexpr size_t WS_ZG = 64 * MiB;
constexpr size_t WS_ZQKV = 128 * MiB;
constexpr size_t WS_ZGA = 224 * MiB;
constexpr size_t WS_ZM = 288 * MiB, WS_OUT2 = 288 * MiB;
constexpr size_t WS_WAT = 416 * MiB, WS_WBT = 424 * MiB, WS_WOT = 432 * MiB;
constexpr size_t WS_ROPE = 440 * MiB;
constexpr size_t WS_AGG = 442 * MiB;
constexpr size_t WS_SSQ = 446 * MiB;
constexpr size_t WS_LWT = 448 * MiB;
constexpr size_t WS_CAR = 450 * MiB;
constexpr size_t WS_BAR = 452 * MiB;
constexpr size_t WS_END = 453 * MiB;
constexpr size_t DO_XN = 0, DO_WINT = 64 * MiB;
constexpr size_t DO_ACF = 0, DO_ACB = 64 * MiB;
#ifndef PROBE_SPLIT
#define PROBE_SPLIT 0
#endif
constexpr size_t WS_YB = PROBE_SPLIT ? WS_ZU : WS_ZGA;
constexpr size_t WS_MRG = PROBE_SPLIT ? WS_ZQKV : WS_MERGED;
constexpr int LDS_BAR_ST = 137216;
constexpr int LDS_BYTES = 137232;

struct Params {
    const float* in[15];
    float* out; unsigned char* ws;
    float inv_freq[16];
    int ph_lo, ph_hi, mix_mask, pad_;
};

DI unsigned cvtpk(float lo, float hi) { unsigned r; asm volatile("v_cvt_pk_bf16_f32 %0, %1, %2" : "=v"(r) : "v"(lo), "v"(hi)); return r; }
DI float bf2f(unsigned short b) { return __uint_as_float(((unsigned)b) << 16); }
DI float bflo(unsigned w) { return __uint_as_float(w << 16); }
DI float bfhi(unsigned w) { return __uint_as_float(w & 0xffff0000u); }
DI unsigned short f2bf(float f) { return (unsigned short)(cvtpk(f, f) & 0xffffu); }
DI float ex2(float x) { return __builtin_amdgcn_exp2f(x); }
DI float rcpf_(float x) { return __builtin_amdgcn_rcpf(x); }
DI float sigm(float x) { return rcpf_(1.f + ex2(-x * LOG2E)); }
DI float wave_sum(float v) {
#pragma unroll
    for (int o = 32; o >= 1; o >>= 1) v += __shfl_xor(v, o);
    return v;
}

namespace pg8 {
constexpr int BM = 256, BK = 64, HALF = 128, HTB = HALF * BK * 2, STAGE_BYTES = 8 * HTB, NXCD = 8, WGM = 8;
DI int lds_byte(int r, int c) { const int st = (r >> 4) * 2 + (c >> 5), rr = r & 15, cc = c & 31, ob = rr * 64 + cc * 2; return st * 1024 + (ob ^ (((ob >> 9) & 1) << 5)); }
DI void stage_rc(int b, int& R, int& C) { const int st = b / 1024, sb = b % 1024, swz = sb ^ (((sb >> 9) & 1) << 5); R = (st >> 1) * 16 + swz / 64; C = (st & 1) * 32 + (swz % 64) / 2; }
DI int perm32(int rho) { const int n = rho >> 4, i = rho & 15; return 8 * (i >> 2) + 4 * n + (i & 3); }
struct Unit { int pm, pn; };
struct Gemm { const bf16_t* A0; const bf16_t* A1; const bf16_t* B0; const bf16_t* B1; int lda, ldb, M, N, K, ksplit; };
struct StaticOrder {
    int nM, nN, nwg, G, c;
    DI void init(int M, int N, int G_, int c_) { nM = M / BM; nN = N / BM; nwg = nM * nN; G = G_; c = c_; }
    DI bool next(int i, Unit& u) const {
        const long L = (long)i * G + c; if (L >= nwg) return false;
        int wgid = (int)L; { const int q = nwg / NXCD, r = nwg % NXCD, xcd = wgid % NXCD, off = wgid / NXCD; wgid = (xcd < r ? xcd * (q + 1) : r * (q + 1) + (xcd - r) * q) + off; }
        const int nig = WGM * nN, gid = wgid / nig, fm = gid * WGM, gsz = (nM - fm) < WGM ? (nM - fm) : WGM;
        u.pm = fm + ((wgid % nig) % gsz); u.pn = (wgid % nig) / gsz; return true;
    }
};

template <class Epi>
DI void gemm_phase(LAS unsigned char* lds, const Gemm g, const StaticOrder& S_, const Epi& E) {
    const int tid = threadIdx.x, wid = __builtin_amdgcn_readfirstlane(tid >> 6), lane = tid & 63, wr = wid >> 2, wc = wid & 3, fr = lane & 15, fq = lane >> 4;
    const int K = g.K, nt = K / BK, ksplit = g.ksplit;
    unsigned voffA[2], voffB[2];
#pragma unroll
    for (int i = 0; i < 2; ++i) { int R, C; stage_rc(tid * 16 + i * 8192, R, C); const int Rb = Epi::PERM ? ((R & ~31) + perm32(R & 31)) : R;
        voffA[i] = (unsigned)(R * g.lda + C) * 2u; voffB[i] = (unsigned)(Rb * g.ldb + C) * 2u; }
    const size_t kstep = (size_t)(BK * 2);
    const size_t hstepA = (size_t)HALF * g.lda * 2, hstepB = (size_t)HALF * g.ldb * 2;
    const size_t tstepA = 2 * hstepA, tstepB = 2 * hstepB;
    const unsigned ldsw = (unsigned)wid * 1024u;
    const int aoff = lds_byte(wr * 64 + fr, fq * 8), boff = lds_byte(wc * 32 + fr, fq * 8);
#define PG8_SA(b, h) (((b) * 2 + (h)) * HTB)
#define PG8_SB(b, h) ((4 + (b) * 2 + (h)) * HTB)
#define PG8_STAGE(bufoff, gbase, voff) do { _Pragma("unroll") for (int _i = 0; _i < 2; ++_i) \
        __builtin_amdgcn_global_load_lds((const unsigned*)((const char*)(gbase) + (voff)[_i]), (LAS unsigned*)(lds + (bufoff) + ldsw + _i * 8192), 16, 0, 0); } while (0)
#define PG8_LDA(dst, b, h) do { _Pragma("unroll") for (int m = 0; m < 4; ++m) _Pragma("unroll") for (int k = 0; k < 2; ++k) dst[m][k] = *(const LAS bf16x8*)(lds + PG8_SA(b, h) + aoff + m * 2048 + k * 1024); } while (0)
#define PG8_LDB(dst, b, h) do { _Pragma("unroll") for (int n = 0; n < 2; ++n) _Pragma("unroll") for (int k = 0; k < 2; ++k) dst[n][k] = *(const LAS bf16x8*)(lds + PG8_SB(b, h) + boff + n * 2048 + k * 1024); } while (0)
#define PG8_MMA(ai, bj, At, Bt) do { __builtin_amdgcn_s_setprio(1); _Pragma("unroll") for (int m = 0; m < 4; ++m) _Pragma("unroll") for (int n = 0; n < 2; ++n) _Pragma("unroll") for (int k = 0; k < 2; ++k) \
        acc[ai][bj][m][n] = __builtin_amdgcn_mfma_f32_16x16x32_bf16(Bt[n][k], At[m][k], acc[ai][bj][m][n], 0, 0, 0); __builtin_amdgcn_s_setprio(0); } while (0)
#define PG8_WAIT_V(n) asm volatile("s_waitcnt vmcnt(" #n ")" ::: "memory")
#define PG8_WAIT_L(n) asm volatile("s_waitcnt lgkmcnt(" #n ")" ::: "memory")
#define PG8_BAR __builtin_amdgcn_s_barrier()
#define PG8_SCHED __builtin_amdgcn_sched_barrier(0)
    Unit cur, nxt; int ui = 0;
    if (!S_.next(0, cur)) return;
    f32x4 acc[2][2][4][2];
#pragma unroll
    for (int a = 0; a < 2; ++a)
#pragma unroll
        for (int b = 0; b < 2; ++b)
#pragma unroll
            for (int m = 0; m < 4; ++m)
#pragma unroll
                for (int n = 0; n < 2; ++n) acc[a][b][m][n] = (f32x4){0.f, 0.f, 0.f, 0.f};
    bf16x8 At[4][2], B0[2][2], B1[2][2];
    const char* cA0 = (const char*)g.A0 + (size_t)cur.pm * tstepA; const char* cA1 = (const char*)g.A1 + (size_t)cur.pm * tstepA;
    const char* cB0 = (const char*)g.B0 + (size_t)cur.pn * tstepB; const char* cB1 = (const char*)g.B1 + (size_t)cur.pn * tstepB;
    PG8_STAGE(PG8_SB(0, 0), cB0, voffB); PG8_STAGE(PG8_SA(0, 0), cA0, voffA); PG8_STAGE(PG8_SB(0, 1), cB0 + hstepB, voffB); PG8_STAGE(PG8_SA(0, 1), cA0 + hstepA, voffA);
    if (wr == 1) PG8_BAR;
    PG8_WAIT_V(4); PG8_BAR;
    PG8_STAGE(PG8_SB(1, 0), cB0 + kstep, voffB); PG8_STAGE(PG8_SA(1, 0), cA0 + kstep, voffA); PG8_STAGE(PG8_SB(1, 1), cB0 + hstepB + kstep, voffB);
    PG8_WAIT_V(6); PG8_BAR;
    for (;;) {
        const bool has_next = S_.next(ui + 1, nxt);
        const char* nA0 = has_next ? (const char*)g.A0 + (size_t)nxt.pm * tstepA : cA0; const char* nB0 = has_next ? (const char*)g.B0 + (size_t)nxt.pn * tstepB : cB0;
        for (int hf = 0; hf < (Epi::MID ? 2 : 1); ++hf) {
        const int tb = Epi::MID ? hf * ksplit : 0, te = Epi::MID ? (hf + 1) * ksplit : nt;
        for (int t = tb; t < te; t += 2) {
            const bool last = (t == nt - 2);
            const bool hA = (t >= ksplit), hB = (t + 2 >= ksplit);
            const char* a1 = (hA ? cA1 : cA0) + (size_t)(t + 1) * kstep;
            const char* a2 = last ? nA0 : (hB ? cA1 : cA0) + (size_t)(t + 2) * kstep; const char* b2 = last ? nB0 : (hB ? cB1 : cB0) + (size_t)(t + 2) * kstep;
            const char* a3 = a2 + kstep; const char* b3 = b2 + kstep;
            PG8_LDB(B0, 0, 0); PG8_SCHED; PG8_LDA(At, 0, 0); PG8_STAGE(PG8_SA(1, 1), a1 + hstepA, voffA);
            PG8_WAIT_L(8); PG8_BAR; PG8_WAIT_L(0); PG8_MMA(0, 0, At, B0); PG8_BAR; PG8_SCHED;
            PG8_LDB(B1, 0, 1); PG8_STAGE(PG8_SB(0, 0), b2, voffB);
            PG8_BAR; PG8_WAIT_L(0); PG8_MMA(0, 1, At, B1); PG8_BAR;
            PG8_LDA(At, 0, 1); PG8_STAGE(PG8_SA(0, 0), a2, voffA);
            PG8_BAR; PG8_WAIT_L(0); PG8_MMA(1, 0, At, B0); PG8_BAR; PG8_SCHED;
            PG8_STAGE(PG8_SB(0, 1), b2 + hstepB, voffB);
            PG8_WAIT_V(6); PG8_BAR; PG8_MMA(1, 1, At, B1); PG8_BAR;
            PG8_LDB(B0, 1, 0); PG8_SCHED; PG8_LDA(At, 1, 0); PG8_STAGE(PG8_SA(0, 1), a2 + hstepA, voffA);
            PG8_WAIT_L(8); PG8_BAR; PG8_WAIT_L(0); PG8_MMA(0, 0, At, B0); PG8_BAR; PG8_SCHED;
            PG8_LDB(B1, 1, 1); PG8_STAGE(PG8_SB(1, 0), b3, voffB);
            PG8_BAR; PG8_WAIT_L(0); PG8_MMA(0, 1, At, B1); PG8_BAR;
            PG8_LDA(At, 1, 1); PG8_STAGE(PG8_SA(1, 0), a3, voffA);
            PG8_BAR; PG8_WAIT_L(0); PG8_MMA(1, 0, At, B0); PG8_BAR; PG8_SCHED;
            PG8_STAGE(PG8_SB(1, 1), b3 + hstepB, voffB);
            PG8_WAIT_V(6); PG8_BAR; PG8_MMA(1, 1, At, B1); PG8_BAR;
        }
        if constexpr (Epi::MID) { if (hf == 0) E.mid(acc, cur, wr, wc, fr, fq); }
        }
        E(acc, cur, wr, wc, fr, fq);
        if (!has_next) break;
#pragma unroll
        for (int a = 0; a < 2; ++a)
#pragma unroll
            for (int b = 0; b < 2; ++b)
#pragma unroll
                for (int m = 0; m < 4; ++m)
#pragma unroll
                    for (int n = 0; n < 2; ++n) acc[a][b][m][n] = (f32x4){0.f, 0.f, 0.f, 0.f};
        cur = nxt; ++ui;
        cA0 = (const char*)g.A0 + (size_t)cur.pm * tstepA; cA1 = (const char*)g.A1 + (size_t)cur.pm * tstepA;
        cB0 = (const char*)g.B0 + (size_t)cur.pn * tstepB; cB1 = (const char*)g.B1 + (size_t)cur.pn * tstepB;
    }
    PG8_WAIT_V(0);
    if (wr == 0) PG8_BAR;
    PG8_BAR;
#undef PG8_SA
#undef PG8_SB
#undef PG8_STAGE
#undef PG8_LDA
#undef PG8_LDB
#undef PG8_MMA
#undef PG8_WAIT_V
#undef PG8_WAIT_L
#undef PG8_BAR
#undef PG8_SCHED
}
}

struct EpiZ {
    static constexpr bool PERM = true, MID = false;
    unsigned char* ws;
    DI void operator()(const f32x4 (&acc)[2][2][4][2], const pg8::Unit& u, int wr, int wc, int fr, int fq) const {
        const int pn = u.pn; bf16_t* base; int ld, colt;
        if (pn < 8) { base = (bf16_t*)(ws + WS_ZU) + (size_t)pn * S * 256; ld = 256; colt = 0; }
        else if (pn < 16) { base = (bf16_t*)(ws + WS_ZG); ld = 2048; colt = (pn - 8) * 256; }
        else if (pn < 28) { base = (bf16_t*)(ws + WS_ZQKV); ld = 3072; colt = (pn - 16) * 256; }
        else if (pn < 36) { base = (bf16_t*)(ws + WS_ZGA); ld = 2048; colt = (pn - 28) * 256; }
        else { base = (bf16_t*)(ws + WS_ZM) + (size_t)(pn - 36) * S * 256; ld = 256; colt = 0; }
        const bool rope = (pn >= 16 && pn < 26 && wc == 0);
        const int row0 = u.pm * 256 + wr * 64 + fr, col0 = colt + wc * 32 + 8 * fq;
        if (rope) {
            const float* cosT = (const float*)(ws + WS_ROPE) + (size_t)row0 * 16 + 4 * fq; const float* sinT = cosT + (size_t)S * 16;
            f32x4 cs[8], sn[8];
#pragma unroll
            for (int k = 0; k < 8; ++k) { cs[k] = *(const f32x4*)(cosT + ((k >> 2) * 128 + (k & 3) * 16) * 16); sn[k] = *(const f32x4*)(sinT + ((k >> 2) * 128 + (k & 3) * 16) * 16); }
#pragma unroll
            for (int ai = 0; ai < 2; ++ai)
#pragma unroll
                for (int m = 0; m < 4; ++m) {
                    const int row = row0 + ai * 128 + m * 16; const f32x4 c4 = cs[ai * 4 + m], s4 = sn[ai * 4 + m];
#pragma unroll
                    for (int bj = 0; bj < 2; ++bj) {
                        const f32x4 v0 = acc[ai][bj][m][0], v1 = acc[ai][bj][m][1]; f32x4 w0, w1;
                        w0[0] = v0[0] * c4[0] - v0[1] * s4[0]; w0[1] = v0[1] * c4[0] + v0[0] * s4[0];
                        w0[2] = v0[2] * c4[1] - v0[3] * s4[1]; w0[3] = v0[3] * c4[1] + v0[2] * s4[1];
                        w1[0] = v1[0] * c4[2] - v1[1] * s4[2]; w1[1] = v1[1] * c4[2] + v1[0] * s4[2];
                        w1[2] = v1[2] * c4[3] - v1[3] * s4[3]; w1[3] = v1[3] * c4[3] + v1[2] * s4[3];
                        u32x4 w = {cvtpk(w0[0], w0[1]), cvtpk(w0[2], w0[3]), cvtpk(w1[0], w1[1]), cvtpk(w1[2], w1[3])};
                        __builtin_nontemporal_store(w, (u32x4*)(base + (size_t)row * ld + col0 + bj * 128));
                    }
                }
        } else if (pn >= 36) {
            unsigned char* gb = ws + WS_ZM + (size_t)(pn - 36) * S * 256 + (size_t)row0 * 256 + wc * 32 + 8 * fq;
#pragma unroll
            for (int ai = 0; ai < 2; ++ai)
#pragma unroll
                for (int m = 0; m < 4; ++m)
#pragma unroll
                    for (int bj = 0; bj < 2; ++bj) {
                        const f32x4 v0 = acc[ai][bj][m][0], v1 = acc[ai][bj][m][1]; unsigned q[8];
#pragma unroll
                        for (int i = 0; i < 4; ++i) { q[i] = (unsigned)fmaxf(sigm(v0[i]) * 255.f + 0.5f, 1.f); q[4 + i] = (unsigned)fmaxf(sigm(v1[i]) * 255.f + 0.5f, 1.f); }
                        const u32x2 w = {q[0] | (q[1] << 8) | (q[2] << 16) | (q[3] << 24), q[4] | (q[5] << 8) | (q[6] << 16) | (q[7] << 24)};
                        __builtin_nontemporal_store(w, (u32x2*)(gb + (size_t)(ai * 128 + m * 16) * 256 + bj * 128));
                    }
        } else {
#pragma unroll
            for (int ai = 0; ai < 2; ++ai)
#pragma unroll
                for (int m = 0; m < 4; ++m) {
                    const int row = row0 + ai * 128 + m * 16;
#pragma unroll
                    for (int bj = 0; bj < 2; ++bj) {
                        const f32x4 v0 = acc[ai][bj][m][0], v1 = acc[ai][bj][m][1];
                        u32x4 w = {cvtpk(v0[0], v0[1]), cvtpk(v0[2], v0[3]), cvtpk(v1[0], v1[1]), cvtpk(v1[2], v1[3])};
                        __builtin_nontemporal_store(w, (u32x4*)(base + (size_t)row * ld + col0 + bj * 128));
                    }
                }
        }
    }
};
DI u32x4 ldg128(const void* base, unsigned boff) { return *(const u32x4*)((const char*)base + boff); }
DI void stg128(void* base, unsigned boff, u32x4 v) { *(u32x4*)((char*)base + boff) = v; }
template <int STEP> struct EpiMerge {
    static constexpr bool PERM = true, MID = false;
    unsigned char* ws; unsigned char* tbuf;
    DI void operator()(const f32x4 (&acc)[2][2][4][2], const pg8::Unit& u, int wr, int wc, int fr, int fq) const {
        const unsigned char* zm = ws + WS_ZM; unsigned char* mg = ws + WS_MRG;
        const unsigned r0_ = (unsigned)(u.pm * 256 + wr * 64 + fr), c0_ = (unsigned)(u.pn * 256 + wc * 32 + 8 * fq);
#pragma unroll
        for (int ai = 0; ai < 2; ++ai)
#pragma unroll
            for (int m = 0; m < 4; ++m) {
                const unsigned row = r0_ + ai * 128 + m * 16;
#pragma unroll
                for (int bj = 0; bj < 2; ++bj) {
                    const unsigned col = c0_ + bj * 128;
                    const u32x4 g = ldg128(zm, row * 8192u + (STEP ? 4096u : 0u) + col * 2u);
                    float v[8];
#pragma unroll
                    for (int i = 0; i < 4; ++i) {
                        v[2 * i] = acc[ai][bj][m][i >> 1][(i & 1) * 2] * sigm(bflo(g[i]));
                        v[2 * i + 1] = acc[ai][bj][m][i >> 1][(i & 1) * 2 + 1] * sigm(bfhi(g[i]));
                    }
                    const unsigned tb = row * 8192u + col * 4u;
                    if (STEP == 0) {
                        stg128(tbuf, tb, __builtin_bit_cast(u32x4, (f32x4){v[0], v[1], v[2], v[3]}));
                        stg128(tbuf, tb + 16u, __builtin_bit_cast(u32x4, (f32x4){v[4], v[5], v[6], v[7]}));
                    } else {
                        const f32x4 t0 = __builtin_bit_cast(f32x4, ldg128(tbuf, tb)), t1 = __builtin_bit_cast(f32x4, ldg128(tbuf, tb + 16u));
                        u32x4 w = {cvtpk(v[0] + t0[0], v[1] + t0[1]), cvtpk(v[2] + t0[2], v[3] + t0[3]), cvtpk(v[4] + t1[0], v[5] + t1[1]), cvtpk(v[6] + t1[2], v[7] + t1[3])};
                        stg128(mg, row * 4096u + col * 2u, w);
                    }
                }
                asm volatile("" ::: "memory");
            }
    }
};

DI float ub(unsigned w, int i) { return (float)((w >> (8 * i)) & 0xffu); }
struct EpiMergeMid {
    static constexpr bool PERM = true, MID = true;
    unsigned char* ws;
    DI void mid(f32x4 (&acc)[2][2][4][2], const pg8::Unit& u, int wr, int wc, int fr, int fq) const {
        const unsigned char* zm = ws + WS_ZM;
        unsigned b0_ = (unsigned)u.pn * (unsigned)(S * 256) + (unsigned)(u.pm * 256 + wr * 64 + fr) * 256u + (unsigned)(wc * 32 + 8 * fq);
        asm volatile("" : "+v"(b0_));
        u32x2 g1[2][4][2], g2[2][4][2];
#pragma unroll
        for (int ai = 0; ai < 2; ++ai)
#pragma unroll
            for (int m = 0; m < 4; ++m)
#pragma unroll
                for (int bj = 0; bj < 2; ++bj) { const unsigned bo = b0_ + (unsigned)(ai * 128 + m * 16) * 256u + bj * 128u;
                    g1[ai][m][bj] = *(const u32x2*)(zm + bo); g2[ai][m][bj] = *(const u32x2*)(zm + bo + (unsigned)(8 * S * 256)); }
#pragma unroll
        for (int ai = 0; ai < 2; ++ai)
#pragma unroll
            for (int m = 0; m < 4; ++m)
#pragma unroll
                for (int bj = 0; bj < 2; ++bj)
#pragma unroll
                    for (int e = 0; e < 8; ++e)
                        acc[ai][bj][m][e >> 2][e & 3] *= ub(g1[ai][m][bj][e >> 2], e & 3) * rcpf_(ub(g2[ai][m][bj][e >> 2], e & 3));
    }
    DI void operator()(const f32x4 (&acc)[2][2][4][2], const pg8::Unit& u, int wr, int wc, int fr, int fq) const {
        const unsigned char* zm = ws + WS_ZM; unsigned char* mg = ws + WS_MRG;
        unsigned r0_ = (unsigned)(u.pm * 256 + wr * 64 + fr), c0_ = (unsigned)(wc * 32 + 8 * fq);
        asm volatile("" : "+v"(r0_), "+v"(c0_));
        u32x2 g2[2][4][2];
#pragma unroll
        for (int ai = 0; ai < 2; ++ai)
#pragma unroll
            for (int m = 0; m < 4; ++m)
#pragma unroll
                for (int bj = 0; bj < 2; ++bj) g2[ai][m][bj] = *(const u32x2*)(zm + (unsigned)(8 + u.pn) * (unsigned)(S * 256) + (r0_ + ai * 128 + m * 16) * 256u + c0_ + bj * 128u);
#pragma unroll
        for (int ai = 0; ai < 2; ++ai)
#pragma unroll
            for (int m = 0; m < 4; ++m) {
                const unsigned row = r0_ + ai * 128 + m * 16;
#pragma unroll
                for (int bj = 0; bj < 2; ++bj) {
                    float v[8];
#pragma unroll
                    for (int e = 0; e < 8; ++e) v[e] = acc[ai][bj][m][e >> 2][e & 3] * (ub(g2[ai][m][bj][e >> 2], e & 3) * (1.f / 255.f));
                    u32x4 w = {cvtpk(v[0], v[1]), cvtpk(v[2], v[3]), cvtpk(v[4], v[5]), cvtpk(v[6], v[7])};
                    stg128(mg, row * 4096u + ((unsigned)u.pn * 256u + c0_) * 2u + bj * 256u, w);
                }
            }
    }
};
struct EpiOut {
    static constexpr bool PERM = true, MID = false;
    unsigned char* ws;
    DI void operator()(const f32x4 (&acc)[2][2][4][2], const pg8::Unit& u, int wr, int wc, int fr, int fq) const {
        unsigned char* o2 = ws + WS_OUT2; float* ssq = (float*)(ws + WS_SSQ);
        const unsigned r0_ = (unsigned)(u.pm * 256 + wr * 64 + fr), c0_ = (unsigned)(u.pn * 256 + wc * 32 + 8 * fq) * 2u;
#pragma unroll
        for (int ai = 0; ai < 2; ++ai)
#pragma unroll
            for (int m = 0; m < 4; ++m) {
                const unsigned row = r0_ + ai * 128 + m * 16; float s = 0.f;
#pragma unroll
                for (int bj = 0; bj < 2; ++bj) {
                    const f32x4 v0 = acc[ai][bj][m][0], v1 = acc[ai][bj][m][1];
                    s += v0[0] * v0[0] + v0[1] * v0[1] + v0[2] * v0[2] + v0[3] * v0[3] + v1[0] * v1[0] + v1[1] * v1[1] + v1[2] * v1[2] + v1[3] * v1[3];
                    u32x4 w = {cvtpk(v0[0], v0[1]), cvtpk(v0[2], v0[3]), cvtpk(v1[0], v1[1]), cvtpk(v1[2], v1[3])};
                    stg128(o2, row * 4096u + c0_ + bj * 256u, w);
                }
                s += __shfl_xor(s, 16); s += __shfl_xor(s, 32);
                if (fq == 0) ssq[(size_t)row * 32 + u.pn * 4 + wc] = s;
            }
    }
};

struct TJob { const float* src; bf16_t* dst; int ld_src, ld_dst, k0, n0, perm, pad_; };
DI void tr_load(const TJob& j, f32x4& v0, f32x4& v1) {
    const int t = threadIdx.x, kl = t >> 4, nl = (t & 15) * 4;
    v0 = *(const f32x4*)(j.src + (size_t)(j.k0 + kl) * j.ld_src + j.n0 + nl);
    v1 = *(const f32x4*)(j.src + (size_t)(j.k0 + kl + 32) * j.ld_src + j.n0 + nl);
}
DI void tr_store(const TJob& j, const f32x4 v0, const f32x4 v1, float* sT) {
    const int t = threadIdx.x;
    { const int kl = t >> 4, nl = (t & 15) * 4;
      sT[kl * 65 + nl] = v0[0]; sT[kl * 65 + nl + 1] = v0[1]; sT[kl * 65 + nl + 2] = v0[2]; sT[kl * 65 + nl + 3] = v0[3];
      sT[(kl + 32) * 65 + nl] = v1[0]; sT[(kl + 32) * 65 + nl + 1] = v1[1]; sT[(kl + 32) * 65 + nl + 2] = v1[2]; sT[(kl + 32) * 65 + nl + 3] = v1[3]; }
    __syncthreads();
    { const int nl = t >> 3, kc = (t & 7) * 8; int ns = nl;
      if (j.perm && nl < 32) ns = (nl & 1) ? 16 + (nl >> 1) : (nl >> 1);
      float q[8];
#pragma unroll
      for (int i = 0; i < 8; ++i) q[i] = sT[(kc + i) * 65 + ns];
      u32x4 w = {cvtpk(q[0], q[1]), cvtpk(q[2], q[3]), cvtpk(q[4], q[5]), cvtpk(q[6], q[7])};
      *(u32x4*)(j.dst + (size_t)(j.n0 + nl) * j.ld_dst + j.k0 + kc) = w; }
    __syncthreads();
}
DI TJob win_job(const Params& p, int j) {
    TJob r; const int nt = j >> 5, kt = j & 31, n0 = nt * 64;
    r.src = p.in[2]; r.dst = (bf16_t*)((unsigned char*)p.out + DO_WINT); r.ld_src = NIN; r.ld_dst = DM; r.k0 = kt * 64; r.n0 = n0;
    r.perm = (n0 >= 4096 && n0 < 6656 && (n0 & 127) == 0) ? 1 : 0; r.pad_ = 0; return r;
}
DI TJob small_job(const Params& p, int j) {
    TJob r; constexpr int J_SQ = 32 * 32;
    if (j < 3 * J_SQ) { const int which = j >> 10, q = j & 1023, nt = q >> 5, kt = q & 31;
        r.src = p.in[11 + which]; r.dst = (bf16_t*)(p.ws + (which == 0 ? WS_WAT : which == 1 ? WS_WBT : WS_WOT)); r.ld_src = DM; r.ld_dst = DM; r.k0 = kt * 64; r.n0 = nt * 64; }
    else { const int jj = j - 3 * J_SQ, gate = jj >> 7, q = jj & 127, blk = q >> 2, sub = q & 3, d = blk >> 4, nb = blk & 15;
        r.src = p.in[gate == 0 ? 5 : 7] + (size_t)blk * 16384; r.dst = (bf16_t*)(p.ws + WS_LWT) + (size_t)((d * 2 + gate) * 16 + nb) * 16384;
        r.ld_src = 128; r.ld_dst = 128; r.k0 = (sub >> 1) * 64; r.n0 = (sub & 1) * 64; }
    r.perm = 0; r.pad_ = 0; return r;
}
DI void phase_prep(const Params& p, unsigned char* shm) {
    const int tid = threadIdx.x, wid = tid >> 6, lane = tid & 63;
    bf16_t* xn = (bf16_t*)((unsigned char*)p.out + DO_XN);
    {
        const float* x = p.in[0]; const float* nw = p.in[1];
        f32x4 w[8];
#pragma unroll
        for (int i = 0; i < 8; ++i) w[i] = *(const f32x4*)(nw + i * 256 + lane * 4);
        for (int row = (blockIdx.x * 8 + wid) * 2; row < S; row += gridDim.x * 16) {
            f32x4 v[2][8];
#pragma unroll
            for (int r = 0; r < 2; ++r)
#pragma unroll
                for (int i = 0; i < 8; ++i) v[r][i] = __builtin_nontemporal_load((const f32x4*)(x + (size_t)(row + r) * DM + i * 256 + lane * 4));
#pragma unroll
            for (int r = 0; r < 2; ++r) {
                float ss = 0.f;
#pragma unroll
                for (int i = 0; i < 8; ++i) ss += v[r][i][0] * v[r][i][0] + v[r][i][1] * v[r][i][1] + v[r][i][2] * v[r][i][2] + v[r][i][3] * v[r][i][3];
                ss = wave_sum(ss);
                const float rs = rsqrtf(ss * (1.f / DM) + EPS);
#pragma unroll
                for (int i = 0; i < 8; ++i) {
                    u32x2 o = {cvtpk(v[r][i][0] * rs * w[i][0], v[r][i][1] * rs * w[i][1]), cvtpk(v[r][i][2] * rs * w[i][2], v[r][i][3] * rs * w[i][3])};
                    *(u32x2*)(xn + (size_t)(row + r) * DM + i * 256 + lane * 4) = o; }
            }
        }
    }
    {
        float* cosT = (float*)(p.ws + WS_ROPE); float* sinT = cosT + (size_t)S * 16;
        for (int i = blockIdx.x * 512 + tid; i < S * 16; i += gridDim.x * 512) {
            const int pos = i >> 4, j = i & 15;
            const float ang = (float)pos * p.inv_freq[j];
            const double rev = (double)ang * 0.15915494309189535; const float fr = (float)(rev - rint(rev));
            cosT[i] = __builtin_amdgcn_cosf(fr); sinT[i] = __builtin_amdgcn_sinf(fr);
        }
    }
    {
        float* sT = (float*)shm; constexpr int NG = 208 * 8;
        const float* src = p.in[2]; bf16_t* dst = (bf16_t*)((unsigned char*)p.out + DO_WINT);
        const int t = threadIdx.x, kl = t >> 4, nl4 = (t & 15) * 4, onl = t >> 3, okc = (t & 7) * 8;
        int g = blockIdx.x;
        if (g < NG) {
            f32x4 v[8];
#pragma unroll
            for (int q = 0; q < 8; ++q) v[q] = __builtin_nontemporal_load((const f32x4*)(src + (size_t)((g & 7) * 256 + q * 32 + kl) * NIN + (g >> 3) * 64 + nl4));
            for (;;) {
                const int gn = g + (int)gridDim.x; const bool more = gn < NG; const int gl = more ? gn : g;
                f32x4 vn[8];
#pragma unroll
                for (int q = 0; q < 8; ++q) vn[q] = __builtin_nontemporal_load((const f32x4*)(src + (size_t)((gl & 7) * 256 + q * 32 + kl) * NIN + (gl >> 3) * 64 + nl4));
#pragma unroll
                for (int q = 0; q < 8; ++q) { float* d = sT + (q * 32 + kl) * 65 + nl4; d[0] = v[q][0]; d[1] = v[q][1]; d[2] = v[q][2]; d[3] = v[q][3]; }
                __syncthreads();
                { const int n0 = (g >> 3) * 64, k0 = (g & 7) * 256; int ns = onl;
                  if (n0 >= 4096 && n0 < 6656 && (n0 & 127) == 0 && onl < 32) ns = (onl & 1) ? 16 + (onl >> 1) : (onl >> 1);
#pragma unroll
                  for (int q = 0; q < 4; ++q) { float f[8];
#pragma unroll
                      for (int i = 0; i < 8; ++i) f[i] = sT[(q * 64 + okc + i) * 65 + ns];
                      *(u32x4*)(dst + (size_t)(n0 + onl) * DM + k0 + q * 64 + okc) = (u32x4){cvtpk(f[0], f[1]), cvtpk(f[2], f[3]), cvtpk(f[4], f[5]), cvtpk(f[6], f[7])}; } }
                __syncthreads();
                if (!more) break;
#pragma unroll
                for (int q = 0; q < 8; ++q) v[q] = vn[q];
                g = gn;
            }
        }
    }
}
DI void prep_small_weights(const Params& p, unsigned char* shm, int idx, int stride) {
    float* sT = (float*)shm; constexpr int NJ = 3 * 1024 + 256;
    int j = idx;
    if (j < NJ) {
        TJob cur = small_job(p, j); f32x4 v0, v1; tr_load(cur, v0, v1);
        for (;;) {
            const int jn = j + stride; const bool more = jn < NJ;
            const TJob nxt = small_job(p, more ? jn : j); f32x4 n0, n1; tr_load(nxt, n0, n1);
            tr_store(cur, v0, v1, sT);
            if (!more) break;
            cur = nxt; v0 = n0; v1 = n1; j = jn;
        }
    }
}

DI void lru_copy_out(const bf16_t* OS, bf16_t* dst_tile, int t) {
    const int row = t >> 2, seg = (t & 3) * 32;
#pragma unroll
    for (int k = 0; k < 4; ++k) { const u32x4 v = *(const u32x4*)(OS + row * 136 + seg + k * 8); *(u32x4*)(dst_tile + (size_t)row * 2048 + seg + k * 8) = v; }
}
DI void lru_tile(const Params& p, unsigned char* shm, int c, int nb) {
    int tid = threadIdx.x; asm volatile("" : "+v"(tid));
    const int wid = __builtin_amdgcn_readfirstlane(tid >> 6), lane = tid & 63;
    constexpr int LDU = 136;
    bf16_t* UB = (bf16_t*)shm;
    bf16_t* SG = (bf16_t*)(shm + 34816);
    bf16_t* OS = (bf16_t*)(shm + 2 * 34816);
    f32x2* AG = (f32x2*)(shm + 3 * 34816) + wid * 512;
    const bf16_t* ZU = (const bf16_t*)(p.ws + WS_ZU);
    bf16_t* ZGt = (bf16_t*)(p.ws + WS_ZG) + (size_t)c * 128 * 2048 + nb * 128;
    {
        const int cgp = tid & 15, rg = tid >> 4, ch = nb * 128 + cgp * 8;
        const float* cw = p.in[3]; const float* cb = p.in[4];
        float w[4][8], bias[8];
#pragma unroll
        for (int tp = 0; tp < 4; ++tp) { const f32x4 a = *(const f32x4*)(cw + tp * 2048 + ch), b = *(const f32x4*)(cw + tp * 2048 + ch + 4);
            w[tp][0] = a[0]; w[tp][1] = a[1]; w[tp][2] = a[2]; w[tp][3] = a[3]; w[tp][4] = b[0]; w[tp][5] = b[1]; w[tp][6] = b[2]; w[tp][7] = b[3]; }
        { const f32x4 a = *(const f32x4*)(cb + ch), b = *(const f32x4*)(cb + ch + 4);
            bias[0] = a[0]; bias[1] = a[1]; bias[2] = a[2]; bias[3] = a[3]; bias[4] = b[0]; bias[5] = b[1]; bias[6] = b[2]; bias[7] = b[3]; }
        float xr[7][8];
#pragma unroll
        for (int k = 0; k < 7; ++k) { const int t = c * 128 + rg * 4 - 2 + k;
            u32x4 v = {0u, 0u, 0u, 0u};
            if (t >= 0 && t < S) v = *(const u32x4*)(ZU + (size_t)(nb >> 1) * S * 256 + (size_t)t * 256 + (nb & 1) * 128 + cgp * 8);
#pragma unroll
            for (int i = 0; i < 4; ++i) { xr[k][2 * i] = bflo(v[i]); xr[k][2 * i + 1] = bfhi(v[i]); } }
#pragma unroll
        for (int o = 0; o < 4; ++o) { float u8[8];
#pragma unroll
            for (int i = 0; i < 8; ++i) { float a = bias[i];
#pragma unroll
                for (int tp = 0; tp < 4; ++tp) a += xr[o + tp][i] * w[tp][i];
                u8[i] = a; }
            *(u32x4*)(UB + (rg * 4 + o) * LDU + cgp * 8) = (u32x4){cvtpk(u8[0], u8[1]), cvtpk(u8[2], u8[3]), cvtpk(u8[4], u8[5]), cvtpk(u8[6], u8[7])};
        }
        __builtin_amdgcn_sched_barrier(0);
        u32x4 gv[4];
#pragma unroll
        for (int o = 0; o < 4; ++o) gv[o] = __builtin_nontemporal_load((const u32x4*)(ZGt + (size_t)(rg * 4 + o) * 2048 + cgp * 8));
#pragma unroll
        for (int o = 0; o < 4; ++o) {
            float sgl[8];
#pragma unroll
            for (int i = 0; i < 4; ++i) { const float g0 = bflo(gv[o][i]), g1 = bfhi(gv[o][i]); sgl[2 * i] = g0 * sigm(g0); sgl[2 * i + 1] = g1 * sigm(g1); }
            *(u32x4*)(SG + (rg * 4 + o) * LDU + cgp * 8) = (u32x4){cvtpk(sgl[0], sgl[1]), cvtpk(sgl[2], sgl[3]), cvtpk(sgl[4], sgl[5]), cvtpk(sgl[6], sgl[7])};
        }
    }
    __syncthreads();
    const int col = lane & 15, q = lane >> 4;
    const int chl = wid * 16 + col, chg = nb * 128 + chl;
    float hsum[8][4];
    f32x2* AGG = (f32x2*)(p.ws + WS_AGG);
    const bf16_t* LWT = (const bf16_t*)(p.ws + WS_LWT);
#pragma unroll
    for (int d = 0; d < 2; ++d) {
        f32x4 acc[2][8];
#pragma unroll
        for (int a = 0; a < 2; ++a)
#pragma unroll
            for (int b = 0; b < 8; ++b) acc[a][b] = (f32x4){0.f, 0.f, 0.f, 0.f};
        bf16x8 bfr[4][2];
#pragma unroll
        for (int s = 0; s < 4; ++s)
#pragma unroll
            for (int gt = 0; gt < 2; ++gt) bfr[s][gt] = *(const bf16x8*)(LWT + ((size_t)((d * 2 + gt) * 16 + nb) * 128 + chl) * 128 + s * 32 + q * 8);
        const float br = p.in[6][d * 2048 + chg], bi = p.in[8][d * 2048 + chg], lam = p.in[9][d * 2048 + chg];
#pragma unroll
        for (int s = 0; s < 4; ++s) {
#pragma unroll
            for (int rt = 0; rt < 8; ++rt) {
                const bf16x8 af = *(const bf16x8*)(UB + (rt * 16 + col) * LDU + s * 32 + q * 8);
#pragma unroll
                for (int gt = 0; gt < 2; ++gt) acc[gt][rt] = __builtin_amdgcn_mfma_f32_16x16x32_bf16(af, bfr[s][gt], acc[gt][rt], 0, 0, 0);
            }
            __builtin_amdgcn_sched_barrier(0);
        }
        const float sp = log1pf(expf(-lam));
        const float cdec = -8.f * sp * LOG2E;
        const f32x2 nl2 = {-LOG2E, -LOG2E}, nbr2 = {-br * LOG2E, -br * LOG2E}, nbi2 = {-bi * LOG2E, -bi * LOG2E}, cd2 = {cdec, cdec}, one2 = {1.f, 1.f};
        float hl[8][4], pc[8][4];
#pragma unroll
        for (int rt = 0; rt < 8; ++rt) {
            float av[4], bv[4];
#pragma unroll
            for (int jp = 0; jp < 2; ++jp) {
                const f32x2 xr = {acc[0][rt][2 * jp], acc[0][rt][2 * jp + 1]}, xi = {acc[1][rt][2 * jp], acc[1][rt][2 * jp + 1]};
                f32x2 er = xr * nl2 + nbr2, ei = xi * nl2 + nbi2;
                er = (f32x2){ex2(er[0]), ex2(er[1])} + one2; ei = (f32x2){ex2(ei[0]), ex2(ei[1])} + one2;
                const f32x2 r = {rcpf_(er[0]), rcpf_(er[1])}, ig = {rcpf_(ei[0]), rcpf_(ei[1])};
                const f32x2 la = r * cd2;
                const f32x2 a = {ex2(la[0]), ex2(la[1])};
                const f32x2 om = one2 - a * a;
                const f32x2 sc = {__builtin_amdgcn_sqrtf(om[0]), __builtin_amdgcn_sqrtf(om[1])};
                const f32x2 u2 = {bf2f(UB[(rt * 16 + 4 * q + 2 * jp) * LDU + chl]), bf2f(UB[(rt * 16 + 4 * q + 2 * jp + 1) * LDU + chl])};
                const f32x2 b2 = sc * ig * u2;
                av[2 * jp] = a[0]; av[2 * jp + 1] = a[1]; bv[2 * jp] = b2[0]; bv[2 * jp + 1] = b2[1];
            }
            float h = 0.f, P = 1.f;
            if (d == 0) {
#pragma unroll
                for (int j = 0; j < 4; ++j) { h = fmaf(av[j], h, bv[j]); P *= av[j]; hl[rt][j] = h; pc[rt][j] = P; }
            } else {
#pragma unroll
                for (int j = 3; j >= 0; --j) { h = fmaf(av[j], h, bv[j]); P *= av[j]; hl[rt][j] = h; pc[rt][j] = P; }
            }
            AG[(rt * 4 + q) * 16 + col] = (f32x2){P, h};
            __builtin_amdgcn_sched_barrier(0);
        }
        asm volatile("s_waitcnt lgkmcnt(0)" ::: "memory");
        float carry[8], pref[8]; float cin = 0.f, pa = 1.f;
#pragma unroll
        for (int gi = 0; gi < 32; ++gi) {
            const int G = d == 0 ? gi : 31 - gi; const int rt = G >> 2, qq = G & 3;
            const f32x2 ah = AG[G * 16 + col];
            if (qq == q) { carry[rt] = cin; pref[rt] = pa; }
            cin = fmaf(ah[0], cin, ah[1]); pa *= ah[0];
        }
        if (q == 0) AGG[((size_t)d * 128 + c) * 2048 + chg] = (f32x2){pa, cin};
        __syncthreads();
#pragma unroll
        for (int rt = 0; rt < 8; ++rt) {
            const f32x2 cr2 = {carry[rt], carry[rt]}, pf2 = {pref[rt], pref[rt]};
#pragma unroll
            for (int jp = 0; jp < 2; ++jp) {
                const int lo = (rt * 16 + 4 * q + 2 * jp) * LDU + chl;
                const f32x2 sg2 = {bf2f(SG[lo]), bf2f(SG[lo + LDU])};
                const f32x2 pc2 = {pc[rt][2 * jp], pc[rt][2 * jp + 1]}, hl2 = {hl[rt][2 * jp], hl[rt][2 * jp + 1]};
                const f32x2 hf = pc2 * cr2 + hl2, ov = pc2 * pf2 * sg2;
                const unsigned w = cvtpk(ov[0], ov[1]);
                OS[lo] = (unsigned short)(w & 0xffffu); OS[lo + LDU] = (unsigned short)(w >> 16);
                if (d == 0) { hsum[rt][2 * jp] = hf[0]; hsum[rt][2 * jp + 1] = hf[1]; }
                else { const f32x2 hs = ((f32x2){hsum[rt][2 * jp], hsum[rt][2 * jp + 1]} + hf) * sg2; hsum[rt][2 * jp] = hs[0]; hsum[rt][2 * jp + 1] = hs[1]; }
            }
            __builtin_amdgcn_sched_barrier(0);
        }
        __syncthreads();
        lru_copy_out(OS, (bf16_t*)((unsigned char*)p.out + (d == 0 ? DO_ACF : DO_ACB)) + (size_t)c * 128 * 2048 + nb * 128, tid);
        __builtin_amdgcn_sched_barrier(0);
    }
    __syncthreads();
#pragma unroll
    for (int rt = 0; rt < 8; ++rt)
#pragma unroll
        for (int jp = 0; jp < 2; ++jp) { const int lo = (rt * 16 + 4 * q + 2 * jp) * LDU + chl; const unsigned w = cvtpk(hsum[rt][2 * jp], hsum[rt][2 * jp + 1]);
            OS[lo] = (unsigned short)(w & 0xffffu); OS[lo + LDU] = (unsigned short)(w >> 16); }
    __syncthreads();
    lru_copy_out(OS, ZGt, tid);
}

namespace att {
constexpr float SCALE = 0.088388347648318440f, THR = 8.f;
constexpr int SHM_V = 64 * 128 * 2, SHM_K = SHM_V, LDK = 3072;
#define KSWZ(row, colB) ((row) * 256 + ((colB) ^ (((row) & 7) << 4)))
#define SBAR() __builtin_amdgcn_sched_barrier(0)
DI int crow(int r, int hi) { return (r & 3) + 8 * (r >> 2) + 4 * hi; }
DI void maskT(f32x16& p0, f32x16& p1, int kt, int qw, int r32, int hi) {
    if ((kt - qw - 31 < -128) || (kt + 63 - qw > 128)) {
        const int db = kt - (qw + r32) + 4 * hi;
#pragma unroll
        for (int r = 0; r < 16; ++r) { const int d = db + (r & 3) + 8 * (r >> 2);
            p0[r] = (d >= -128 && d <= 128) ? p0[r] : -1e30f; p1[r] = (d + 32 >= -128 && d + 32 <= 128) ? p1[r] : -1e30f; }
    }
}
DI void partialSM(f32x16& p0, f32x16& p1, float& m_reg, float& mn, float& alpha) {
    constexpr float C = SCALE * 1.4426950408889634f;
    float pmax = p0[0];
#pragma unroll
    for (int r = 1; r < 16; ++r) pmax = fmaxf(pmax, p0[r]);
#pragma unroll
    for (int r = 0; r < 16; ++r) pmax = fmaxf(pmax, p1[r]);
    { auto rr = __builtin_amdgcn_permlane32_swap(__float_as_uint(pmax), __float_as_uint(pmax), false, false);
      pmax = fmaxf(__uint_as_float(rr[0]), __uint_as_float(rr[1])); }
    if (__builtin_expect(__all(pmax - m_reg <= THR / SCALE), 1)) { mn = m_reg; alpha = 1.f; }
    else { mn = fmaxf(m_reg, pmax); alpha = __builtin_amdgcn_exp2f((m_reg - mn) * C); m_reg = mn; }
    const float mnC = -mn * C;
#pragma unroll
    for (int r = 0; r < 16; ++r) p0[r] = fmaf(p0[r], C, mnC);
#pragma unroll
    for (int r = 0; r < 16; ++r) p1[r] = fmaf(p1[r], C, mnC);
#pragma unroll
    for (int r = 0; r < 16; ++r) p0[r] = __builtin_amdgcn_exp2f(p0[r]);
}
DI void finishSM(f32x16& p0, f32x16& p1, float alpha, float& l_reg, bf16x8& pa0, bf16x8& pa1, bf16x8& pa2, bf16x8& pa3) {
#pragma unroll
    for (int r = 0; r < 16; ++r) p1[r] = __builtin_amdgcn_exp2f(p1[r]);
    float ps = 0;
#pragma unroll
    for (int r = 0; r < 16; ++r) ps += p0[r];
#pragma unroll
    for (int r = 0; r < 16; ++r) ps += p1[r];
    { auto rr = __builtin_amdgcn_permlane32_swap(__float_as_uint(ps), __float_as_uint(ps), false, false);
      ps = __uint_as_float(rr[0]) + __uint_as_float(rr[1]); }
    l_reg = l_reg * alpha + ps;
#define PK4(P, BASE, OUT) do { unsigned a0 = cvtpk(P[BASE + 0], P[BASE + 1]), a1 = cvtpk(P[BASE + 2], P[BASE + 3]);   \
    unsigned b0 = cvtpk(P[BASE + 4], P[BASE + 5]), b1 = cvtpk(P[BASE + 6], P[BASE + 7]);                              \
    auto r0 = __builtin_amdgcn_permlane32_swap(a0, b0, false, false); auto r1 = __builtin_amdgcn_permlane32_swap(a1, b1, false, false); \
    u32x4 w = {r0[0], r1[0], r0[1], r1[1]}; OUT = __builtin_bit_cast(bf16x8, w); } while (0)
    PK4(p0, 0, pa0); PK4(p0, 8, pa1); PK4(p1, 0, pa2); PK4(p1, 8, pa3);
#undef PK4
}
DI void qkt(f32x16& p0, f32x16& p1, const char* Ks, const bf16x8* qr, int r32, int hi) {
#pragma unroll
    for (int i = 0; i < 16; ++i) { p0[i] = 0.f; p1[i] = 0.f; }
#pragma unroll
    for (int d0 = 0; d0 < 8; ++d0) { const int cb = (d0 * 16 + hi * 8) * 2;
        const bf16x8 b0 = *reinterpret_cast<const bf16x8*>(Ks + KSWZ(r32, cb));
        const bf16x8 b1 = *reinterpret_cast<const bf16x8*>(Ks + KSWZ(32 + r32, cb));
        p0 = __builtin_amdgcn_mfma_f32_32x32x16_bf16(b0, qr[d0], p0, 0, 0, 0);
        p1 = __builtin_amdgcn_mfma_f32_32x32x16_bf16(b1, qr[d0], p1, 0, 0, 0); }
}
DI int v_st(int k, int c) { const int kk = (k & ~0xC) | ((k & 4) << 1) | ((k & 8) >> 1); return ((kk >> 3) * 4 + (c >> 5)) * 512 + ((kk & 7) * 32 + (c & 31)) * 2; }
DI int v_rd_base(int lane) { return ((lane & 3) << 3) | (((lane >> 2) & 3) << 6) | (((lane >> 4) & 1) << 5) | (((lane >> 5) & 1) << 8); }
constexpr int v_rd_off(int d0, int ks, int half) { return d0 * 512 + ks * 4096 + half * 2048; }
template <int OFF> DI s16x4 tr_read(int vb) {
    s16x4 r; asm volatile("ds_read_b64_tr_b16 %0, %1 offset:%2" : "=&v"(r) : "v"(vb), "i"(OFF) : "memory"); return r;
}
template <int D0> DI void pv_one(f32x16& od, int vb, bf16x8 pa0, bf16x8 pa1, bf16x8 pa2, bf16x8 pa3) {
    const s16x4 l0 = tr_read<v_rd_off(D0, 0, 0)>(vb), h0 = tr_read<v_rd_off(D0, 0, 1)>(vb), l1 = tr_read<v_rd_off(D0, 1, 0)>(vb), h1 = tr_read<v_rd_off(D0, 1, 1)>(vb);
    const s16x4 l2 = tr_read<v_rd_off(D0, 2, 0)>(vb), h2 = tr_read<v_rd_off(D0, 2, 1)>(vb), l3 = tr_read<v_rd_off(D0, 3, 0)>(vb), h3 = tr_read<v_rd_off(D0, 3, 1)>(vb);
    asm volatile("s_waitcnt lgkmcnt(0)" ::: "memory"); SBAR();
#define PK(L, H) (bf16x8){L[0], L[1], L[2], L[3], H[0], H[1], H[2], H[3]}
    od = __builtin_amdgcn_mfma_f32_32x32x16_bf16(pa0, PK(l0, h0), od, 0, 0, 0);
    od = __builtin_amdgcn_mfma_f32_32x32x16_bf16(pa1, PK(l1, h1), od, 0, 0, 0);
    od = __builtin_amdgcn_mfma_f32_32x32x16_bf16(pa2, PK(l2, h2), od, 0, 0, 0);
    od = __builtin_amdgcn_mfma_f32_32x32x16_bf16(pa3, PK(l3, h3), od, 0, 0, 0);
#undef PK
}
DI void pv_d0(f32x16* o, int vb, bf16x8 pa0, bf16x8 pa1, bf16x8 pa2, bf16x8 pa3) {
    pv_one<0>(o[0], vb, pa0, pa1, pa2, pa3); pv_one<1>(o[1], vb, pa0, pa1, pa2, pa3); pv_one<2>(o[2], vb, pa0, pa1, pa2, pa3); pv_one<3>(o[3], vb, pa0, pa1, pa2, pa3);
}
DI void attn_item(const bf16_t* __restrict__ Qw_, const bf16_t* __restrict__ Kh, const bf16_t* __restrict__ Vh, const bf16_t* Gw, bf16_t* Ow,
                  int NT, int kt0, int qw, float sinkv, char* lds) {
    const int tid = threadIdx.x, wid = __builtin_amdgcn_readfirstlane(tid >> 6), lane = tid & 63, r32 = lane & 31, hi = lane >> 5;
    char* V_lds = lds; char* K_lds = lds + 2 * SHM_V;
    float* wsp = (float*)(lds + 2 * SHM_V + 2 * SHM_K) + wid * 64; float* li_l = wsp; float* al_l = wsp + 32;
    float m_reg = sinkv * (1.f / SCALE), l_reg = 1.f; f32x16 o[4]; bf16x8 qr[8];
#pragma unroll
    for (int d = 0; d < 4; ++d)
#pragma unroll
        for (int r = 0; r < 16; ++r) o[d][r] = 0.f;
    const bf16_t* Qw = Qw_ + (size_t)r32 * LDK + hi * 8;
#pragma unroll
    for (int d0 = 0; d0 < 8; ++d0) qr[d0] = *(const bf16x8*)(Qw + d0 * 16);
    const int sr = tid >> 4, sc = (tid & 15) * 8, vst0 = v_st(sr, sc), vst1 = v_st(32 + sr, sc);
    const int vb0 = (int)(uintptr_t)V_lds + v_rd_base(lane);
    struct { bf16x8 vs0, vs1, ks0, ks1; } sr_[2];
#define SLOAD(i, k0) do { sr_[i].vs0 = *(const bf16x8*)(&Vh[(size_t)((k0) + sr) * LDK + sc]); sr_[i].vs1 = *(const bf16x8*)(&Vh[(size_t)((k0) + 32 + sr) * LDK + sc]); \
    sr_[i].ks0 = *(const bf16x8*)(&Kh[(size_t)((k0) + sr) * LDK + sc]); sr_[i].ks1 = *(const bf16x8*)(&Kh[(size_t)((k0) + 32 + sr) * LDK + sc]); } while (0)
#define SWRITE(b, i) do { *(bf16x8*)(V_lds + (b) * SHM_V + vst0) = sr_[i].vs0;          \
    *(bf16x8*)(V_lds + (b) * SHM_V + vst1) = sr_[i].vs1; const int kc = sc * 2;               \
    *(bf16x8*)(K_lds + (b) * SHM_K + KSWZ(sr, kc)) = sr_[i].ks0;                       \
    *(bf16x8*)(K_lds + (b) * SHM_K + KSWZ(32 + sr, kc)) = sr_[i].ks1; } while (0)
#define SWAIT() asm volatile("s_waitcnt vmcnt(4)" ::: "memory")
#define RESC(a) do { if (__any((a) < 1.f)) { if (hi == 0) al_l[r32] = (a); asm volatile("s_waitcnt lgkmcnt(0)" ::: "memory"); \
    _Pragma("unroll") for (int d = 0; d < 4; ++d) _Pragma("unroll") for (int r = 0; r < 16; ++r) o[d][r] *= al_l[crow(r, hi)]; } } while (0)
    f32x16 pA0, pA1, pB0, pB1; float mnA, mnB, alA, alB; bf16x8 pa0, pa1, pa2, pa3;
    constexpr int SE = 0, SO = 1;
    SLOAD(SE, 0); asm volatile("s_waitcnt vmcnt(0)" ::: "memory"); SWRITE(0, SE); __syncthreads();
    qkt(pA0, pA1, K_lds, qr, r32, hi); maskT(pA0, pA1, kt0, qw, r32, hi); partialSM(pA0, pA1, m_reg, mnA, alA);
    SLOAD(SO, 64); if (2 < NT) SLOAD(SE, 128);
    SWAIT(); SWRITE(1, SO); __syncthreads();
    for (int j = 1; j + 1 < NT; j += 2) {
        SBAR(); qkt(pB0, pB1, K_lds + SHM_K, qr, r32, hi);
        finishSM(pA0, pA1, alA, l_reg, pa0, pa1, pa2, pa3); SBAR();
        SLOAD(SO, (j + 2) * 64); SBAR();
        pv_d0(o, vb0, pa0, pa1, pa2, pa3); maskT(pB0, pB1, kt0 + 64 * j, qw, r32, hi); partialSM(pB0, pB1, m_reg, mnB, alB);
        __syncthreads(); SWAIT(); SWRITE(0, SE);
        RESC(alB); __syncthreads();
        SBAR(); qkt(pA0, pA1, K_lds, qr, r32, hi);
        finishSM(pB0, pB1, alB, l_reg, pa0, pa1, pa2, pa3); SBAR();
        if (j + 3 < NT) SLOAD(SE, (j + 3) * 64); SBAR();
        pv_d0(o, vb0 + SHM_V, pa0, pa1, pa2, pa3); maskT(pA0, pA1, kt0 + 64 * (j + 1), qw, r32, hi); partialSM(pA0, pA1, m_reg, mnA, alA);
        __syncthreads(); SWAIT(); SWRITE(1, SO);
        RESC(alA); __syncthreads();
    }
    SBAR(); qkt(pB0, pB1, K_lds + SHM_K, qr, r32, hi);
    finishSM(pA0, pA1, alA, l_reg, pa0, pa1, pa2, pa3); SBAR();
    pv_d0(o, vb0, pa0, pa1, pa2, pa3); maskT(pB0, pB1, kt0 + 64 * (NT - 1), qw, r32, hi); partialSM(pB0, pB1, m_reg, mnB, alB);
    __syncthreads(); RESC(alB);
    finishSM(pB0, pB1, alB, l_reg, pa0, pa1, pa2, pa3); SBAR();
    pv_d0(o, vb0 + SHM_V, pa0, pa1, pa2, pa3);
    int lane2 = threadIdx.x & 63; asm volatile("" : "+v"(lane2));
    const int ec = lane2 & 15, er = lane2 >> 4;
    if (hi == 0) li_l[r32] = l_reg; asm volatile("s_waitcnt lgkmcnt(0)" ::: "memory");
    bf16_t* OT = (bf16_t*)(lds + 67584 + wid * 8704);
#pragma unroll
    for (int r = 0; r < 16; ++r) { const int orow = crow(r, hi); const float rl = __builtin_amdgcn_rcpf(li_l[orow]);
#pragma unroll
        for (int d0 = 0; d0 < 4; ++d0) OT[orow * 136 + d0 * 32 + r32] = f2bf(o[d0][r] * rl); }
    __builtin_amdgcn_sched_barrier(0);
    u32x4 gv[8];
#pragma unroll
    for (int k = 0; k < 8; ++k) gv[k] = __builtin_nontemporal_load((const u32x4*)(Gw + (size_t)(er + 4 * k) * 2048 + ec * 8));
    asm volatile("s_waitcnt lgkmcnt(0)" ::: "memory");
#pragma unroll
    for (int k = 0; k < 8; ++k) {
        const u32x4 ov = *(const u32x4*)(OT + (er + 4 * k) * 136 + ec * 8); u32x4 w;
#pragma unroll
        for (int i = 0; i < 4; ++i) { const float g0 = bflo(gv[k][i]), g1 = bfhi(gv[k][i]); w[i] = cvtpk(bflo(ov[i]) * g0 * sigm(g0), bfhi(ov[i]) * g1 * sigm(g1)); }
        *(u32x4*)(Ow + (size_t)(er + 4 * k) * 2048 + ec * 8) = w;
    }
#undef SLOAD
#undef SWRITE
#undef SWAIT
#undef RESC
}
}

DI void phase_lru(const Params& p, unsigned char* shm) {
    for (int it = blockIdx.x; it < 2048; it += gridDim.x) lru_tile(p, shm, it >> 4, it & 15);
    __syncthreads();
}
DI void phase_att(const Params& p, unsigned char* shm) {
    const int wid = __builtin_amdgcn_readfirstlane(threadIdx.x >> 6);
    const bf16_t* Z = (const bf16_t*)(p.ws + WS_ZQKV); const bf16_t* GA = (const bf16_t*)(p.ws + WS_ZGA); bf16_t* YB = (bf16_t*)(p.ws + WS_YB);
    for (int it = blockIdx.x; it < 1024; it += gridDim.x) {
        const int hp = it & 1, g = (it >> 1) & 3, n = it >> 3;
        const int head = g * 4 + hp * 2 + (wid >> 2), qw = 32 * (wid & 3);
        const int kfirst = n == 0 ? 0 : (n - 1) * 128, NT = (n == 0 || n == 127) ? 4 : 6, kt0 = kfirst - n * 128;
        __syncthreads();
        const size_t go = (size_t)(n * 128 + qw) * 2048 + head * 128;
        att::attn_item(Z + (size_t)(n * 128 + qw) * 3072 + head * 128, Z + (size_t)kfirst * 3072 + 2048 + g * 128, Z + (size_t)kfirst * 3072 + 2560 + g * 128,
                       GA + go, YB + go, NT, kt0, qw, p.in[10][head], (char*)shm);
    }
    __syncthreads();
}
DI void phase_mixers(const Params& p, unsigned char* shm) { if (p.mix_mask & 1) phase_lru(p, shm); if (p.mix_mask & 2) phase_att(p, shm); }

DI void phase_carry(const Params& p) {
    const int tid = threadIdx.x;
    if (tid >= 64) return;
    const f32x2* AGG = (const f32x2*)(p.ws + WS_AGG); float* CAR = (float*)(p.ws + WS_CAR);
    for (int w = blockIdx.x; w < 64; w += gridDim.x) {
        const int id = w * 64 + tid, d = id >> 11, ch = id & 2047;
        const f32x2* ag = AGG + (size_t)d * 128 * 2048 + ch; float* car = CAR + (size_t)d * 128 * 2048 + ch;
        float cin = 0.f;
        for (int b = 0; b < 4; ++b) {
            f32x2 v[32];
#pragma unroll
            for (int u = 0; u < 32; ++u) { const int k = b * 32 + u, cc = d == 0 ? k : 127 - k; v[u] = ag[(size_t)cc * 2048]; }
#pragma unroll
            for (int u = 0; u < 32; ++u) { const int k = b * 32 + u, cc = d == 0 ? k : 127 - k; car[(size_t)cc * 2048] = cin; cin = fmaf(v[u][0], cin, v[u][1]); }
        }
    }
}
DI void phase_fixup(const Params& p) {
    const int tid = threadIdx.x, ch = tid * 4;
    const float* CAR = (const float*)(p.ws + WS_CAR);
    bf16_t* ZG = (bf16_t*)(p.ws + WS_ZG);
    const bf16_t* ACF = (const bf16_t*)((unsigned char*)p.out + DO_ACF); const bf16_t* ACB = (const bf16_t*)((unsigned char*)p.out + DO_ACB);
    for (int it = blockIdx.x; it < 512; it += gridDim.x) {
        const int c = it >> 2, rq = it & 3;
        const f32x4 cf = *(const f32x4*)(CAR + (size_t)c * 2048 + ch), cb = *(const f32x4*)(CAR + (size_t)(128 + c) * 2048 + ch);
#pragma unroll 8
        for (int i = 0; i < 32; ++i) {
            const size_t off = (size_t)(c * 128 + rq * 32 + i) * 2048 + ch;
            const u32x2 h = __builtin_nontemporal_load((const u32x2*)(ZG + off)), f = __builtin_nontemporal_load((const u32x2*)(ACF + off)), b = __builtin_nontemporal_load((const u32x2*)(ACB + off));
            const float y0 = bflo(h[0]) + bflo(f[0]) * cf[0] + bflo(b[0]) * cb[0], y1 = bfhi(h[0]) + bfhi(f[0]) * cf[1] + bfhi(b[0]) * cb[1];
            const float y2 = bflo(h[1]) + bflo(f[1]) * cf[2] + bflo(b[1]) * cb[2], y3 = bfhi(h[1]) + bfhi(f[1]) * cf[3] + bfhi(b[1]) * cb[3];
            *(u32x2*)(ZG + off) = (u32x2){cvtpk(y0, y1), cvtpk(y2, y3)};
        }
    }
}

DI void phase_final(const Params& p) {
    const int tid = threadIdx.x, wid = tid >> 6, lane = tid & 63;
    const float* x = p.in[0]; const float* nw = p.in[14]; const bf16_t* o2 = (const bf16_t*)(p.ws + WS_OUT2); const float* ssq = (const float*)(p.ws + WS_SSQ);
    f32x4 w[8];
#pragma unroll
    for (int i = 0; i < 8; ++i) w[i] = *(const f32x4*)(nw + i * 256 + lane * 4);
    for (int row = (blockIdx.x * 8 + wid) * 2; row < S; row += gridDim.x * 16) {
        f32x4 xv[2][8]; u32x2 yv[2][8]; float sq[2];
#pragma unroll
        for (int r = 0; r < 2; ++r) {
            sq[r] = lane < 32 ? ssq[(size_t)(row + r) * 32 + lane] : 0.f;
#pragma unroll
            for (int i = 0; i < 8; ++i) { const size_t off = (size_t)(row + r) * DM + i * 256 + lane * 4; xv[r][i] = __builtin_nontemporal_load((const f32x4*)(x + off)); yv[r][i] = __builtin_nontemporal_load((const u32x2*)(o2 + off)); }
        }
#pragma unroll
        for (int r = 0; r < 2; ++r) {
            const float rs = rsqrtf(wave_sum(sq[r]) * (1.f / DM) + EPS);
#pragma unroll
            for (int i = 0; i < 8; ++i) { const size_t off = (size_t)(row + r) * DM + i * 256 + lane * 4;
                const f32x4 ov = {xv[r][i][0] + bflo(yv[r][i][0]) * rs * w[i][0], xv[r][i][1] + bfhi(yv[r][i][0]) * rs * w[i][1],
                                  xv[r][i][2] + bflo(yv[r][i][1]) * rs * w[i][2], xv[r][i][3] + bfhi(yv[r][i][1]) * rs * w[i][3]};
                __builtin_nontemporal_store(ov, (f32x4*)(p.out + off)); }
        }
    }
}

#define XB_TMO      128
#define XB_XCNT(j)  (256  + 64 * (j))
#define XB_XSUB(j)  (1280 + 64 * (j))
#define XB_XGEN(j)  (2304 + 64 * (j))
#define XB_TOP      3328
#define XB_TOPGEN   3392
#define XCD_BAR_WORDS 3456
#define XB_SPIN_CAP (1u << 18)

__device__ __forceinline__ unsigned xb_ld(unsigned* p)              { return __hip_atomic_load(p, __ATOMIC_RELAXED, __HIP_MEMORY_SCOPE_AGENT); }
__device__ __forceinline__ unsigned xb_add(unsigned* p, unsigned v) { return __hip_atomic_fetch_add(p, v, __ATOMIC_RELAXED, __HIP_MEMORY_SCOPE_AGENT); }
__device__ __forceinline__ unsigned xb_xcc_id() { return (unsigned)__builtin_amdgcn_s_getreg((3 << 11) | 20) & 0xFu; }
#define XB_SPIN(cond, bar) do { unsigned _sp = 0; while (cond) { __builtin_amdgcn_s_sleep(1); \
    if ((++_sp & 255u) == 0u) { if (xb_ld(&(bar)[XB_TMO])) break; if (_sp > XB_SPIN_CAP) { atomicAdd(&(bar)[XB_TMO], 1u); break; } } } } while (0)

struct XcdBarrier {
    unsigned* bar; unsigned x;
    volatile LAS unsigned* st;
};

__device__ __forceinline__ XcdBarrier xcd_barrier_post(unsigned* bar, volatile LAS unsigned* st) {
    XcdBarrier b; b.bar = bar; b.x = xb_xcc_id(); b.st = st;
    if (threadIdx.x == 0) (void)xb_add(&bar[XB_XCNT(b.x)], 1u);
    return b;
}
__device__ __forceinline__ void xcd_barrier_complete(unsigned* bar, unsigned x, unsigned& nloc, unsigned& nx) {
    const unsigned G = gridDim.x * gridDim.y * gridDim.z;
    unsigned sum, cnt, mine, sp = 0u;
    for (;;) {
        sum = 0u; cnt = 0u; mine = 0u;
#pragma unroll
        for (unsigned j = 0; j < 16; ++j) { const unsigned c = xb_ld(&bar[XB_XCNT(j)]); sum += c; cnt += (c > 0u) ? 1u : 0u; mine = (j == x) ? c : mine; }
        if (sum == G) break;
        __builtin_amdgcn_s_sleep(1);
        if ((++sp & 255u) == 0u) { if (xb_ld(&bar[XB_TMO])) break; if (sp > XB_SPIN_CAP) { atomicAdd(&bar[XB_TMO], 1u); break; } }
    }
    nloc = mine > 0u ? mine : 1u; nx = cnt > 0u ? cnt : 1u;
}

__device__ __forceinline__ void xcd_barrier(const XcdBarrier& b) {
    asm volatile("s_waitcnt vmcnt(0)" ::: "memory");
    __syncthreads();
    if (threadIdx.x == 0) {
        unsigned* bar = b.bar;
        __builtin_amdgcn_s_waitcnt(0);
        unsigned nloc = b.st[0], nx = b.st[1];
        if (nloc == 0u) { xcd_barrier_complete(bar, b.x, nloc, nx); b.st[0] = nloc; b.st[1] = nx; }
        const unsigned old = xb_add(&bar[XB_XSUB(b.x)], 1u);
        const unsigned gen = old / nloc;
        if (old + 1u == (gen + 1u) * nloc) {
            __builtin_amdgcn_fence(__ATOMIC_RELEASE, "agent");
            asm volatile("s_waitcnt vmcnt(0)" ::: "memory");
            const unsigned og = xb_add(&bar[XB_TOP], 1u);
            const unsigned tg = og / nx;
            if (og + 1u == (tg + 1u) * nx) xb_add(&bar[XB_TOPGEN], 1u);
            else XB_SPIN(xb_ld(&bar[XB_TOPGEN]) == tg, bar);
            __builtin_amdgcn_fence(__ATOMIC_ACQUIRE, "agent");
            xb_add(&bar[XB_XGEN(b.x)], 1u);
            asm volatile("s_waitcnt vmcnt(0)" ::: "memory");
        } else {
            XB_SPIN(xb_ld(&bar[XB_XGEN(b.x)]) == gen, bar);
            __builtin_amdgcn_fence(__ATOMIC_ACQUIRE, "agent");
            asm volatile("s_waitcnt vmcnt(0)" ::: "memory");
        }
    }
    __syncthreads();
}

__global__ void __launch_bounds__(512, 2) mega(Params p) {
    extern __shared__ __attribute__((aligned(16))) unsigned char shm[];
    cg::grid_group grid = cg::this_grid();
    volatile LAS unsigned* bst = (volatile LAS unsigned*)((LAS unsigned char*)shm + LDS_BAR_ST);
    if (threadIdx.x < 4) bst[threadIdx.x] = 0u;
    __syncthreads();
    XcdBarrier xbar; xbar.bar = (unsigned*)(p.ws + WS_BAR); xbar.x = 0; xbar.st = bst;
    if (p.ph_hi - p.ph_lo > 1) xbar = xcd_barrier_post((unsigned*)(p.ws + WS_BAR), bst);
    if (p.ph_lo > 64) grid.sync();
#ifndef PHMASK
#define PHMASK 0xff
#endif
#define PH(i) (((PHMASK >> (i)) & 1) && p.ph_lo <= (i) && (i) < p.ph_hi)
#define SEAM(i) do { if (p.ph_lo <= (i) && (i) + 1 < p.ph_hi) xcd_barrier(xbar); } while (0)
    if (PH(0)) phase_prep(p, shm);
    SEAM(0);
    if (PH(1)) {
        pg8::Gemm g; g.A0 = (const bf16_t*)((unsigned char*)p.out + DO_XN); g.A1 = g.A0; g.B0 = (const bf16_t*)((unsigned char*)p.out + DO_WINT); g.B1 = g.B0;
        g.lda = DM; g.ldb = DM; g.M = S; g.N = NIN; g.K = DM; g.ksplit = DM / 64;
        pg8::StaticOrder so; so.init(g.M, g.N, (int)gridDim.x, (int)blockIdx.x);
        EpiZ e; e.ws = p.ws;
        if (gridDim.x >= 16 && (gridDim.x & 15) == 0) { if ((blockIdx.x >> 3) & 1) prep_small_weights(p, shm, (int)((blockIdx.x >> 4) * 8 + (blockIdx.x & 7)), (int)(gridDim.x / 2)); }
        else prep_small_weights(p, shm, (int)blockIdx.x, (int)gridDim.x);
        pg8::gemm_phase<EpiZ>((LAS unsigned char*)shm, g, so, e);
    }
    SEAM(1);
#if PROBE_SPLIT
    if (PH(2)) phase_lru(p, shm);
    if (p.ph_lo == 8) phase_att(p, shm);
#else
    if (PH(2)) phase_mixers(p, shm);
#endif
    SEAM(2);
    if (PH(3)) phase_carry(p);
    SEAM(3);
    if (PH(4)) phase_fixup(p);
    SEAM(4);
    if (PH(5)) {
        pg8::Gemm g; g.A0 = (const bf16_t*)(p.ws + WS_ZG); g.A1 = (const bf16_t*)(p.ws + WS_YB) - 2048; g.B0 = (const bf16_t*)(p.ws + WS_WAT); g.B1 = (const bf16_t*)(p.ws + WS_WBT) - 2048;
        g.lda = DM; g.ldb = DM; g.M = S; g.N = DM; g.K = 2 * DM; g.ksplit = DM / 64;
        pg8::StaticOrder so; so.init(g.M, g.N, (int)gridDim.x, (int)blockIdx.x);
        EpiMergeMid e; e.ws = p.ws;
        pg8::gemm_phase<EpiMergeMid>((LAS unsigned char*)shm, g, so, e);
    }
    SEAM(5);
    if (PH(6)) {
        pg8::Gemm g; g.A0 = (const bf16_t*)(p.ws + WS_MRG); g.A1 = g.A0; g.B0 = (const bf16_t*)(p.ws + WS_WOT); g.B1 = g.B0;
        g.lda = DM; g.ldb = DM; g.M = S; g.N = DM; g.K = DM; g.ksplit = DM / 64;
        pg8::StaticOrder so; so.init(g.M, g.N, (int)gridDim.x, (int)blockIdx.x);
        EpiOut e; e.ws = p.ws;
        pg8::gemm_phase<EpiOut>((LAS unsigned char*)shm, g, so, e);
    }
    SEAM(6);
    if (PH(7)) phase_final(p);
}

extern "C" void kernel_launch(void* const* d_in, const int* in_sizes, int n_in, void* d_out, int out_size, void* d_ws, size_t ws_size, hipStream_t stream) {
    static int grid = 0;
    if (grid == 0) {
        if (n_in != 15 || in_sizes[0] != S * DM || out_size != S * DM || ws_size < WS_END) {
            fprintf(stderr, "kernel_launch: unexpected shapes (n_in %d, in0 %d, out %d, ws %zu; need ws >= %zu)\n", n_in, n_in > 0 ? in_sizes[0] : -1, out_size, ws_size, (size_t)WS_END); grid = -1; return; }
        int dev = 0, cus = 0, per_cu = 0;
        (void)hipGetDevice(&dev); (void)hipDeviceGetAttribute(&cus, hipDeviceAttributeMultiprocessorCount, dev);
        if (hipFuncSetAttribute((const void*)mega, hipFuncAttributeMaxDynamicSharedMemorySize, LDS_BYTES) != hipSuccess) { fprintf(stderr, "kernel_launch: hipFuncSetAttribute failed\n"); grid = -1; return; }
        if (hipOccupancyMaxActiveBlocksPerMultiprocessor(&per_cu, (const void*)mega, 512, LDS_BYTES) != hipSuccess || per_cu < 1) { fprintf(stderr, "kernel_launch: occupancy query gave %d\n", per_cu); per_cu = 1; }
        (void)hipGetLastError();
        grid = cus * per_cu;
    }
    if (grid < 0) return;
    Params p{};
    for (int i = 0; i < 15; ++i) p.in[i] = (const float*)d_in[i];
    p.out = (float*)d_out; p.ws = (unsigned char*)d_ws;
    for (int j = 0; j < 16; ++j) p.inv_freq[j] = (float)pow(500000.0, -(double)j / 16.0);
    p.mix_mask = 3;
#if MK_SINGLE
    p.ph_lo = 0; p.ph_hi = 8;
    if (hipMemsetAsync((unsigned char*)d_ws + WS_BAR, 0, XCD_BAR_WORDS * sizeof(unsigned), stream) != hipSuccess) { fprintf(stderr, "kernel_launch: memset of barrier words failed\n"); return; }
    void* args[] = {&p};
    hipError_t e = hipLaunchCooperativeKernel((const void*)mega, dim3(grid), dim3(512), args, LDS_BYTES, stream);
    if (e != hipSuccess) fprintf(stderr, "kernel_launch: cooperative launch failed: %s (grid %d)\n", hipGetErrorString(e), grid);
#else
#ifndef REPMASK
#define REPMASK 0
#endif
#ifndef HALFMASK
#define HALFMASK 0
#endif
    static const int lph[9] = {0, 1, 2, 2, 3, 4, 5, 6, 7}; static const int lmix[9] = {3, 3, 1, 2, 3, 3, 3, 3, 3};
    for (int li = 0; li < 9; ++li) {
        p.ph_lo = lph[li]; p.ph_hi = lph[li] + 1; p.mix_mask = lmix[li];
#ifndef REPMASK
#define REPMASK 0
#endif
        for (int rep = 0; rep < (((REPMASK >> li) & 1) ? 2 : 1); ++rep)
        hipLaunchKernelGGL(mega, dim3(((HALFMASK >> li) & 1) ? grid / 2 : grid), dim3(512), LDS_BYTES, stream, p);
    }
#endif
}
```

```cpp
#include <hip/hip_runtime.h>
#include <hip/hip_cooperative_groups.h>
#include <cstdio>
#include <cstdint>
#include <cmath>
namespace cg = cooperative_groups;

#ifndef MK_SINGLE
#define MK_SINGLE 1
#endif

#define LAS __attribute__((address_space(3)))
#define DI __device__ __forceinline__
typedef unsigned short bf16_t;
typedef short bf16x8 __attribute__((ext_vector_type(8)));
typedef short s16x4 __attribute__((ext_vector_type(4)));
typedef float f32x2 __attribute__((ext_vector_type(2)));
typedef float f32x4 __attribute__((ext_vector_type(4)));
typedef float f32x16 __attribute__((ext_vector_type(16)));
typedef unsigned u32x2 __attribute__((ext_vector_type(2)));
typedef unsigned u32x4 __attribute__((ext_vector_type(4)));

constexpr int S = 16384, DM = 2048, NIN = 13312;
constexpr float EPS = 1e-6f;
constexpr float LOG2E = 1.4426950408889634f;
constexpr size_t MiB = (size_t)1 << 20;
constexpr size_t WS_ZU = 0, WS_MERGED = 0;
constexpr size_t WS_ZG = 64 * MiB;
constexpr size_t WS_ZQKV = 128 * MiB;
constexpr size_t WS_ZGA = 224 * MiB;
constexpr size_t WS_ZM = 288 * MiB, WS_OUT2 = 288 * MiB;
constexpr size_t WS_WAT = 416 * MiB, WS_WBT = 424 * MiB, WS_WOT = 432 * MiB;
constexpr size_t WS_ROPE = 440 * MiB;
constexpr size_t WS_AGG = 442 * MiB;
constexpr size_t WS_SSQ = 446 * MiB;
constexpr size_t WS_LWT = 448 * MiB;
constexpr size_t WS_CAR = 450 * MiB;
constexpr size_t WS_BAR = 452 * MiB;
constexpr size_t WS_END = 453 * MiB;
constexpr size_t DO_XN = 0, DO_WINT = 64 * MiB;
constexpr size_t DO_ACF = 0, DO_ACB = 64 * MiB;
#ifndef PROBE_SPLIT
#define PROBE_SPLIT 0
#endif
constexpr size_t WS_YB = PROBE_SPLIT ? WS_ZU : WS_ZGA;
constexpr size_t WS_MRG = PROBE_SPLIT ? WS_ZQKV : WS_MERGED;
constexpr int LDS_BAR_ST = 137216;
constexpr int LDS_BYTES = 137232;

struct Params {
    const float* in[15];
    float* out; unsigned char* ws;
    float inv_freq[16];
    int ph_lo, ph_hi, mix_mask, pad_;
};

DI unsigned cvtpk(float lo, float hi) { unsigned r; asm volatile("v_cvt_pk_bf16_f32 %0, %1, %2" : "=v"(r) : "v"(lo), "v"(hi)); return r; }
DI float bf2f(unsigned short b) { return __uint_as_float(((unsigned)b) << 16); }
DI float bflo(unsigned w) { return __uint_as_float(w << 16); }
DI float bfhi(unsigned w) { return __uint_as_float(w & 0xffff0000u); }
DI unsigned short f2bf(float f) { return (unsigned short)(cvtpk(f, f) & 0xffffu); }
DI float ex2(float x) { return __builtin_amdgcn_exp2f(x); }
DI float rcpf_(float x) { return __builtin_amdgcn_rcpf(x); }
DI float sigm(float x) { return rcpf_(1.f + ex2(-x * LOG2E)); }
DI float wave_sum(float v) {
#pragma unroll
    for (int o = 32; o >= 1; o >>= 1) v += __shfl_xor(v, o);
    return v;
}

namespace pg8 {
constexpr int BM = 256, BK = 64, HALF = 128, HTB = HALF * BK * 2, STAGE_BYTES = 8 * HTB, NXCD = 8, WGM = 8;
DI int lds_byte(int r, int c) { const int st = (r >> 4) * 2 + (c >> 5), rr = r & 15, cc = c & 31, ob = rr * 64 + cc * 2; return st * 1024 + (ob ^ (((ob >> 9) & 1) << 5)); }
DI void stage_rc(int b, int& R, int& C) { const int st = b / 1024, sb = b % 1024, swz = sb ^ (((sb >> 9) & 1) << 5); R = (st >> 1) * 16 + swz / 64; C = (st & 1) * 32 + (swz % 64) / 2; }
DI int perm32(int rho) { const int n = rho >> 4, i = rho & 15; return 8 * (i >> 2) + 4 * n + (i & 3); }
struct Unit { int pm, pn; };
struct Gemm { const bf16_t* A0; const bf16_t* A1; const bf16_t* B0; const bf16_t* B1; int lda, ldb, M, N, K, ksplit; };
struct StaticOrder {
    int nM, nN, nwg, G, c;
    DI void init(int M, int N, int G_, int c_) { nM = M / BM; nN = N / BM; nwg = nM * nN; G = G_; c = c_; }
    DI bool next(int i, Unit& u) const {
        const long L = (long)i * G + c; if (L >= nwg) return false;
        int wgid = (int)L; { const int q = nwg / NXCD, r = nwg % NXCD, xcd = wgid % NXCD, off = wgid / NXCD; wgid = (xcd < r ? xcd * (q + 1) : r * (q + 1) + (xcd - r) * q) + off; }
        const int nig = WGM * nN, gid = wgid / nig, fm = gid * WGM, gsz = (nM - fm) < WGM ? (nM - fm) : WGM;
        u.pm = fm + ((wgid % nig) % gsz); u.pn = (wgid % nig) / gsz; return true;
    }
};

template <class Epi>
DI void gemm_phase(LAS unsigned char* lds, const Gemm g, const StaticOrder& S_, const Epi& E) {
    const int tid = threadIdx.x, wid = __builtin_amdgcn_readfirstlane(tid >> 6), lane = tid & 63, wr = wid >> 2, wc = wid & 3, fr = lane & 15, fq = lane >> 4;
    const int K = g.K, nt = K / BK, ksplit = g.ksplit;
    unsigned voffA[2], voffB[2];
#pragma unroll
    for (int i = 0; i < 2; ++i) { int R, C; stage_rc(tid * 16 + i * 8192, R, C); const int Rb = Epi::PERM ? ((R & ~31) + perm32(R & 31)) : R;
        voffA[i] = (unsigned)(R * g.lda + C) * 2u; voffB[i] = (unsigned)(Rb * g.ldb + C) * 2u; }
    const size_t kstep = (size_t)(BK * 2);
    const size_t hstepA = (size_t)HALF * g.lda * 2, hstepB = (size_t)HALF * g.ldb * 2;
    const size_t tstepA = 2 * hstepA, tstepB = 2 * hstepB;
    const unsigned ldsw = (unsigned)wid * 1024u;
    const int aoff = lds_byte(wr * 64 + fr, fq * 8), boff = lds_byte(wc * 32 + fr, fq * 8);
#define PG8_SA(b, h) (((b) * 2 + (h)) * HTB)
#define PG8_SB(b, h) ((4 + (b) * 2 + (h)) * HTB)
#define PG8_STAGE(bufoff, gbase, voff) do { _Pragma("unroll") for (int _i = 0; _i < 2; ++_i) \
        __builtin_amdgcn_global_load_lds((const unsigned*)((const char*)(gbase) + (voff)[_i]), (LAS unsigned*)(lds + (bufoff) + ldsw + _i * 8192), 16, 0, 0); } while (0)
#define PG8_LDA(dst, b, h) do { _Pragma("unroll") for (int m = 0; m < 4; ++m) _Pragma("unroll") for (int k = 0; k < 2; ++k) dst[m][k] = *(const LAS bf16x8*)(lds + PG8_SA(b, h) + aoff + m * 2048 + k * 1024); } while (0)
#define PG8_LDB(dst, b, h) do { _Pragma("unroll") for (int n = 0; n < 2; ++n) _Pragma("unroll") for (int k = 0; k < 2; ++k) dst[n][k] = *(const LAS bf16x8*)(lds + PG8_SB(b, h) + boff + n * 2048 + k * 1024); } while (0)
#define PG8_MMA(ai, bj, At, Bt) do { __builtin_amdgcn_s_setprio(1); _Pragma("unroll") for (int m = 0; m < 4; ++m) _Pragma("unroll") for (int n = 0; n < 2; ++n) _Pragma("unroll") for (int k = 0; k < 2; ++k) \
        acc[ai][bj][m][n] = __builtin_amdgcn_mfma_f32_16x16x32_bf16(Bt[n][k], At[m][k], acc[ai][bj][m][n], 0, 0, 0); __builtin_amdgcn_s_setprio(0); } while (0)
#define PG8_WAIT_V(n) asm volatile("s_waitcnt vmcnt(" #n ")" ::: "memory")
#define PG8_WAIT_L(n) asm volatile("s_waitcnt lgkmcnt(" #n ")" ::: "memory")
#define PG8_BAR __builtin_amdgcn_s_barrier()
#define PG8_SCHED __builtin_amdgcn_sched_barrier(0)
    Unit cur, nxt; int ui = 0;
    if (!S_.next(0, cur)) return;
    f32x4 acc[2][2][4][2];
#pragma unroll
    for (int a = 0; a < 2; ++a)
#pragma unroll
        for (int b = 0; b < 2; ++b)
#pragma unroll
            for (int m = 0; m < 4; ++m)
#pragma unroll
                for (int n = 0; n < 2; ++n) acc[a][b][m][n] = (f32x4){0.f, 0.f, 0.f, 0.f};
    bf16x8 At[4][2], B0[2][2], B1[2][2];
    const char* cA0 = (const char*)g.A0 + (size_t)cur.pm * tstepA; const char* cA1 = (const char*)g.A1 + (size_t)cur.pm * tstepA;
    const char* cB0 = (const char*)g.B0 + (size_t)cur.pn * tstepB; const char* cB1 = (const char*)g.B1 + (size_t)cur.pn * tstepB;
    PG8_STAGE(PG8_SB(0, 0), cB0, voffB); PG8_STAGE(PG8_SA(0, 0), cA0, voffA); PG8_STAGE(PG8_SB(0, 1), cB0 + hstepB, voffB); PG8_STAGE(PG8_SA(0, 1), cA0 + hstepA, voffA);
    if (wr == 1) PG8_BAR;
    PG8_WAIT_V(4); PG8_BAR;
    PG8_STAGE(PG8_SB(1, 0), cB0 + kstep, voffB); PG8_STAGE(PG8_SA(1, 0), cA0 + kstep, voffA); PG8_STAGE(PG8_SB(1, 1), cB0 + hstepB + kstep, voffB);
    PG8_WAIT_V(6); PG8_BAR;
    for (;;) {
        const bool has_next = S_.next(ui + 1, nxt);
        const char* nA0 = has_next ? (const char*)g.A0 + (size_t)nxt.pm * tstepA : cA0; const char* nB0 = has_next ? (const char*)g.B0 + (size_t)nxt.pn * tstepB : cB0;
        for (int hf = 0; hf < (Epi::MID ? 2 : 1); ++hf) {
        const int tb = Epi::MID ? hf * ksplit : 0, te = Epi::MID ? (hf + 1) * ksplit : nt;
        for (int t = tb; t < te; t += 2) {
            const bool last = (t == nt - 2);
            const bool hA = (t >= ksplit), hB = (t + 2 >= ksplit);
            const char* a1 = (hA ? cA1 : cA0) + (size_t)(t + 1) * kstep;
            const char* a2 = last ? nA0 : (hB ? cA1 : cA0) + (size_t)(t + 2) * kstep; const char* b2 = last ? nB0 : (hB ? cB1 : cB0) + (size_t)(t + 2) * kstep;
            const char* a3 = a2 + kstep; const char* b3 = b2 + kstep;
            PG8_LDB(B0, 0, 0); PG8_SCHED; PG8_LDA(At, 0, 0); PG8_STAGE(PG8_SA(1, 1), a1 + hstepA, voffA);
            PG8_WAIT_L(8); PG8_BAR; PG8_WAIT_L(0); PG8_MMA(0, 0, At, B0); PG8_BAR; PG8_SCHED;
            PG8_LDB(B1, 0, 1); PG8_STAGE(PG8_SB(0, 0), b2, voffB);
            PG8_BAR; PG8_WAIT_L(0); PG8_MMA(0, 1, At, B1); PG8_BAR;
            PG8_LDA(At, 0, 1); PG8_STAGE(PG8_SA(0, 0), a2, voffA);
            PG8_BAR; PG8_WAIT_L(0); PG8_MMA(1, 0, At, B0); PG8_BAR; PG8_SCHED;
            PG8_STAGE(PG8_SB(0, 1), b2 + hstepB, voffB);
            PG8_WAIT_V(6); PG8_BAR; PG8_MMA(1, 1, At, B1); PG8_BAR;
            PG8_LDB(B0, 1, 0); PG8_SCHED; PG8_LDA(At, 1, 0); PG8_STAGE(PG8_SA(0, 1), a2 + hstepA, voffA);
            PG8_WAIT_L(8); PG8_BAR; PG8_WAIT_L(0); PG8_MMA(0, 0, At, B0); PG8_BAR; PG8_SCHED;
            PG8_LDB(B1, 1, 1); PG8_STAGE(PG8_SB(1, 0), b3, voffB);
            PG8_BAR; PG8_WAIT_L(0); PG8_MMA(0, 1, At, B1); PG8_BAR;
            PG8_LDA(At, 1, 1); PG8_STAGE(PG8_SA(1, 0), a3, voffA);
            PG8_BAR; PG8_WAIT_L(0); PG8_MMA(1, 0, At, B0); PG8_BAR; PG8_SCHED;
            PG8_STAGE(PG8_SB(1, 1), b3 + hstepB, voffB);
            PG8_WAIT_V(6); PG8_BAR; PG8_MMA(1, 1, At, B1); PG8_BAR;
        }
        if constexpr (Epi::MID) { if (hf == 0) E.mid(acc, cur, wr, wc, fr, fq); }
        }
        E(acc, cur, wr, wc, fr, fq);
        if (!has_next) break;
#pragma unroll
        for (int a = 0; a < 2; ++a)
#pragma unroll
            for (int b = 0; b < 2; ++b)
#pragma unroll
                for (int m = 0; m < 4; ++m)
#pragma unroll
                    for (int n = 0; n < 2; ++n) acc[a][b][m][n] = (f32x4){0.f, 0.f, 0.f, 0.f};
        cur = nxt; ++ui;
        cA0 = (const char*)g.A0 + (size_t)cur.pm * tstepA; cA1 = (const char*)g.A1 + (size_t)cur.pm * tstepA;
        cB0 = (const char*)g.B0 + (size_t)cur.pn * tstepB; cB1 = (const char*)g.B1 + (size_t)cur.pn * tstepB;
    }
    PG8_WAIT_V(0);
    if (wr == 0) PG8_BAR;
    PG8_BAR;
#undef PG8_SA
#undef PG8_SB
#undef PG8_STAGE
#undef PG8_LDA
#undef PG8_LDB
#undef PG8_MMA
#undef PG8_WAIT_V
#undef PG8_WAIT_L
#undef PG8_BAR
#undef PG8_SCHED
}
}

struct EpiZ {
    static constexpr bool PERM = true, MID = false;
    unsigned char* ws;
    DI void operator()(const f32x4 (&acc)[2][2][4][2], const pg8::Unit& u, int wr, int wc, int fr, int fq) const {
        const int pn = u.pn; bf16_t* base; int ld, colt;
        if (pn < 8) { base = (bf16_t*)(ws + WS_ZU) + (size_t)pn * S * 256; ld = 256; colt = 0; }
        else if (pn < 16) { base = (bf16_t*)(ws + WS_ZG); ld = 2048; colt = (pn - 8) * 256; }
        else if (pn < 28) { base = (bf16_t*)(ws + WS_ZQKV); ld = 3072; colt = (pn - 16) * 256; }
        else if (pn < 36) { base = (bf16_t*)(ws + WS_ZGA); ld = 2048; colt = (pn - 28) * 256; }
        else { base = (bf16_t*)(ws + WS_ZM) + (size_t)(pn - 36) * S * 256; ld = 256; colt = 0; }
        const bool rope = (pn >= 16 && pn < 26 && wc == 0);
        const int row0 = u.pm * 256 + wr * 64 + fr, col0 = colt + wc * 32 + 8 * fq;
        if (rope) {
            const float* cosT = (const float*)(ws + WS_ROPE) + (size_t)row0 * 16 + 4 * fq; const float* sinT = cosT + (size_t)S * 16;
            f32x4 cs[8], sn[8];
#pragma unroll
            for (int k = 0; k < 8; ++k) { cs[k] = *(const f32x4*)(cosT + ((k >> 2) * 128 + (k & 3) * 16) * 16); sn[k] = *(const f32x4*)(sinT + ((k >> 2) * 128 + (k & 3) * 16) * 16); }
#pragma unroll
            for (int ai = 0; ai < 2; ++ai)
#pragma unroll
                for (int m = 0; m < 4; ++m) {
                    const int row = row0 + ai * 128 + m * 16; const f32x4 c4 = cs[ai * 4 + m], s4 = sn[ai * 4 + m];
#pragma unroll
                    for (int bj = 0; bj < 2; ++bj) {
                        const f32x4 v0 = acc[ai][bj][m][0], v1 = acc[ai][bj][m][1]; f32x4 w0, w1;
                        w0[0] = v0[0] * c4[0] - v0[1] * s4[0]; w0[1] = v0[1] * c4[0] + v0[0] * s4[0];
                        w0[2] = v0[2] * c4[1] - v0[3] * s4[1]; w0[3] = v0[3] * c4[1] + v0[2] * s4[1];
                        w1[0] = v1[0] * c4[2] - v1[1] * s4[2]; w1[1] = v1[1] * c4[2] + v1[0] * s4[2];
                        w1[2] = v1[2] * c4[3] - v1[3] * s4[3]; w1[3] = v1[3] * c4[3] + v1[2] * s4[3];
                        u32x4 w = {cvtpk(w0[0], w0[1]), cvtpk(w0[2], w0[3]), cvtpk(w1[0], w1[1]), cvtpk(w1[2], w1[3])};
                        __builtin_nontemporal_store(w, (u32x4*)(base + (size_t)row * ld + col0 + bj * 128));
                    }
                }
        } else if (pn >= 36) {
            unsigned char* gb = ws + WS_ZM + (size_t)(pn - 36) * S * 256 + (size_t)row0 * 256 + wc * 32 + 8 * fq;
#pragma unroll
            for (int ai = 0; ai < 2; ++ai)
#pragma unroll
                for (int m = 0; m < 4; ++m)
#pragma unroll
                    for (int bj = 0; bj < 2; ++bj) {
                        const f32x4 v0 = acc[ai][bj][m][0], v1 = acc[ai][bj][m][1]; unsigned q[8];
#pragma unroll
                        for (int i = 0; i < 4; ++i) { q[i] = (unsigned)fmaxf(sigm(v0[i]) * 255.f + 0.5f, 1.f); q[4 + i] = (unsigned)fmaxf(sigm(v1[i]) * 255.f + 0.5f, 1.f); }
                        const u32x2 w = {q[0] | (q[1] << 8) | (q[2] << 16) | (q[3] << 24), q[4] | (q[5] << 8) | (q[6] << 16) | (q[7] << 24)};
                        __builtin_nontemporal_store(w, (u32x2*)(gb + (size_t)(ai * 128 + m * 16) * 256 + bj * 128));
                    }
        } else {
#pragma unroll
            for (int ai = 0; ai < 2; ++ai)
#pragma unroll
                for (int m = 0; m < 4; ++m) {
                    const int row = row0 + ai * 128 + m * 16;
#pragma unroll
                    for (int bj = 0; bj < 2; ++bj) {
                        const f32x4 v0 = acc[ai][bj][m][0], v1 = acc[ai][bj][m][1];
                        u32x4 w = {cvtpk(v0[0], v0[1]), cvtpk(v0[2], v0[3]), cvtpk(v1[0], v1[1]), cvtpk(v1[2], v1[3])};
                        __builtin_nontemporal_store(w, (u32x4*)(base + (size_t)row * ld + col0 + bj * 128));
                    }
                }
        }
    }
};
DI u32x4 ldg128(const void* base, unsigned boff) { return *(const u32x4*)((const char*)base + boff); }
DI void stg128(void* base, unsigned boff, u32x4 v) { *(u32x4*)((char*)base + boff) = v; }
template <int STEP> struct EpiMerge {
    static constexpr bool PERM = true, MID = false;
    unsigned char* ws; unsigned char* tbuf;
    DI void operator()(const f32x4 (&acc)[2][2][4][2], const pg8::Unit& u, int wr, int wc, int fr, int fq) const {
        const unsigned char* zm = ws + WS_ZM; unsigned char* mg = ws + WS_MRG;
        const unsigned r0_ = (unsigned)(u.pm * 256 + wr * 64 + fr), c0_ = (unsigned)(u.pn * 256 + wc * 32 + 8 * fq);
#pragma unroll
        for (int ai = 0; ai < 2; ++ai)
#pragma unroll
            for (int m = 0; m < 4; ++m) {
                const unsigned row = r0_ + ai * 128 + m * 16;
#pragma unroll
                for (int bj = 0; bj < 2; ++bj) {
                    const unsigned col = c0_ + bj * 128;
                    const u32x4 g = ldg128(zm, row * 8192u + (STEP ? 4096u : 0u) + col * 2u);
                    float v[8];
#pragma unroll
                    for (int i = 0; i < 4; ++i) {
                        v[2 * i] = acc[ai][bj][m][i >> 1][(i & 1) * 2] * sigm(bflo(g[i]));
                        v[2 * i + 1] = acc[ai][bj][m][i >> 1][(i & 1) * 2 + 1] * sigm(bfhi(g[i]));
                    }
                    const unsigned tb = row * 8192u + col * 4u;
                    if (STEP == 0) {
                        stg128(tbuf, tb, __builtin_bit_cast(u32x4, (f32x4){v[0], v[1], v[2], v[3]}));
                        stg128(tbuf, tb + 16u, __builtin_bit_cast(u32x4, (f32x4){v[4], v[5], v[6], v[7]}));
                    } else {
                        const f32x4 t0 = __builtin_bit_cast(f32x4, ldg128(tbuf, tb)), t1 = __builtin_bit_cast(f32x4, ldg128(tbuf, tb + 16u));
                        u32x4 w = {cvtpk(v[0] + t0[0], v[1] + t0[1]), cvtpk(v[2] + t0[2], v[3] + t0[3]), cvtpk(v[4] + t1[0], v[5] + t1[1]), cvtpk(v[6] + t1[2], v[7] + t1[3])};
                        stg128(mg, row * 4096u + col * 2u, w);
                    }
                }
                asm volatile("" ::: "memory");
            }
    }
};

DI float ub(unsigned w, int i) { return (float)((w >> (8 * i)) & 0xffu); }
struct EpiMergeMid {
    static constexpr bool PERM = true, MID = true;
    unsigned char* ws;
    DI void mid(f32x4 (&acc)[2][2][4][2], const pg8::Unit& u, int wr, int wc, int fr, int fq) const {
        const unsigned char* zm = ws + WS_ZM;
        unsigned b0_ = (unsigned)u.pn * (unsigned)(S * 256) + (unsigned)(u.pm * 256 + wr * 64 + fr) * 256u + (unsigned)(wc * 32 + 8 * fq);
        asm volatile("" : "+v"(b0_));
        u32x2 g1[2][4][2], g2[2][4][2];
#pragma unroll
        for (int ai = 0; ai < 2; ++ai)
#pragma unroll
            for (int m = 0; m < 4; ++m)
#pragma unroll
                for (int bj = 0; bj < 2; ++bj) { const unsigned bo = b0_ + (unsigned)(ai * 128 + m * 16) * 256u + bj * 128u;
                    g1[ai][m][bj] = *(const u32x2*)(zm + bo); g2[ai][m][bj] = *(const u32x2*)(zm + bo + (unsigned)(8 * S * 256)); }
#pragma unroll
        for (int ai = 0; ai < 2; ++ai)
#pragma unroll
            for (int m = 0; m < 4; ++m)
#pragma unroll
                for (int bj = 0; bj < 2; ++bj)
#pragma unroll
                    for (int e = 0; e < 8; ++e)
                        acc[ai][bj][m][e >> 2][e & 3] *= ub(g1[ai][m][bj][e >> 2], e & 3) * rcpf_(ub(g2[ai][m][bj][e >> 2], e & 3));
    }
    DI void operator()(const f32x4 (&acc)[2][2][4][2], const pg8::Unit& u, int wr, int wc, int fr, int fq) const {
        const unsigned char* zm = ws + WS_ZM; unsigned char* mg = ws + WS_MRG;
        unsigned r0_ = (unsigned)(u.pm * 256 + wr * 64 + fr), c0_ = (unsigned)(wc * 32 + 8 * fq);
        asm volatile("" : "+v"(r0_), "+v"(c0_));
        u32x2 g2[2][4][2];
#pragma unroll
        for (int ai = 0; ai < 2; ++ai)
#pragma unroll
            for (int m = 0; m < 4; ++m)
#pragma unroll
                for (int bj = 0; bj < 2; ++bj) g2[ai][m][bj] = *(const u32x2*)(zm + (unsigned)(8 + u.pn) * (unsigned)(S * 256) + (r0_ + ai * 128 + m * 16) * 256u + c0_ + bj * 128u);
#pragma unroll
        for (int ai = 0; ai < 2; ++ai)
#pragma unroll
            for (int m = 0; m < 4; ++m) {
                const unsigned row = r0_ + ai * 128 + m * 16;
#pragma unroll
                for (int bj = 0; bj < 2; ++bj) {
                    float v[8];
#pragma unroll
                    for (int e = 0; e < 8; ++e) v[e] = acc[ai][bj][m][e >> 2][e & 3] * (ub(g2[ai][m][bj][e >> 2], e & 3) * (1.f / 255.f));
                    u32x4 w = {cvtpk(v[0], v[1]), cvtpk(v[2], v[3]), cvtpk(v[4], v[5]), cvtpk(v[6], v[7])};
                    stg128(mg, row * 4096u + ((unsigned)u.pn * 256u + c0_) * 2u + bj * 256u, w);
                }
            }
    }
};
struct EpiOut {
    static constexpr bool PERM = true, MID = false;
    unsigned char* ws;
    DI void operator()(const f32x4 (&acc)[2][2][4][2], const pg8::Unit& u, int wr, int wc, int fr, int fq) const {
        unsigned char* o2 = ws + WS_OUT2; float* ssq = (float*)(ws + WS_SSQ);
        const unsigned r0_ = (unsigned)(u.pm * 256 + wr * 64 + fr), c0_ = (unsigned)(u.pn * 256 + wc * 32 + 8 * fq) * 2u;
#pragma unroll
        for (int ai = 0; ai < 2; ++ai)
#pragma unroll
            for (int m = 0; m < 4; ++m) {
                const unsigned row = r0_ + ai * 128 + m * 16; float s = 0.f;
#pragma unroll
                for (int bj = 0; bj < 2; ++bj) {
                    const f32x4 v0 = acc[ai][bj][m][0], v1 = acc[ai][bj][m][1];
                    s += v0[0] * v0[0] + v0[1] * v0[1] + v0[2] * v0[2] + v0[3] * v0[3] + v1[0] * v1[0] + v1[1] * v1[1] + v1[2] * v1[2] + v1[3] * v1[3];
                    u32x4 w = {cvtpk(v0[0], v0[1]), cvtpk(v0[2], v0[3]), cvtpk(v1[0], v1[1]), cvtpk(v1[2], v1[3])};
                    stg128(o2, row * 4096u + c0_ + bj * 256u, w);
                }
                s += __shfl_xor(s, 16); s += __shfl_xor(s, 32);
                if (fq == 0) ssq[(size_t)row * 32 + u.pn * 4 + wc] = s;
            }
    }
};

struct TJob { const float* src; bf16_t* dst; int ld_src, ld_dst, k0, n0, perm, pad_; };
DI void tr_load(const TJob& j, f32x4& v0, f32x4& v1) {
    const int t = threadIdx.x, kl = t >> 4, nl = (t & 15) * 4;
    v0 = *(const f32x4*)(j.src + (size_t)(j.k0 + kl) * j.ld_src + j.n0 + nl);
    v1 = *(const f32x4*)(j.src + (size_t)(j.k0 + kl + 32) * j.ld_src + j.n0 + nl);
}
DI void tr_store(const TJob& j, const f32x4 v0, const f32x4 v1, float* sT) {
    const int t = threadIdx.x;
    { const int kl = t >> 4, nl = (t & 15) * 4;
      sT[kl * 65 + nl] = v0[0]; sT[kl * 65 + nl + 1] = v0[1]; sT[kl * 65 + nl + 2] = v0[2]; sT[kl * 65 + nl + 3] = v0[3];
      sT[(kl + 32) * 65 + nl] = v1[0]; sT[(kl + 32) * 65 + nl + 1] = v1[1]; sT[(kl + 32) * 65 + nl + 2] = v1[2]; sT[(kl + 32) * 65 + nl + 3] = v1[3]; }
    __syncthreads();
    { const int nl = t >> 3, kc = (t & 7) * 8; int ns = nl;
      if (j.perm && nl < 32) ns = (nl & 1) ? 16 + (nl >> 1) : (nl >> 1);
      float q[8];
#pragma unroll
      for (int i = 0; i < 8; ++i) q[i] = sT[(kc + i) * 65 + ns];
      u32x4 w = {cvtpk(q[0], q[1]), cvtpk(q[2], q[3]), cvtpk(q[4], q[5]), cvtpk(q[6], q[7])};
      *(u32x4*)(j.dst + (size_t)(j.n0 + nl) * j.ld_dst + j.k0 + kc) = w; }
    __syncthreads();
}
DI TJob win_job(const Params& p, int j) {
    TJob r; const int nt = j >> 5, kt = j & 31, n0 = nt * 64;
    r.src = p.in[2]; r.dst = (bf16_t*)((unsigned char*)p.out + DO_WINT); r.ld_src = NIN; r.ld_dst = DM; r.k0 = kt * 64; r.n0 = n0;
    r.perm = (n0 >= 4096 && n0 < 6656 && (n0 & 127) == 0) ? 1 : 0; r.pad_ = 0; return r;
}
DI TJob small_job(const Params& p, int j) {
    TJob r; constexpr int J_SQ = 32 * 32;
    if (j < 3 * J_SQ) { const int which = j >> 10, q = j & 1023, nt = q >> 5, kt = q & 31;
        r.src = p.in[11 + which]; r.dst = (bf16_t*)(p.ws + (which == 0 ? WS_WAT : which == 1 ? WS_WBT : WS_WOT)); r.ld_src = DM; r.ld_dst = DM; r.k0 = kt * 64; r.n0 = nt * 64; }
    else { const int jj = j - 3 * J_SQ, gate = jj >> 7, q = jj & 127, blk = q >> 2, sub = q & 3, d = blk >> 4, nb = blk & 15;
        r.src = p.in[gate == 0 ? 5 : 7] + (size_t)blk * 16384; r.dst = (bf16_t*)(p.ws + WS_LWT) + (size_t)((d * 2 + gate) * 16 + nb) * 16384;
        r.ld_src = 128; r.ld_dst = 128; r.k0 = (sub >> 1) * 64; r.n0 = (sub & 1) * 64; }
    r.perm = 0; r.pad_ = 0; return r;
}
DI void phase_prep(const Params& p, unsigned char* shm) {
    const int tid = threadIdx.x, wid = tid >> 6, lane = tid & 63;
    bf16_t* xn = (bf16_t*)((unsigned char*)p.out + DO_XN);
    {
        const float* x = p.in[0]; const float* nw = p.in[1];
        f32x4 w[8];
#pragma unroll
        for (int i = 0; i < 8; ++i) w[i] = *(const f32x4*)(nw + i * 256 + lane * 4);
        for (int row = (blockIdx.x * 8 + wid) * 2; row < S; row += gridDim.x * 16) {
            f32x4 v[2][8];
#pragma unroll
            for (int r = 0; r < 2; ++r)
#pragma unroll
                for (int i = 0; i < 8; ++i) v[r][i] = __builtin_nontemporal_load((const f32x4*)(x + (size_t)(row + r) * DM + i * 256 + lane * 4));
#pragma unroll
            for (int r = 0; r < 2; ++r) {
                float ss = 0.f;
#pragma unroll
                for (int i = 0; i < 8; ++i) ss += v[r][i][0] * v[r][i][0] + v[r][i][1] * v[r][i][1] + v[r][i][2] * v[r][i][2] + v[r][i][3] * v[r][i][3];
                ss = wave_sum(ss);
                const float rs = rsqrtf(ss * (1.f / DM) + EPS);
#pragma unroll
                for (int i = 0; i < 8; ++i) {
                    u32x2 o = {cvtpk(v[r][i][0] * rs * w[i][0], v[r][i][1] * rs * w[i][1]), cvtpk(v[r][i][2] * rs * w[i][2], v[r][i][3] * rs * w[i][3])};
                    *(u32x2*)(xn + (size_t)(row + r) * DM + i * 256 + lane * 4) = o; }
            }
        }
    }
    {
        float* cosT = (float*)(p.ws + WS_ROPE); float* sinT = cosT + (size_t)S * 16;
        for (int i = blockIdx.x * 512 + tid; i < S * 16; i += gridDim.x * 512) {
            const int pos = i >> 4, j = i & 15;
            const float ang = (float)pos * p.inv_freq[j];
            const double rev = (double)ang * 0.15915494309189535; const float fr = (float)(rev - rint(rev));
            cosT[i] = __builtin_amdgcn_cosf(fr); sinT[i] = __builtin_amdgcn_sinf(fr);
        }
    }
    {
        float* sT = (float*)shm; constexpr int NG = 208 * 8;
        const float* src = p.in[2]; bf16_t* dst = (bf16_t*)((unsigned char*)p.out + DO_WINT);
        const int t = threadIdx.x, kl = t >> 4, nl4 = (t & 15) * 4, onl = t >> 3, okc = (t & 7) * 8;
        int g = blockIdx.x;
        if (g < NG) {
            f32x4 v[8];
#pragma unroll
            for (int q = 0; q < 8; ++q) v[q] = __builtin_nontemporal_load((const f32x4*)(src + (size_t)((g & 7) * 256 + q * 32 + kl) * NIN + (g >> 3) * 64 + nl4));
            for (;;) {
                const int gn = g + (int)gridDim.x; const bool more = gn < NG; const int gl = more ? gn : g;
                f32x4 vn[8];
#pragma unroll
                for (int q = 0; q < 8; ++q) vn[q] = __builtin_nontemporal_load((const f32x4*)(src + (size_t)((gl & 7) * 256 + q * 32 + kl) * NIN + (gl >> 3) * 64 + nl4));
#pragma unroll
                for (int q = 0; q < 8; ++q) { float* d = sT + (q * 32 + kl) * 65 + nl4; d[0] = v[q][0]; d[1] = v[q][1]; d[2] = v[q][2]; d[3] = v[q][3]; }
                __syncthreads();
                { const int n0 = (g >> 3) * 64, k0 = (g & 7) * 256; int ns = onl;
                  if (n0 >= 4096 && n0 < 6656 && (n0 & 127) == 0 && onl < 32) ns = (onl & 1) ? 16 + (onl >> 1) : (onl >> 1);
#pragma unroll
                  for (int q = 0; q < 4; ++q) { float f[8];
#pragma unroll
                      for (int i = 0; i < 8; ++i) f[i] = sT[(q * 64 + okc + i) * 65 + ns];
                      *(u32x4*)(dst + (size_t)(n0 + onl) * DM + k0 + q * 64 + okc) = (u32x4){cvtpk(f[0], f[1]), cvtpk(f[2], f[3]), cvtpk(f[4], f[5]), cvtpk(f[6], f[7])}; } }
                __syncthreads();
                if (!more) break;
#pragma unroll
                for (int q = 0; q < 8; ++q) v[q] = vn[q];
                g = gn;
            }
        }
    }
}
DI void prep_small_weights(const Params& p, unsigned char* shm, int idx, int stride) {
    float* sT = (float*)shm; constexpr int NJ = 3 * 1024 + 256;
    int j = idx;
    if (j < NJ) {
        TJob cur = small_job(p, j); f32x4 v0, v1; tr_load(cur, v0, v1);
        for (;;) {
            const int jn = j + stride; const bool more = jn < NJ;
            const TJob nxt = small_job(p, more ? jn : j); f32x4 n0, n1; tr_load(nxt, n0, n1);
            tr_store(cur, v0, v1, sT);
            if (!more) break;
            cur = nxt; v0 = n0; v1 = n1; j = jn;
        }
    }
}

DI void lru_copy_out(const bf16_t* OS, bf16_t* dst_tile, int t) {
    const int row = t >> 2, seg = (t & 3) * 32;
#pragma unroll
    for (int k = 0; k < 4; ++k) { const u32x4 v = *(const u32x4*)(OS + row * 136 + seg + k * 8); *(u32x4*)(dst_tile + (size_t)row * 2048 + seg + k * 8) = v; }
}
DI void lru_tile(const Params& p, unsigned char* shm, int c, int nb) {
    int tid = threadIdx.x; asm volatile("" : "+v"(tid));
    const int wid = __builtin_amdgcn_readfirstlane(tid >> 6), lane = tid & 63;
    constexpr int LDU = 136;
    bf16_t* UB = (bf16_t*)shm;
    bf16_t* PS = (bf16_t*)(shm + 34816);
    bf16_t* OS = (bf16_t*)(shm + 2 * 34816);
    f32x2* AG = (f32x2*)(shm + 3 * 34816) + wid * 512;
    const bf16_t* ZU = (const bf16_t*)(p.ws + WS_ZU);
    {
        const int cgp = tid & 15, rg = tid >> 4, ch = nb * 128 + cgp * 8;
        const float* cw = p.in[3]; const float* cb = p.in[4];
        float w[4][8], bias[8];
#pragma unroll
        for (int tp = 0; tp < 4; ++tp) { const f32x4 a = *(const f32x4*)(cw + tp * 2048 + ch), b = *(const f32x4*)(cw + tp * 2048 + ch + 4);
            w[tp][0] = a[0]; w[tp][1] = a[1]; w[tp][2] = a[2]; w[tp][3] = a[3]; w[tp][4] = b[0]; w[tp][5] = b[1]; w[tp][6] = b[2]; w[tp][7] = b[3]; }
        { const f32x4 a = *(const f32x4*)(cb + ch), b = *(const f32x4*)(cb + ch + 4);
            bias[0] = a[0]; bias[1] = a[1]; bias[2] = a[2]; bias[3] = a[3]; bias[4] = b[0]; bias[5] = b[1]; bias[6] = b[2]; bias[7] = b[3]; }
        float xr[7][8];
#pragma unroll
        for (int k = 0; k < 7; ++k) { const int t = c * 128 + rg * 4 - 2 + k;
            u32x4 v = {0u, 0u, 0u, 0u};
            if (t >= 0 && t < S) v = *(const u32x4*)(ZU + (size_t)(nb >> 1) * S * 256 + (size_t)t * 256 + (nb & 1) * 128 + cgp * 8);
#pragma unroll
            for (int i = 0; i < 4; ++i) { xr[k][2 * i] = bflo(v[i]); xr[k][2 * i + 1] = bfhi(v[i]); } }
#pragma unroll
        for (int o = 0; o < 4; ++o) { float u8[8];
#pragma unroll
            for (int i = 0; i < 8; ++i) { float a = bias[i];
#pragma unroll
                for (int tp = 0; tp < 4; ++tp) a += xr[o + tp][i] * w[tp][i];
                u8[i] = a; }
            *(u32x4*)(UB + (rg * 4 + o) * LDU + cgp * 8) = (u32x4){cvtpk(u8[0], u8[1]), cvtpk(u8[2], u8[3]), cvtpk(u8[4], u8[5]), cvtpk(u8[6], u8[7])};
        }
    }
    __syncthreads();
    const int col = lane & 15, q = lane >> 4;
    const int chl = wid * 16 + col, chg = nb * 128 + chl;
    float hsum[8][4]; unsigned ppk[8][2];
    f32x2* AGG = (f32x2*)(p.ws + WS_AGG);
    const bf16_t* LWT = (const bf16_t*)(p.ws + WS_LWT);
#pragma unroll
    for (int d = 0; d < 2; ++d) {
        f32x4 acc[2][8];
#pragma unroll
        for (int a = 0; a < 2; ++a)
#pragma unroll
            for (int b = 0; b < 8; ++b) acc[a][b] = (f32x4){0.f, 0.f, 0.f, 0.f};
        bf16x8 bfr[4][2];
#pragma unroll
        for (int s = 0; s < 4; ++s)
#pragma unroll
            for (int gt = 0; gt < 2; ++gt) bfr[s][gt] = *(const bf16x8*)(LWT + ((size_t)((d * 2 + gt) * 16 + nb) * 128 + chl) * 128 + s * 32 + q * 8);
        const float br = p.in[6][d * 2048 + chg], bi = p.in[8][d * 2048 + chg], lam = p.in[9][d * 2048 + chg];
#pragma unroll
        for (int s = 0; s < 4; ++s) {
#pragma unroll
            for (int rt = 0; rt < 8; ++rt) {
                const bf16x8 af = *(const bf16x8*)(UB + (rt * 16 + col) * LDU + s * 32 + q * 8);
#pragma unroll
                for (int gt = 0; gt < 2; ++gt) acc[gt][rt] = __builtin_amdgcn_mfma_f32_16x16x32_bf16(af, bfr[s][gt], acc[gt][rt], 0, 0, 0);
            }
            __builtin_amdgcn_sched_barrier(0);
        }
        const float sp = log1pf(expf(-lam));
        const float cdec = -8.f * sp * LOG2E;
        const f32x2 nl2 = {-LOG2E, -LOG2E}, nbr2 = {-br * LOG2E, -br * LOG2E}, nbi2 = {-bi * LOG2E, -bi * LOG2E}, cd2 = {cdec, cdec}, one2 = {1.f, 1.f};
        float hl[8][4], pc[8][4];
#pragma unroll
        for (int rt = 0; rt < 8; ++rt) {
            float av[4], bv[4];
#pragma unroll
            for (int jp = 0; jp < 2; ++jp) {
                const f32x2 xr = {acc[0][rt][2 * jp], acc[0][rt][2 * jp + 1]}, xi = {acc[1][rt][2 * jp], acc[1][rt][2 * jp + 1]};
                f32x2 er = xr * nl2 + nbr2, ei = xi * nl2 + nbi2;
                er = (f32x2){ex2(er[0]), ex2(er[1])} + one2; ei = (f32x2){ex2(ei[0]), ex2(ei[1])} + one2;
                const f32x2 r = {rcpf_(er[0]), rcpf_(er[1])}, ig = {rcpf_(ei[0]), rcpf_(ei[1])};
                const f32x2 la = r * cd2;
                const f32x2 a = {ex2(la[0]), ex2(la[1])};
                const f32x2 om = one2 - a * a;
                const f32x2 sc = {__builtin_amdgcn_sqrtf(om[0]), __builtin_amdgcn_sqrtf(om[1])};
                const f32x2 u2 = {bf2f(UB[(rt * 16 + 4 * q + 2 * jp) * LDU + chl]), bf2f(UB[(rt * 16 + 4 * q + 2 * jp + 1) * LDU + chl])};
                const f32x2 b2 = sc * ig * u2;
                av[2 * jp] = a[0]; av[2 * jp + 1] = a[1]; bv[2 * jp] = b2[0]; bv[2 * jp + 1] = b2[1];
            }
            float h = 0.f, P = 1.f;
            if (d == 0) {
#pragma unroll
                for (int j = 0; j < 4; ++j) { h = fmaf(av[j], h, bv[j]); P *= av[j]; hl[rt][j] = h; pc[rt][j] = P; }
            } else {
#pragma unroll
                for (int j = 3; j >= 0; --j) { h = fmaf(av[j], h, bv[j]); P *= av[j]; hl[rt][j] = h; pc[rt][j] = P; }
            }
            AG[(rt * 4 + q) * 16 + col] = (f32x2){P, h};
            __builtin_amdgcn_sched_barrier(0);
        }
        asm volatile("s_waitcnt lgkmcnt(0)" ::: "memory");
        float carry[8], pref[8]; float cin = 0.f, pa = 1.f;
#pragma unroll
        for (int gi = 0; gi < 32; ++gi) {
            const int G = d == 0 ? gi : 31 - gi; const int rt = G >> 2, qq = G & 3;
            const f32x2 ah = AG[G * 16 + col];
            if (qq == q) { carry[rt] = cin; pref[rt] = pa; }
            cin = fmaf(ah[0], cin, ah[1]); pa *= ah[0];
        }
        if (q == 0) AGG[((size_t)d * 128 + c) * 2048 + chg] = (f32x2){pa, cin};
#pragma unroll
        for (int rt = 0; rt < 8; ++rt) {
            const f32x2 cr2 = {carry[rt], carry[rt]}, pf2 = {pref[rt] * 255.f, pref[rt] * 255.f}, half2 = {0.5f, 0.5f};
#pragma unroll
            for (int jp = 0; jp < 2; ++jp) {
                const f32x2 pc2 = {pc[rt][2 * jp], pc[rt][2 * jp + 1]}, hl2 = {hl[rt][2 * jp], hl[rt][2 * jp + 1]};
                const f32x2 hf = pc2 * cr2 + hl2, pq = pc2 * pf2 + half2;
                const unsigned q0 = (unsigned)pq[0], q1 = (unsigned)pq[1];
                if (d == 0) { hsum[rt][2 * jp] = hf[0]; hsum[rt][2 * jp + 1] = hf[1]; ppk[rt][jp] = q0 | (q1 << 16); }
                else {
                    const int lo = (rt * 16 + 4 * q + 2 * jp) * LDU + chl;
                    const unsigned w = cvtpk(hsum[rt][2 * jp] + hf[0], hsum[rt][2 * jp + 1] + hf[1]);
                    OS[lo] = (unsigned short)(w & 0xffffu); OS[lo + LDU] = (unsigned short)(w >> 16);
                    const unsigned pw = ppk[rt][jp] | (q0 << 8) | (q1 << 24);
                    PS[lo] = (unsigned short)(pw & 0xffffu); PS[lo + LDU] = (unsigned short)(pw >> 16);
                }
            }
            __builtin_amdgcn_sched_barrier(0);
        }
    }
    __syncthreads();
    lru_copy_out(OS, (bf16_t*)((unsigned char*)p.out + DO_ACF) + (size_t)c * 128 * 2048 + nb * 128, tid);
    lru_copy_out(PS, (bf16_t*)((unsigned char*)p.out + DO_ACB) + (size_t)c * 128 * 2048 + nb * 128, tid);
}

namespace att {
constexpr float SCALE = 0.088388347648318440f, THR = 8.f;
constexpr int SHM_V = 64 * 128 * 2, SHM_K = SHM_V, LDK = 3072;
#define KSWZ(row, colB) ((row) * 256 + ((colB) ^ (((row) & 7) << 4)))
#define SBAR() __builtin_amdgcn_sched_barrier(0)
DI int crow(int r, int hi) { return (r & 3) + 8 * (r >> 2) + 4 * hi; }
DI void maskT(f32x16& p0, f32x16& p1, int kt, int qw, int r32, int hi) {
    if ((kt - qw - 31 < -128) || (kt + 63 - qw > 128)) {
        const int db = kt - (qw + r32) + 4 * hi;
#pragma unroll
        for (int r = 0; r < 16; ++r) { const int d = db + (r & 3) + 8 * (r >> 2);
            p0[r] = (d >= -128 && d <= 128) ? p0[r] : -1e30f; p1[r] = (d + 32 >= -128 && d + 32 <= 128) ? p1[r] : -1e30f; }
    }
}
DI void partialSM(f32x16& p0, f32x16& p1, float& m_reg, float& mn, float& alpha) {
    constexpr float C = SCALE * 1.4426950408889634f;
    float pmax = p0[0];
#pragma unroll
    for (int r = 1; r < 16; ++r) pmax = fmaxf(pmax, p0[r]);
#pragma unroll
    for (int r = 0; r < 16; ++r) pmax = fmaxf(pmax, p1[r]);
    { auto rr = __builtin_amdgcn_permlane32_swap(__float_as_uint(pmax), __float_as_uint(pmax), false, false);
      pmax = fmaxf(__uint_as_float(rr[0]), __uint_as_float(rr[1])); }
    if (__builtin_expect(__all(pmax - m_reg <= THR / SCALE), 1)) { mn = m_reg; alpha = 1.f; }
    else { mn = fmaxf(m_reg, pmax); alpha = __builtin_amdgcn_exp2f((m_reg - mn) * C); m_reg = mn; }
    const float mnC = -mn * C;
#pragma unroll
    for (int r = 0; r < 16; ++r) p0[r] = fmaf(p0[r], C, mnC);
#pragma unroll
    for (int r = 0; r < 16; ++r) p1[r] = fmaf(p1[r], C, mnC);
#pragma unroll
    for (int r = 0; r < 16; ++r) p0[r] = __builtin_amdgcn_exp2f(p0[r]);
}
DI void finishSM(f32x16& p0, f32x16& p1, float alpha, float& l_reg, bf16x8& pa0, bf16x8& pa1, bf16x8& pa2, bf16x8& pa3) {
#pragma unroll
    for (int r = 0; r < 16; ++r) p1[r] = __builtin_amdgcn_exp2f(p1[r]);
    float ps = 0;
#pragma unroll
    for (int r = 0; r < 16; ++r) ps += p0[r];
#pragma unroll
    for (int r = 0; r < 16; ++r) ps += p1[r];
    { auto rr = __builtin_amdgcn_permlane32_swap(__float_as_uint(ps), __float_as_uint(ps), false, false);
      ps = __uint_as_float(rr[0]) + __uint_as_float(rr[1]); }
    l_reg = l_reg * alpha + ps;
#define PK4(P, BASE, OUT) do { unsigned a0 = cvtpk(P[BASE + 0], P[BASE + 1]), a1 = cvtpk(P[BASE + 2], P[BASE + 3]);   \
    unsigned b0 = cvtpk(P[BASE + 4], P[BASE + 5]), b1 = cvtpk(P[BASE + 6], P[BASE + 7]);                              \
    auto r0 = __builtin_amdgcn_permlane32_swap(a0, b0, false, false); auto r1 = __builtin_amdgcn_permlane32_swap(a1, b1, false, false); \
    u32x4 w = {r0[0], r1[0], r0[1], r1[1]}; OUT = __builtin_bit_cast(bf16x8, w); } while (0)
    PK4(p0, 0, pa0); PK4(p0, 8, pa1); PK4(p1, 0, pa2); PK4(p1, 8, pa3);
#undef PK4
}
DI void qkt(f32x16& p0, f32x16& p1, const char* Ks, const bf16x8* qr, int r32, int hi) {
#pragma unroll
    for (int i = 0; i < 16; ++i) { p0[i] = 0.f; p1[i] = 0.f; }
#pragma unroll
    for (int d0 = 0; d0 < 8; ++d0) { const int cb = (d0 * 16 + hi * 8) * 2;
        const bf16x8 b0 = *reinterpret_cast<const bf16x8*>(Ks + KSWZ(r32, cb));
        const bf16x8 b1 = *reinterpret_cast<const bf16x8*>(Ks + KSWZ(32 + r32, cb));
        p0 = __builtin_amdgcn_mfma_f32_32x32x16_bf16(b0, qr[d0], p0, 0, 0, 0);
        p1 = __builtin_amdgcn_mfma_f32_32x32x16_bf16(b1, qr[d0], p1, 0, 0, 0); }
}
DI int v_st(int k, int c) { const int kk = (k & ~0xC) | ((k & 4) << 1) | ((k & 8) >> 1); return ((kk >> 3) * 4 + (c >> 5)) * 512 + ((kk & 7) * 32 + (c & 31)) * 2; }
DI int v_rd_base(int lane) { return ((lane & 3) << 3) | (((lane >> 2) & 3) << 6) | (((lane >> 4) & 1) << 5) | (((lane >> 5) & 1) << 8); }
constexpr int v_rd_off(int d0, int ks, int half) { return d0 * 512 + ks * 4096 + half * 2048; }
template <int OFF> DI s16x4 tr_read(int vb) {
    s16x4 r; asm volatile("ds_read_b64_tr_b16 %0, %1 offset:%2" : "=&v"(r) : "v"(vb), "i"(OFF) : "memory"); return r;
}
template <int D0> DI void pv_one(f32x16& od, int vb, bf16x8 pa0, bf16x8 pa1, bf16x8 pa2, bf16x8 pa3) {
    const s16x4 l0 = tr_read<v_rd_off(D0, 0, 0)>(vb), h0 = tr_read<v_rd_off(D0, 0, 1)>(vb), l1 = tr_read<v_rd_off(D0, 1, 0)>(vb), h1 = tr_read<v_rd_off(D0, 1, 1)>(vb);
    const s16x4 l2 = tr_read<v_rd_off(D0, 2, 0)>(vb), h2 = tr_read<v_rd_off(D0, 2, 1)>(vb), l3 = tr_read<v_rd_off(D0, 3, 0)>(vb), h3 = tr_read<v_rd_off(D0, 3, 1)>(vb);
    asm volatile("s_waitcnt lgkmcnt(0)" ::: "memory"); SBAR();
#define PK(L, H) (bf16x8){L[0], L[1], L[2], L[3], H[0], H[1], H[2], H[3]}
    od = __builtin_amdgcn_mfma_f32_32x32x16_bf16(pa0, PK(l0, h0), od, 0, 0, 0);
    od = __builtin_amdgcn_mfma_f32_32x32x16_bf16(pa1, PK(l1, h1), od, 0, 0, 0);
    od = __builtin_amdgcn_mfma_f32_32x32x16_bf16(pa2, PK(l2, h2), od, 0, 0, 0);
    od = __builtin_amdgcn_mfma_f32_32x32x16_bf16(pa3, PK(l3, h3), od, 0, 0, 0);
#undef PK
}
DI void pv_d0(f32x16* o, int vb, bf16x8 pa0, bf16x8 pa1, bf16x8 pa2, bf16x8 pa3) {
    pv_one<0>(o[0], vb, pa0, pa1, pa2, pa3); pv_one<1>(o[1], vb, pa0, pa1, pa2, pa3); pv_one<2>(o[2], vb, pa0, pa1, pa2, pa3); pv_one<3>(o[3], vb, pa0, pa1, pa2, pa3);
}
DI void attn_item(const bf16_t* __restrict__ Qw_, const bf16_t* __restrict__ Kh, const bf16_t* __restrict__ Vh, const bf16_t* Gw, bf16_t* Ow,
                  int NT, int kt0, int qw, float sinkv, char* lds) {
    const int tid = threadIdx.x, wid = __builtin_amdgcn_readfirstlane(tid >> 6), lane = tid & 63, r32 = lane & 31, hi = lane >> 5;
    char* V_lds = lds; char* K_lds = lds + 2 * SHM_V;
    float* wsp = (float*)(lds + 2 * SHM_V + 2 * SHM_K) + wid * 64; float* li_l = wsp; float* al_l = wsp + 32;
    float m_reg = sinkv * (1.f / SCALE), l_reg = 1.f; f32x16 o[4]; bf16x8 qr[8];
#pragma unroll
    for (int d = 0; d < 4; ++d)
#pragma unroll
        for (int r = 0; r < 16; ++r) o[d][r] = 0.f;
    const bf16_t* Qw = Qw_ + (size_t)r32 * LDK + hi * 8;
#pragma unroll
    for (int d0 = 0; d0 < 8; ++d0) qr[d0] = *(const bf16x8*)(Qw + d0 * 16);
    const int sr = tid >> 4, sc = (tid & 15) * 8, vst0 = v_st(sr, sc), vst1 = v_st(32 + sr, sc);
    const int vb0 = (int)(uintptr_t)V_lds + v_rd_base(lane);
    struct { bf16x8 vs0, vs1, ks0, ks1; } sr_[2];
#define SLOAD(i, k0) do { sr_[i].vs0 = *(const bf16x8*)(&Vh[(size_t)((k0) + sr) * LDK + sc]); sr_[i].vs1 = *(const bf16x8*)(&Vh[(size_t)((k0) + 32 + sr) * LDK + sc]); \
    sr_[i].ks0 = *(const bf16x8*)(&Kh[(size_t)((k0) + sr) * LDK + sc]); sr_[i].ks1 = *(const bf16x8*)(&Kh[(size_t)((k0) + 32 + sr) * LDK + sc]); } while (0)
#define SWRITE(b, i) do { *(bf16x8*)(V_lds + (b) * SHM_V + vst0) = sr_[i].vs0;          \
    *(bf16x8*)(V_lds + (b) * SHM_V + vst1) = sr_[i].vs1; const int kc = sc * 2;               \
    *(bf16x8*)(K_lds + (b) * SHM_K + KSWZ(sr, kc)) = sr_[i].ks0;                       \
    *(bf16x8*)(K_lds + (b) * SHM_K + KSWZ(32 + sr, kc)) = sr_[i].ks1; } while (0)
#define SWAIT() asm volatile("s_waitcnt vmcnt(4)" ::: "memory")
#define RESC(a) do { if (__any((a) < 1.f)) { if (hi == 0) al_l[r32] = (a); asm volatile("s_waitcnt lgkmcnt(0)" ::: "memory"); \
    _Pragma("unroll") for (int d = 0; d < 4; ++d) _Pragma("unroll") for (int r = 0; r < 16; ++r) o[d][r] *= al_l[crow(r, hi)]; } } while (0)
    f32x16 pA0, pA1, pB0, pB1; float mnA, mnB, alA, alB; bf16x8 pa0, pa1, pa2, pa3;
    constexpr int SE = 0, SO = 1;
    SLOAD(SE, 0); asm volatile("s_waitcnt vmcnt(0)" ::: "memory"); SWRITE(0, SE); __syncthreads();
    qkt(pA0, pA1, K_lds, qr, r32, hi); maskT(pA0, pA1, kt0, qw, r32, hi); partialSM(pA0, pA1, m_reg, mnA, alA);
    SLOAD(SO, 64); if (2 < NT) SLOAD(SE, 128);
    SWAIT(); SWRITE(1, SO); __syncthreads();
    for (int j = 1; j + 1 < NT; j += 2) {
        SBAR(); qkt(pB0, pB1, K_lds + SHM_K, qr, r32, hi);
        finishSM(pA0, pA1, alA, l_reg, pa0, pa1, pa2, pa3); SBAR();
        SLOAD(SO, (j + 2) * 64); SBAR();
        pv_d0(o, vb0, pa0, pa1, pa2, pa3); maskT(pB0, pB1, kt0 + 64 * j, qw, r32, hi); partialSM(pB0, pB1, m_reg, mnB, alB);
        __syncthreads(); SWAIT(); SWRITE(0, SE);
        RESC(alB); __syncthreads();
        SBAR(); qkt(pA0, pA1, K_lds, qr, r32, hi);
        finishSM(pB0, pB1, alB, l_reg, pa0, pa1, pa2, pa3); SBAR();
        if (j + 3 < NT) SLOAD(SE, (j + 3) * 64); SBAR();
        pv_d0(o, vb0 + SHM_V, pa0, pa1, pa2, pa3); maskT(pA0, pA1, kt0 + 64 * (j + 1), qw, r32, hi); partialSM(pA0, pA1, m_reg, mnA, alA);
        __syncthreads(); SWAIT(); SWRITE(1, SO);
        RESC(alA); __syncthreads();
    }
    SBAR(); qkt(pB0, pB1, K_lds + SHM_K, qr, r32, hi);
    finishSM(pA0, pA1, alA, l_reg, pa0, pa1, pa2, pa3); SBAR();
    pv_d0(o, vb0, pa0, pa1, pa2, pa3); maskT(pB0, pB1, kt0 + 64 * (NT - 1), qw, r32, hi); partialSM(pB0, pB1, m_reg, mnB, alB);
    __syncthreads(); RESC(alB);
    finishSM(pB0, pB1, alB, l_reg, pa0, pa1, pa2, pa3); SBAR();
    pv_d0(o, vb0 + SHM_V, pa0, pa1, pa2, pa3);
    int lane2 = threadIdx.x & 63; asm volatile("" : "+v"(lane2));
    const int ec = lane2 & 15, er = lane2 >> 4;
    if (hi == 0) li_l[r32] = l_reg; asm volatile("s_waitcnt lgkmcnt(0)" ::: "memory");
    bf16_t* OT = (bf16_t*)(lds + 67584 + wid * 8704);
#pragma unroll
    for (int r = 0; r < 16; ++r) { const int orow = crow(r, hi); const float rl = __builtin_amdgcn_rcpf(li_l[orow]);
#pragma unroll
        for (int d0 = 0; d0 < 4; ++d0) OT[orow * 136 + d0 * 32 + r32] = f2bf(o[d0][r] * rl); }
    __builtin_amdgcn_sched_barrier(0);
    u32x4 gv[8];
#pragma unroll
    for (int k = 0; k < 8; ++k) gv[k] = __builtin_nontemporal_load((const u32x4*)(Gw + (size_t)(er + 4 * k) * 2048 + ec * 8));
    asm volatile("s_waitcnt lgkmcnt(0)" ::: "memory");
#pragma unroll
    for (int k = 0; k < 8; ++k) {
        const u32x4 ov = *(const u32x4*)(OT + (er + 4 * k) * 136 + ec * 8); u32x4 w;
#pragma unroll
        for (int i = 0; i < 4; ++i) { const float g0 = bflo(gv[k][i]), g1 = bfhi(gv[k][i]); w[i] = cvtpk(bflo(ov[i]) * g0 * sigm(g0), bfhi(ov[i]) * g1 * sigm(g1)); }
        *(u32x4*)(Ow + (size_t)(er + 4 * k) * 2048 + ec * 8) = w;
    }
#undef SLOAD
#undef SWRITE
#undef SWAIT
#undef RESC
}
}

DI void phase_lru(const Params& p, unsigned char* shm) {
    for (int it = blockIdx.x; it < 2048; it += gridDim.x) lru_tile(p, shm, it >> 4, it & 15);
    __syncthreads();
}
DI void phase_att(const Params& p, unsigned char* shm) {
    const int wid = __builtin_amdgcn_readfirstlane(threadIdx.x >> 6);
    const bf16_t* Z = (const bf16_t*)(p.ws + WS_ZQKV); const bf16_t* GA = (const bf16_t*)(p.ws + WS_ZGA); bf16_t* YB = (bf16_t*)(p.ws + WS_YB);
    for (int it = blockIdx.x; it < 1024; it += gridDim.x) {
        const int hp = it & 1, g = (it >> 1) & 3, n = it >> 3;
        const int head = g * 4 + hp * 2 + (wid >> 2), qw = 32 * (wid & 3);
        const int kfirst = n == 0 ? 0 : (n - 1) * 128, NT = (n == 0 || n == 127) ? 4 : 6, kt0 = kfirst - n * 128;
        __syncthreads();
        const size_t go = (size_t)(n * 128 + qw) * 2048 + head * 128;
        att::attn_item(Z + (size_t)(n * 128 + qw) * 3072 + head * 128, Z + (size_t)kfirst * 3072 + 2048 + g * 128, Z + (size_t)kfirst * 3072 + 2560 + g * 128,
                       GA + go, YB + go, NT, kt0, qw, p.in[10][head], (char*)shm);
    }
    __syncthreads();
}
DI void phase_mixers(const Params& p, unsigned char* shm) { if (p.mix_mask & 1) phase_lru(p, shm); if (p.mix_mask & 2) phase_att(p, shm); }

DI void phase_carry(const Params& p) {
    const int tid = threadIdx.x;
    if (tid >= 64) return;
    const f32x2* AGG = (const f32x2*)(p.ws + WS_AGG); float* CAR = (float*)(p.ws + WS_CAR);
    for (int w = blockIdx.x; w < 64; w += gridDim.x) {
        const int id = w * 64 + tid, d = id >> 11, ch = id & 2047;
        const f32x2* ag = AGG + (size_t)d * 128 * 2048 + ch; float* car = CAR + (size_t)d * 128 * 2048 + ch;
        float cin = 0.f;
        for (int b = 0; b < 4; ++b) {
            f32x2 v[32];
#pragma unroll
            for (int u = 0; u < 32; ++u) { const int k = b * 32 + u, cc = d == 0 ? k : 127 - k; v[u] = ag[(size_t)cc * 2048]; }
#pragma unroll
            for (int u = 0; u < 32; ++u) { const int k = b * 32 + u, cc = d == 0 ? k : 127 - k; car[(size_t)cc * 2048] = cin; cin = fmaf(v[u][0], cin, v[u][1]); }
        }
    }
}
DI void phase_fixup(const Params& p) {
    const int tid = threadIdx.x, ch = tid * 4;
    const float* CAR = (const float*)(p.ws + WS_CAR);
    bf16_t* ZG = (bf16_t*)(p.ws + WS_ZG);
    const bf16_t* HLp = (const bf16_t*)((unsigned char*)p.out + DO_ACF); const bf16_t* PPp = (const bf16_t*)((unsigned char*)p.out + DO_ACB);
    for (int it = blockIdx.x; it < 512; it += gridDim.x) {
        const int c = it >> 2, rq = it & 3;
        const f32x4 cf = *(const f32x4*)(CAR + (size_t)c * 2048 + ch) * (1.f / 255.f), cb = *(const f32x4*)(CAR + (size_t)(128 + c) * 2048 + ch) * (1.f / 255.f);
#pragma unroll 8
        for (int i = 0; i < 32; ++i) {
            const size_t off = (size_t)(c * 128 + rq * 32 + i) * 2048 + ch;
            const u32x2 g = __builtin_nontemporal_load((const u32x2*)(ZG + off)), h = __builtin_nontemporal_load((const u32x2*)(HLp + off)), pp = __builtin_nontemporal_load((const u32x2*)(PPp + off));
            const float g0 = bflo(g[0]), g1 = bfhi(g[0]), g2 = bflo(g[1]), g3 = bfhi(g[1]);
            const float y0 = (bflo(h[0]) + ub(pp[0], 0) * cf[0] + ub(pp[0], 1) * cb[0]) * g0 * sigm(g0), y1 = (bfhi(h[0]) + ub(pp[0], 2) * cf[1] + ub(pp[0], 3) * cb[1]) * g1 * sigm(g1);
            const float y2 = (bflo(h[1]) + ub(pp[1], 0) * cf[2] + ub(pp[1], 1) * cb[2]) * g2 * sigm(g2), y3 = (bfhi(h[1]) + ub(pp[1], 2) * cf[3] + ub(pp[1], 3) * cb[3]) * g3 * sigm(g3);
            *(u32x2*)(ZG + off) = (u32x2){cvtpk(y0, y1), cvtpk(y2, y3)};
        }
    }
}

DI void phase_final(const Params& p) {
    const int tid = threadIdx.x, wid = tid >> 6, lane = tid & 63;
    const float* x = p.in[0]; const float* nw = p.in[14]; const bf16_t* o2 = (const bf16_t*)(p.ws + WS_OUT2); const float* ssq = (const float*)(p.ws + WS_SSQ);
    f32x4 w[8];
#pragma unroll
    for (int i = 0; i < 8; ++i) w[i] = *(const f32x4*)(nw + i * 256 + lane * 4);
    for (int row = (blockIdx.x * 8 + wid) * 2; row < S; row += gridDim.x * 16) {
        f32x4 xv[2][8]; u32x2 yv[2][8]; float sq[2];
#pragma unroll
        for (int r = 0; r < 2; ++r) {
            sq[r] = lane < 32 ? ssq[(size_t)(row + r) * 32 + lane] : 0.f;
#pragma unroll
            for (int i = 0; i < 8; ++i) { const size_t off = (size_t)(row + r) * DM + i * 256 + lane * 4; xv[r][i] = __builtin_nontemporal_load((const f32x4*)(x + off)); yv[r][i] = __builtin_nontemporal_load((const u32x2*)(o2 + off)); }
        }
#pragma unroll
        for (int r = 0; r < 2; ++r) {
            const float rs = rsqrtf(wave_sum(sq[r]) * (1.f / DM) + EPS);
#pragma unroll
            for (int i = 0; i < 8; ++i) { const size_t off = (size_t)(row + r) * DM + i * 256 + lane * 4;
                const f32x4 ov = {xv[r][i][0] + bflo(yv[r][i][0]) * rs * w[i][0], xv[r][i][1] + bfhi(yv[r][i][0]) * rs * w[i][1],
                                  xv[r][i][2] + bflo(yv[r][i][1]) * rs * w[i][2], xv[r][i][3] + bfhi(yv[r][i][1]) * rs * w[i][3]};
                __builtin_nontemporal_store(ov, (f32x4*)(p.out + off)); }
        }
    }
}

#define XB_TMO      128
#define XB_XCNT(j)  (256  + 64 * (j))
#define XB_XSUB(j)  (1280 + 64 * (j))
#define XB_XGEN(j)  (2304 + 64 * (j))
#define XB_TOP      3328
#define XB_TOPGEN   3392
#define XCD_BAR_WORDS 3456
#define XB_SPIN_CAP (1u << 18)

__device__ __forceinline__ unsigned xb_ld(unsigned* p)              { return __hip_atomic_load(p, __ATOMIC_RELAXED, __HIP_MEMORY_SCOPE_AGENT); }
__device__ __forceinline__ unsigned xb_add(unsigned* p, unsigned v) { return __hip_atomic_fetch_add(p, v, __ATOMIC_RELAXED, __HIP_MEMORY_SCOPE_AGENT); }
__device__ __forceinline__ unsigned xb_xcc_id() { return (unsigned)__builtin_amdgcn_s_getreg((3 << 11) | 20) & 0xFu; }
#define XB_SPIN(cond, bar) do { unsigned _sp = 0; while (cond) { __builtin_amdgcn_s_sleep(1); \
    if ((++_sp & 255u) == 0u) { if (xb_ld(&(bar)[XB_TMO])) break; if (_sp > XB_SPIN_CAP) { atomicAdd(&(bar)[XB_TMO], 1u); break; } } } } while (0)

struct XcdBarrier {
    unsigned* bar; unsigned x;
    volatile LAS unsigned* st;
};

__device__ __forceinline__ XcdBarrier xcd_barrier_post(unsigned* bar, volatile LAS unsigned* st) {
    XcdBarrier b; b.bar = bar; b.x = xb_xcc_id(); b.st = st;
    if (threadIdx.x == 0) (void)xb_add(&bar[XB_XCNT(b.x)], 1u);
    return b;
}
__device__ __forceinline__ void xcd_barrier_complete(unsigned* bar, unsigned x, unsigned& nloc, unsigned& nx) {
    const unsigned G = gridDim.x * gridDim.y * gridDim.z;
    unsigned sum, cnt, mine, sp = 0u;
    for (;;) {
        sum = 0u; cnt = 0u; mine = 0u;
#pragma unroll
        for (unsigned j = 0; j < 16; ++j) { const unsigned c = xb_ld(&bar[XB_XCNT(j)]); sum += c; cnt += (c > 0u) ? 1u : 0u; mine = (j == x) ? c : mine; }
        if (sum == G) break;
        __builtin_amdgcn_s_sleep(1);
        if ((++sp & 255u) == 0u) { if (xb_ld(&bar[XB_TMO])) break; if (sp > XB_SPIN_CAP) { atomicAdd(&bar[XB_TMO], 1u); break; } }
    }
    nloc = mine > 0u ? mine : 1u; nx = cnt > 0u ? cnt : 1u;
}

__device__ __forceinline__ void xcd_barrier(const XcdBarrier& b) {
    asm volatile("s_waitcnt vmcnt(0)" ::: "memory");
    __syncthreads();
    if (threadIdx.x == 0) {
        unsigned* bar = b.bar;
        __builtin_amdgcn_s_waitcnt(0);
        unsigned nloc = b.st[0], nx = b.st[1];
        if (nloc == 0u) { xcd_barrier_complete(bar, b.x, nloc, nx); b.st[0] = nloc; b.st[1] = nx; }
        const unsigned old = xb_add(&bar[XB_XSUB(b.x)], 1u);
        const unsigned gen = old / nloc;
        if (old + 1u == (gen + 1u) * nloc) {
            __builtin_amdgcn_fence(__ATOMIC_RELEASE, "agent");
            asm volatile("s_waitcnt vmcnt(0)" ::: "memory");
            const unsigned og = xb_add(&bar[XB_TOP], 1u);
            const unsigned tg = og / nx;
            if (og + 1u == (tg + 1u) * nx) xb_add(&bar[XB_TOPGEN], 1u);
            else XB_SPIN(xb_ld(&bar[XB_TOPGEN]) == tg, bar);
            __builtin_amdgcn_fence(__ATOMIC_ACQUIRE, "agent");
            xb_add(&bar[XB_XGEN(b.x)], 1u);
            asm volatile("s_waitcnt vmcnt(0)" ::: "memory");
        } else {
            XB_SPIN(xb_ld(&bar[XB_XGEN(b.x)]) == gen, bar);
            __builtin_amdgcn_fence(__ATOMIC_ACQUIRE, "agent");
            asm volatile("s_waitcnt vmcnt(0)" ::: "memory");
        }
    }
    __syncthreads();
}

__global__ void __launch_bounds__(512, 2) mega(Params p) {
    extern __shared__ __attribute__((aligned(16))) unsigned char shm[];
    cg::grid_group grid = cg::this_grid();
    volatile LAS unsigned* bst = (volatile LAS unsigned*)((LAS unsigned char*)shm + LDS_BAR_ST);
    if (threadIdx.x < 4) bst[threadIdx.x] = 0u;
    __syncthreads();
    XcdBarrier xbar; xbar.bar = (unsigned*)(p.ws + WS_BAR); xbar.x = 0; xbar.st = bst;
    if (p.ph_hi - p.ph_lo > 1) xbar = xcd_barrier_post((unsigned*)(p.ws + WS_BAR), bst);
    if (p.ph_lo > 64) grid.sync();
#ifndef PHMASK
#define PHMASK 0xff
#endif
#define PH(i) (((PHMASK >> (i)) & 1) && p.ph_lo <= (i) && (i) < p.ph_hi)
#define SEAM(i) do { if (p.ph_lo <= (i) && (i) + 1 < p.ph_hi) xcd_barrier(xbar); } while (0)
    if (PH(0)) phase_prep(p, shm);
    SEAM(0);
    if (PH(1)) {
        pg8::Gemm g; g.A0 = (const bf16_t*)((unsigned char*)p.out + DO_XN); g.A1 = g.A0; g.B0 = (const bf16_t*)((unsigned char*)p.out + DO_WINT); g.B1 = g.B0;
        g.lda = DM; g.ldb = DM; g.M = S; g.N = NIN; g.K = DM; g.ksplit = DM / 64;
        pg8::StaticOrder so; so.init(g.M, g.N, (int)gridDim.x, (int)blockIdx.x);
        EpiZ e; e.ws = p.ws;
        if (gridDim.x >= 16 && (gridDim.x & 15) == 0) { if ((blockIdx.x >> 3) & 1) prep_small_weights(p, shm, (int)((blockIdx.x >> 4) * 8 + (blockIdx.x & 7)), (int)(gridDim.x / 2)); }
        else prep_small_weights(p, shm, (int)blockIdx.x, (int)gridDim.x);
        pg8::gemm_phase<EpiZ>((LAS unsigned char*)shm, g, so, e);
    }
    SEAM(1);
#if PROBE_SPLIT
    if (PH(2)) phase_lru(p, shm);
    if (p.ph_lo == 8) phase_att(p, shm);
#else
    if (PH(2)) phase_mixers(p, shm);
#endif
    SEAM(2);
    if (PH(3)) phase_carry(p);
    SEAM(3);
    if (PH(4)) phase_fixup(p);
    SEAM(4);
    if (PH(5)) {
        pg8::Gemm g; g.A0 = (const bf16_t*)(p.ws + WS_ZG); g.A1 = (const bf16_t*)(p.ws + WS_YB) - 2048; g.B0 = (const bf16_t*)(p.ws + WS_WAT); g.B1 = (const bf16_t*)(p.ws + WS_WBT) - 2048;
        g.lda = DM; g.ldb = DM; g.M = S; g.N = DM; g.K = 2 * DM; g.ksplit = DM / 64;
        pg8::StaticOrder so; so.init(g.M, g.N, (int)gridDim.x, (int)blockIdx.x);
        EpiMergeMid e; e.ws = p.ws;
        pg8::gemm_phase<EpiMergeMid>((LAS unsigned char*)shm, g, so, e);
    }
    SEAM(5);
    if (PH(6)) {
        pg8::Gemm g; g.A0 = (const bf16_t*)(p.ws + WS_MRG); g.A1 = g.A0; g.B0 = (const bf16_t*)(p.ws + WS_WOT); g.B1 = g.B0;
        g.lda = DM; g.ldb = DM; g.M = S; g.N = DM; g.K = DM; g.ksplit = DM / 64;
        pg8::StaticOrder so; so.init(g.M, g.N, (int)gridDim.x, (int)blockIdx.x);
        EpiOut e; e.ws = p.ws;
        pg8::gemm_phase<EpiOut>((LAS unsigned char*)shm, g, so, e);
    }
    SEAM(6);
    if (PH(7)) phase_final(p);
}

extern "C" void kernel_launch(void* const* d_in, const int* in_sizes, int n_in, void* d_out, int out_size, void* d_ws, size_t ws_size, hipStream_t stream) {
    static int grid = 0;
    if (grid == 0) {
        if (n_in != 15 || in_sizes[0] != S * DM || out_size != S * DM || ws_size < WS_END) {
            fprintf(stderr, "kernel_launch: unexpected shapes (n_in %d, in0 %d, out %d, ws %zu; need ws >= %zu)\n", n_in, n_in > 0 ? in_sizes[0] : -1, out_size, ws_size, (size_t)WS_END); grid = -1; return; }
        int dev = 0, cus = 0, per_cu = 0;
        (void)hipGetDevice(&dev); (void)hipDeviceGetAttribute(&cus, hipDeviceAttributeMultiprocessorCount, dev);
        if (hipFuncSetAttribute((const void*)mega, hipFuncAttributeMaxDynamicSharedMemorySize, LDS_BYTES) != hipSuccess) { fprintf(stderr, "kernel_launch: hipFuncSetAttribute failed\n"); grid = -1; return; }
        if (hipOccupancyMaxActiveBlocksPerMultiprocessor(&per_cu, (const void*)mega, 512, LDS_BYTES) != hipSuccess || per_cu < 1) { fprintf(stderr, "kernel_launch: occupancy query gave %d\n", per_cu); per_cu = 1; }
        (void)hipGetLastError();
        grid = cus * per_cu;
    }
    if (grid < 0) return;
    Params p{};
    for (int i = 0; i < 15; ++i) p.in[i] = (const float*)d_in[i];
    p.out = (float*)d_out; p.ws = (unsigned char*)d_ws;
    for (int j = 0; j < 16; ++j) p.inv_freq[j] = (float)pow(500000.0, -(double)j / 16.0);
    p.mix_mask = 3;
#if MK_SINGLE
    p.ph_lo = 0; p.ph_hi = 8;
    if (hipMemsetAsync((unsigned char*)d_ws + WS_BAR, 0, XCD_BAR_WORDS * sizeof(unsigned), stream) != hipSuccess) { fprintf(stderr, "kernel_launch: memset of barrier words failed\n"); return; }
    void* args[] = {&p};
    hipError_t e = hipLaunchCooperativeKernel((const void*)mega, dim3(grid), dim3(512), args, LDS_BYTES, stream);
    if (e != hipSuccess) fprintf(stderr, "kernel_launch: cooperative launch failed: %s (grid %d)\n", hipGetErrorString(e), grid);
#else
#ifndef REPMASK
#define REPMASK 0
#endif
#ifndef HALFMASK
#define HALFMASK 0
#endif
    static const int lph[9] = {0, 1, 2, 2, 3, 4, 5, 6, 7}; static const int lmix[9] = {3, 3, 1, 2, 3, 3, 3, 3, 3};
    for (int li = 0; li < 9; ++li) {
        p.ph_lo = lph[li]; p.ph_hi = lph[li] + 1; p.mix_mask = lmix[li];
#ifndef REPMASK
#define REPMASK 0
#endif
        for (int rep = 0; rep < (((REPMASK >> li) & 1) ? 2 : 1); ++rep)
        hipLaunchKernelGGL(mega, dim3(((HALFMASK >> li) & 1) ? grid / 2 : grid), dim3(512), LDS_BYTES, stream, p);
    }
#endif
}
```

```cpp
#include <hip/hip_runtime.h>
#include <hip/hip_cooperative_groups.h>
#include <cstdio>
#include <cstdint>
#include <cmath>
namespace cg = cooperative_groups;

#ifndef MK_SINGLE
#define MK_SINGLE 1
#endif

#define LAS __attribute__((address_space(3)))
#define DI __device__ __forceinline__
typedef unsigned short bf16_t;
typedef short bf16x8 __attribute__((ext_vector_type(8)));
typedef short s16x4 __attribute__((ext_vector_type(4)));
typedef float f32x2 __attribute__((ext_vector_type(2)));
typedef float f32x4 __attribute__((ext_vector_type(4)));
typedef float f32x16 __attribute__((ext_vector_type(16)));
typedef unsigned u32x2 __attribute__((ext_vector_type(2)));
typedef unsigned u32x4 __attribute__((ext_vector_type(4)));

constexpr int S = 16384, DM = 2048, NIN = 13312;
constexpr float EPS = 1e-6f;
constexpr float LOG2E = 1.4426950408889634f;
constexpr size_t MiB = (size_t)1 << 20;
constexpr size_t WS_ZU = 0, WS_MERGED = 0;
constexpr size_t WS_ZG = 64 * MiB;
constexpr size_t WS_ZQKV = 128 * MiB;
constexpr size_t WS_ZGA = 224 * MiB;
constexpr size_t WS_ZM = 288 * MiB, WS_OUT2 = 288 * MiB;
constexpr size_t WS_WAT = 416 * MiB, WS_WBT = 424 * MiB, WS_WOT = 432 * MiB;
constexpr size_t WS_ROPE = 440 * MiB;
constexpr size_t WS_AGG = 442 * MiB;
constexpr size_t WS_SSQ = 446 * MiB;
constexpr size_t WS_LWT = 448 * MiB;
constexpr size_t WS_CAR = 450 * MiB;
constexpr size_t WS_BAR = 452 * MiB;
constexpr size_t WS_END = 453 * MiB;
constexpr size_t DO_XN = 0, DO_WINT = 64 * MiB;
constexpr size_t DO_ACF = 0, DO_ACB = 64 * MiB;
#ifndef PROBE_SPLIT
#define PROBE_SPLIT 0
#endif
constexpr size_t WS_YB = PROBE_SPLIT ? WS_ZU : WS_ZGA;
constexpr size_t WS_MRG = PROBE_SPLIT ? WS_ZQKV : WS_MERGED;
constexpr int LDS_BAR_ST = 137216;
constexpr int LDS_BYTES = 137232;

struct Params {
    const float* in[15];
    float* out; unsigned char* ws;
    float inv_freq[16];
    int ph_lo, ph_hi, mix_mask, pad_;
};

DI unsigned cvtpk(float lo, float hi) { unsigned r; asm volatile("v_cvt_pk_bf16_f32 %0, %1, %2" : "=v"(r) : "v"(lo), "v"(hi)); return r; }
DI float bf2f(unsigned short b) { return __uint_as_float(((unsigned)b) << 16); }
DI float bflo(unsigned w) { return __uint_as_float(w << 16); }
DI float bfhi(unsigned w) { return __uint_as_float(w & 0xffff0000u); }
DI unsigned short f2bf(float f) { return (unsigned short)(cvtpk(f, f) & 0xffffu); }
DI float ex2(float x) { return __builtin_amdgcn_exp2f(x); }
DI float rcpf_(float x) { return __builtin_amdgcn_rcpf(x); }
DI float sigm(float x) { return rcpf_(1.f + ex2(-x * LOG2E)); }
DI float wave_sum(float v) {
#pragma unroll
    for (int o = 32; o >= 1; o >>= 1) v += __shfl_xor(v, o);
    return v;
}

namespace pg8 {
constexpr int BM = 256, BK = 64, HALF = 128, HTB = HALF * BK * 2, STAGE_BYTES = 8 * HTB, NXCD = 8, WGM = 8;
DI int lds_byte(int r, int c) { const int st = (r >> 4) * 2 + (c >> 5), rr = r & 15, cc = c & 31, ob = rr * 64 + cc * 2; return st * 1024 + (ob ^ (((ob >> 9) & 1) << 5)); }
DI void stage_rc(int b, int& R, int& C) { const int st = b / 1024, sb = b % 1024, swz = sb ^ (((sb >> 9) & 1) << 5); R = (st >> 1) * 16 + swz / 64; C = (st & 1) * 32 + (swz % 64) / 2; }
DI int perm32(int rho) { const int n = rho >> 4, i = rho & 15; return 8 * (i >> 2) + 4 * n + (i & 3); }
struct Unit { int pm, pn; };
struct Gemm { const bf16_t* A0; const bf16_t* A1; const bf16_t* B0; const bf16_t* B1; int lda, ldb, M, N, K, ksplit; };
struct StaticOrder {
    int nM, nN, nwg, G, c;
    DI void init(int M, int N, int G_, int c_) { nM = M / BM; nN = N / BM; nwg = nM * nN; G = G_; c = c_; }
    DI bool next(int i, Unit& u) const {
        const long L = (long)i * G + c; if (L >= nwg) return false;
        int wgid = (int)L; { const int q = nwg / NXCD, r = nwg % NXCD, xcd = wgid % NXCD, off = wgid / NXCD; wgid = (xcd < r ? xcd * (q + 1) : r * (q + 1) + (xcd - r) * q) + off; }
        const int nig = WGM * nN, gid = wgid / nig, fm = gid * WGM, gsz = (nM - fm) < WGM ? (nM - fm) : WGM;
        u.pm = fm + ((wgid % nig) % gsz); u.pn = (wgid % nig) / gsz; return true;
    }
};

template <class Epi>
DI void gemm_phase(LAS unsigned char* lds, const Gemm g, const StaticOrder& S_, const Epi& E) {
    const int tid = threadIdx.x, wid = __builtin_amdgcn_readfirstlane(tid >> 6), lane = tid & 63, wr = wid >> 2, wc = wid & 3, fr = lane & 15, fq = lane >> 4;
    const int K = g.K, nt = K / BK, ksplit = g.ksplit;
    unsigned voffA[2], voffB[2];
#pragma unroll
    for (int i = 0; i < 2; ++i) { int R, C; stage_rc(tid * 16 + i * 8192, R, C); const int Rb = Epi::PERM ? ((R & ~31) + perm32(R & 31)) : R;
        voffA[i] = (unsigned)(R * g.lda + C) * 2u; voffB[i] = (unsigned)(Rb * g.ldb + C) * 2u; }
    const size_t kstep = (size_t)(BK * 2);
    const size_t hstepA = (size_t)HALF * g.lda * 2, hstepB = (size_t)HALF * g.ldb * 2;
    const size_t tstepA = 2 * hstepA, tstepB = 2 * hstepB;
    const unsigned ldsw = (unsigned)wid * 1024u;
    const int aoff = lds_byte(wr * 64 + fr, fq * 8), boff = lds_byte(wc * 32 + fr, fq * 8);
#define PG8_SA(b, h) (((b) * 2 + (h)) * HTB)
#define PG8_SB(b, h) ((4 + (b) * 2 + (h)) * HTB)
#define PG8_STAGE(bufoff, gbase, voff) do { _Pragma("unroll") for (int _i = 0; _i < 2; ++_i) \
        __builtin_amdgcn_global_load_lds((const unsigned*)((const char*)(gbase) + (voff)[_i]), (LAS unsigned*)(lds + (bufoff) + ldsw + _i * 8192), 16, 0, 0); } while (0)
#define PG8_LDA(dst, b, h) do { _Pragma("unroll") for (int m = 0; m < 4; ++m) _Pragma("unroll") for (int k = 0; k < 2; ++k) dst[m][k] = *(const LAS bf16x8*)(lds + PG8_SA(b, h) + aoff + m * 2048 + k * 1024); } while (0)
#define PG8_LDB(dst, b, h) do { _Pragma("unroll") for (int n = 0; n < 2; ++n) _Pragma("unroll") for (int k = 0; k < 2; ++k) dst[n][k] = *(const LAS bf16x8*)(lds + PG8_SB(b, h) + boff + n * 2048 + k * 1024); } while (0)
#define PG8_MMA(ai, bj, At, Bt) do { __builtin_amdgcn_s_setprio(1); _Pragma("unroll") for (int m = 0; m < 4; ++m) _Pragma("unroll") for (int n = 0; n < 2; ++n) _Pragma("unroll") for (int k = 0; k < 2; ++k) \
        acc[ai][bj][m][n] = __builtin_amdgcn_mfma_f32_16x16x32_bf16(Bt[n][k], At[m][k], acc[ai][bj][m][n], 0, 0, 0); __builtin_amdgcn_s_setprio(0); } while (0)
#define PG8_WAIT_V(n) asm volatile("s_waitcnt vmcnt(" #n ")" ::: "memory")
#define PG8_WAIT_L(n) asm volatile("s_waitcnt lgkmcnt(" #n ")" ::: "memory")
#define PG8_BAR __builtin_amdgcn_s_barrier()
#define PG8_SCHED __builtin_amdgcn_sched_barrier(0)
    Unit cur, nxt; int ui = 0;
    if (!S_.next(0, cur)) return;
    f32x4 acc[2][2][4][2];
#pragma unroll
    for (int a = 0; a < 2; ++a)
#pragma unroll
        for (int b = 0; b < 2; ++b)
#pragma unroll
            for (int m = 0; m < 4; ++m)
#pragma unroll
                for (int n = 0; n < 2; ++n) acc[a][b][m][n] = (f32x4){0.f, 0.f, 0.f, 0.f};
    bf16x8 At[4][2], B0[2][2], B1[2][2];
    const char* cA0 = (const char*)g.A0 + (size_t)cur.pm * tstepA; const char* cA1 = (const char*)g.A1 + (size_t)cur.pm * tstepA;
    const char* cB0 = (const char*)g.B0 + (size_t)cur.pn * tstepB; const char* cB1 = (const char*)g.B1 + (size_t)cur.pn * tstepB;
    PG8_STAGE(PG8_SB(0, 0), cB0, voffB); PG8_STAGE(PG8_SA(0, 0), cA0, voffA); PG8_STAGE(PG8_SB(0, 1), cB0 + hstepB, voffB); PG8_STAGE(PG8_SA(0, 1), cA0 + hstepA, voffA);
    if (wr == 1) PG8_BAR;
    PG8_WAIT_V(4); PG8_BAR;
    PG8_STAGE(PG8_SB(1, 0), cB0 + kstep, voffB); PG8_STAGE(PG8_SA(1, 0), cA0 + kstep, voffA); PG8_STAGE(PG8_SB(1, 1), cB0 + hstepB + kstep, voffB);
    PG8_WAIT_V(6); PG8_BAR;
    for (;;) {
        const bool has_next = S_.next(ui + 1, nxt);
        const char* nA0 = has_next ? (const char*)g.A0 + (size_t)nxt.pm * tstepA : cA0; const char* nB0 = has_next ? (const char*)g.B0 + (size_t)nxt.pn * tstepB : cB0;
        for (int hf = 0; hf < (Epi::MID ? 2 : 1); ++hf) {
        const int tb = Epi::MID ? hf * ksplit : 0, te = Epi::MID ? (hf + 1) * ksplit : nt;
        for (int t = tb; t < te; t += 2) {
            const bool last = (t == nt - 2);
            const bool hA = (t >= ksplit), hB = (t + 2 >= ksplit);
            const char* a1 = (hA ? cA1 : cA0) + (size_t)(t + 1) * kstep;
            const char* a2 = last ? nA0 : (hB ? cA1 : cA0) + (size_t)(t + 2) * kstep; const char* b2 = last ? nB0 : (hB ? cB1 : cB0) + (size_t)(t + 2) * kstep;
            const char* a3 = a2 + kstep; const char* b3 = b2 + kstep;
            PG8_LDB(B0, 0, 0); PG8_SCHED; PG8_LDA(At, 0, 0); PG8_STAGE(PG8_SA(1, 1), a1 + hstepA, voffA);
            PG8_WAIT_L(8); PG8_BAR; PG8_WAIT_L(0); PG8_MMA(0, 0, At, B0); PG8_BAR; PG8_SCHED;
            PG8_LDB(B1, 0, 1); PG8_STAGE(PG8_SB(0, 0), b2, voffB);
            PG8_BAR; PG8_WAIT_L(0); PG8_MMA(0, 1, At, B1); PG8_BAR;
            PG8_LDA(At, 0, 1); PG8_STAGE(PG8_SA(0, 0), a2, voffA);
            PG8_BAR; PG8_WAIT_L(0); PG8_MMA(1, 0, At, B0); PG8_BAR; PG8_SCHED;
            PG8_STAGE(PG8_SB(0, 1), b2 + hstepB, voffB);
            PG8_WAIT_V(6); PG8_BAR; PG8_MMA(1, 1, At, B1); PG8_BAR;
            PG8_LDB(B0, 1, 0); PG8_SCHED; PG8_LDA(At, 1, 0); PG8_STAGE(PG8_SA(0, 1), a2 + hstepA, voffA);
            PG8_WAIT_L(8); PG8_BAR; PG8_WAIT_L(0); PG8_MMA(0, 0, At, B0); PG8_BAR; PG8_SCHED;
            PG8_LDB(B1, 1, 1); PG8_STAGE(PG8_SB(1, 0), b3, voffB);
            PG8_BAR; PG8_WAIT_L(0); PG8_MMA(0, 1, At, B1); PG8_BAR;
            PG8_LDA(At, 1, 1); PG8_STAGE(PG8_SA(1, 0), a3, voffA);
            PG8_BAR; PG8_WAIT_L(0); PG8_MMA(1, 0, At, B0); PG8_BAR; PG8_SCHED;
            PG8_STAGE(PG8_SB(1, 1), b3 + hstepB, voffB);
            PG8_WAIT_V(6); PG8_BAR; PG8_MMA(1, 1, At, B1); PG8_BAR;
        }
        if constexpr (Epi::MID) { if (hf == 0) E.mid(acc, cur, wr, wc, fr, fq); }
        }
        E(acc, cur, wr, wc, fr, fq);
        if (!has_next) break;
#pragma unroll
        for (int a = 0; a < 2; ++a)
#pragma unroll
            for (int b = 0; b < 2; ++b)
#pragma unroll
                for (int m = 0; m < 4; ++m)
#pragma unroll
                    for (int n = 0; n < 2; ++n) acc[a][b][m][n] = (f32x4){0.f, 0.f, 0.f, 0.f};
        cur = nxt; ++ui;
        cA0 = (const char*)g.A0 + (size_t)cur.pm * tstepA; cA1 = (const char*)g.A1 + (size_t)cur.pm * tstepA;
        cB0 = (const char*)g.B0 + (size_t)cur.pn * tstepB; cB1 = (const char*)g.B1 + (size_t)cur.pn * tstepB;
    }
    PG8_WAIT_V(0);
    if (wr == 0) PG8_BAR;
    PG8_BAR;
#undef PG8_SA
#undef PG8_SB
#undef PG8_STAGE
#undef PG8_LDA
#undef PG8_LDB
#undef PG8_MMA
#undef PG8_WAIT_V
#undef PG8_WAIT_L
#undef PG8_BAR
#undef PG8_SCHED
}
}

struct EpiZ {
    static constexpr bool PERM = true, MID = false;
    unsigned char* ws;
    DI void operator()(const f32x4 (&acc)[2][2][4][2], const pg8::Unit& u, int wr, int wc, int fr, int fq) const {
        const int pn = u.pn; bf16_t* base; int ld, colt;
        if (pn < 8) { base = (bf16_t*)(ws + WS_ZU) + (size_t)pn * S * 256; ld = 256; colt = 0; }
        else if (pn < 16) { base = (bf16_t*)(ws + WS_ZG); ld = 2048; colt = (pn - 8) * 256; }
        else if (pn < 28) { base = (bf16_t*)(ws + WS_ZQKV); ld = 3072; colt = (pn - 16) * 256; }
        else if (pn < 36) { base = (bf16_t*)(ws + WS_ZGA); ld = 2048; colt = (pn - 28) * 256; }
        else { base = (bf16_t*)(ws + WS_ZM) + (size_t)(pn - 36) * S * 256; ld = 256; colt = 0; }
        const bool rope = (pn >= 16 && pn < 26 && wc == 0);
        const int row0 = u.pm * 256 + wr * 64 + fr, col0 = colt + wc * 32 + 8 * fq;
        if (rope) {
            const float* cosT = (const float*)(ws + WS_ROPE) + (size_t)row0 * 16 + 4 * fq; const float* sinT = cosT + (size_t)S * 16;
            f32x4 cs[8], sn[8];
#pragma unroll
            for (int k = 0; k < 8; ++k) { cs[k] = *(const f32x4*)(cosT + ((k >> 2) * 128 + (k & 3) * 16) * 16); sn[k] = *(const f32x4*)(sinT + ((k >> 2) * 128 + (k & 3) * 16) * 16); }
#pragma unroll
            for (int ai = 0; ai < 2; ++ai)
#pragma unroll
                for (int m = 0; m < 4; ++m) {
                    const int row = row0 + ai * 128 + m * 16; const f32x4 c4 = cs[ai * 4 + m], s4 = sn[ai * 4 + m];
#pragma unroll
                    for (int bj = 0; bj < 2; ++bj) {
                        const f32x4 v0 = acc[ai][bj][m][0], v1 = acc[ai][bj][m][1]; f32x4 w0, w1;
                        w0[0] = v0[0] * c4[0] - v0[1] * s4[0]; w0[1] = v0[1] * c4[0] + v0[0] * s4[0];
                        w0[2] = v0[2] * c4[1] - v0[3] * s4[1]; w0[3] = v0[3] * c4[1] + v0[2] * s4[1];
                        w1[0] = v1[0] * c4[2] - v1[1] * s4[2]; w1[1] = v1[1] * c4[2] + v1[0] * s4[2];
                        w1[2] = v1[2] * c4[3] - v1[3] * s4[3]; w1[3] = v1[3] * c4[3] + v1[2] * s4[3];
                        u32x4 w = {cvtpk(w0[0], w0[1]), cvtpk(w0[2], w0[3]), cvtpk(w1[0], w1[1]), cvtpk(w1[2], w1[3])};
                        __builtin_nontemporal_store(w, (u32x4*)(base + (size_t)row * ld + col0 + bj * 128));
                    }
                }
        } else if (pn >= 36) {
            unsigned char* gb = ws + WS_ZM + (size_t)(pn - 36) * S * 256 + (size_t)row0 * 256 + wc * 32 + 8 * fq;
#pragma unroll
            for (int ai = 0; ai < 2; ++ai)
#pragma unroll
                for (int m = 0; m < 4; ++m)
#pragma unroll
                    for (int bj = 0; bj < 2; ++bj) {
                        const f32x4 v0 = acc[ai][bj][m][0], v1 = acc[ai][bj][m][1]; unsigned q[8];
#pragma unroll
                        for (int i = 0; i < 4; ++i) { q[i] = (unsigned)fmaxf(sigm(v0[i]) * 255.f + 0.5f, 1.f); q[4 + i] = (unsigned)fmaxf(sigm(v1[i]) * 255.f + 0.5f, 1.f); }
                        const u32x2 w = {q[0] | (q[1] << 8) | (q[2] << 16) | (q[3] << 24), q[4] | (q[5] << 8) | (q[6] << 16) | (q[7] << 24)};
                        __builtin_nontemporal_store(w, (u32x2*)(gb + (size_t)(ai * 128 + m * 16) * 256 + bj * 128));
                    }
        } else {
#pragma unroll
            for (int ai = 0; ai < 2; ++ai)
#pragma unroll
                for (int m = 0; m < 4; ++m) {
                    const int row = row0 + ai * 128 + m * 16;
#pragma unroll
                    for (int bj = 0; bj < 2; ++bj) {
                        const f32x4 v0 = acc[ai][bj][m][0], v1 = acc[ai][bj][m][1];
                        u32x4 w = {cvtpk(v0[0], v0[1]), cvtpk(v0[2], v0[3]), cvtpk(v1[0], v1[1]), cvtpk(v1[2], v1[3])};
                        __builtin_nontemporal_store(w, (u32x4*)(base + (size_t)row * ld + col0 + bj * 128));
                    }
                }
        }
    }
};
DI u32x4 ldg128(const void* base, unsigned boff) { return *(const u32x4*)((const char*)base + boff); }
DI void stg128(void* base, unsigned boff, u32x4 v) { *(u32x4*)((char*)base + boff) = v; }
template <int STEP> struct EpiMerge {
    static constexpr bool PERM = true, MID = false;
    unsigned char* ws; unsigned char* tbuf;
    DI void operator()(const f32x4 (&acc)[2][2][4][2], const pg8::Unit& u, int wr, int wc, int fr, int fq) const {
        const unsigned char* zm = ws + WS_ZM; unsigned char* mg = ws + WS_MRG;
        const unsigned r0_ = (unsigned)(u.pm * 256 + wr * 64 + fr), c0_ = (unsigned)(u.pn * 256 + wc * 32 + 8 * fq);
#pragma unroll
        for (int ai = 0; ai < 2; ++ai)
#pragma unroll
            for (int m = 0; m < 4; ++m) {
                const unsigned row = r0_ + ai * 128 + m * 16;
#pragma unroll
                for (int bj = 0; bj < 2; ++bj) {
                    const unsigned col = c0_ + bj * 128;
                    const u32x4 g = ldg128(zm, row * 8192u + (STEP ? 4096u : 0u) + col * 2u);
                    float v[8];
#pragma unroll
                    for (int i = 0; i < 4; ++i) {
                        v[2 * i] = acc[ai][bj][m][i >> 1][(i & 1) * 2] * sigm(bflo(g[i]));
                        v[2 * i + 1] = acc[ai][bj][m][i >> 1][(i & 1) * 2 + 1] * sigm(bfhi(g[i]));
                    }
                    const unsigned tb = row * 8192u + col * 4u;
                    if (STEP == 0) {
                        stg128(tbuf, tb, __builtin_bit_cast(u32x4, (f32x4){v[0], v[1], v[2], v[3]}));
                        stg128(tbuf, tb + 16u, __builtin_bit_cast(u32x4, (f32x4){v[4], v[5], v[6], v[7]}));
                    } else {
                        const f32x4 t0 = __builtin_bit_cast(f32x4, ldg128(tbuf, tb)), t1 = __builtin_bit_cast(f32x4, ldg128(tbuf, tb + 16u));
                        u32x4 w = {cvtpk(v[0] + t0[0], v[1] + t0[1]), cvtpk(v[2] + t0[2], v[3] + t0[3]), cvtpk(v[4] + t1[0], v[5] + t1[1]), cvtpk(v[6] + t1[2], v[7] + t1[3])};
                        stg128(mg, row * 4096u + col * 2u, w);
                    }
                }
                asm volatile("" ::: "memory");
            }
    }
};

DI float ub(unsigned w, int i) { return (float)((w >> (8 * i)) & 0xffu); }
struct EpiMergeMid {
    static constexpr bool PERM = true, MID = true;
    unsigned char* ws;
    DI void mid(f32x4 (&acc)[2][2][4][2], const pg8::Unit& u, int wr, int wc, int fr, int fq) const {
        const unsigned char* zm = ws + WS_ZM;
        unsigned b0_ = (unsigned)u.pn * (unsigned)(S * 256) + (unsigned)(u.pm * 256 + wr * 64 + fr) * 256u + (unsigned)(wc * 32 + 8 * fq);
        asm volatile("" : "+v"(b0_));
        u32x2 g1[2][4][2], g2[2][4][2];
#pragma unroll
        for (int ai = 0; ai < 2; ++ai)
#pragma unroll
            for (int m = 0; m < 4; ++m)
#pragma unroll
                for (int bj = 0; bj < 2; ++bj) { const unsigned bo = b0_ + (unsigned)(ai * 128 + m * 16) * 256u + bj * 128u;
                    g1[ai][m][bj] = *(const u32x2*)(zm + bo); g2[ai][m][bj] = *(const u32x2*)(zm + bo + (unsigned)(8 * S * 256)); }
#pragma unroll
        for (int ai = 0; ai < 2; ++ai)
#pragma unroll
            for (int m = 0; m < 4; ++m)
#pragma unroll
                for (int bj = 0; bj < 2; ++bj)
#pragma unroll
                    for (int e = 0; e < 8; ++e)
                        acc[ai][bj][m][e >> 2][e & 3] *= ub(g1[ai][m][bj][e >> 2], e & 3) * rcpf_(ub(g2[ai][m][bj][e >> 2], e & 3));
    }
    DI void operator()(const f32x4 (&acc)[2][2][4][2], const pg8::Unit& u, int wr, int wc, int fr, int fq) const {
        const unsigned char* zm = ws + WS_ZM; unsigned char* mg = ws + WS_MRG;
        unsigned r0_ = (unsigned)(u.pm * 256 + wr * 64 + fr), c0_ = (unsigned)(wc * 32 + 8 * fq);
        asm volatile("" : "+v"(r0_), "+v"(c0_));
        u32x2 g2[2][4][2];
#pragma unroll
        for (int ai = 0; ai < 2; ++ai)
#pragma unroll
            for (int m = 0; m < 4; ++m)
#pragma unroll
                for (int bj = 0; bj < 2; ++bj) g2[ai][m][bj] = *(const u32x2*)(zm + (unsigned)(8 + u.pn) * (unsigned)(S * 256) + (r0_ + ai * 128 + m * 16) * 256u + c0_ + bj * 128u);
#pragma unroll
        for (int ai = 0; ai < 2; ++ai)
#pragma unroll
            for (int m = 0; m < 4; ++m) {
                const unsigned row = r0_ + ai * 128 + m * 16;
#pragma unroll
                for (int bj = 0; bj < 2; ++bj) {
                    float v[8];
#pragma unroll
                    for (int e = 0; e < 8; ++e) v[e] = acc[ai][bj][m][e >> 2][e & 3] * (ub(g2[ai][m][bj][e >> 2], e & 3) * (1.f / 255.f));
                    u32x4 w = {cvtpk(v[0], v[1]), cvtpk(v[2], v[3]), cvtpk(v[4], v[5]), cvtpk(v[6], v[7])};
                    stg128(mg, row * 4096u + ((unsigned)u.pn * 256u + c0_) * 2u + bj * 256u, w);
                }
            }
    }
};
struct EpiOut {
    static constexpr bool PERM = true, MID = false;
    unsigned char* ws;
    DI void operator()(const f32x4 (&acc)[2][2][4][2], const pg8::Unit& u, int wr, int wc, int fr, int fq) const {
        unsigned char* o2 = ws + WS_OUT2; float* ssq = (float*)(ws + WS_SSQ);
        const unsigned r0_ = (unsigned)(u.pm * 256 + wr * 64 + fr), c0_ = (unsigned)(u.pn * 256 + wc * 32 + 8 * fq) * 2u;
#pragma unroll
        for (int ai = 0; ai < 2; ++ai)
#pragma unroll
            for (int m = 0; m < 4; ++m) {
                const unsigned row = r0_ + ai * 128 + m * 16; float s = 0.f;
#pragma unroll
                for (int bj = 0; bj < 2; ++bj) {
                    const f32x4 v0 = acc[ai][bj][m][0], v1 = acc[ai][bj][m][1];
                    s += v0[0] * v0[0] + v0[1] * v0[1] + v0[2] * v0[2] + v0[3] * v0[3] + v1[0] * v1[0] + v1[1] * v1[1] + v1[2] * v1[2] + v1[3] * v1[3];
                    u32x4 w = {cvtpk(v0[0], v0[1]), cvtpk(v0[2], v0[3]), cvtpk(v1[0], v1[1]), cvtpk(v1[2], v1[3])};
                    stg128(o2, row * 4096u + c0_ + bj * 256u, w);
                }
                s += __shfl_xor(s, 16); s += __shfl_xor(s, 32);
                if (fq == 0) ssq[(size_t)row * 32 + u.pn * 4 + wc] = s;
            }
    }
};

struct TJob { const float* src; bf16_t* dst; int ld_src, ld_dst, k0, n0, perm, pad_; };
DI void tr_load(const TJob& j, f32x4& v0, f32x4& v1) {
    const int t = threadIdx.x, kl = t >> 4, nl = (t & 15) * 4;
    v0 = *(const f32x4*)(j.src + (size_t)(j.k0 + kl) * j.ld_src + j.n0 + nl);
    v1 = *(const f32x4*)(j.src + (size_t)(j.k0 + kl + 32) * j.ld_src + j.n0 + nl);
}
DI void tr_store(const TJob& j, const f32x4 v0, const f32x4 v1, float* sT) {
    const int t = threadIdx.x;
    { const int kl = t >> 4, nl = (t & 15) * 4;
      sT[kl * 65 + nl] = v0[0]; sT[kl * 65 + nl + 1] = v0[1]; sT[kl * 65 + nl + 2] = v0[2]; sT[kl * 65 + nl + 3] = v0[3];
      sT[(kl + 32) * 65 + nl] = v1[0]; sT[(kl + 32) * 65 + nl + 1] = v1[1]; sT[(kl + 32) * 65 + nl + 2] = v1[2]; sT[(kl + 32) * 65 + nl + 3] = v1[3]; }
    __syncthreads();
    { const int nl = t >> 3, kc = (t & 7) * 8; int ns = nl;
      if (j.perm && nl < 32) ns = (nl & 1) ? 16 + (nl >> 1) : (nl >> 1);
      float q[8];
#pragma unroll
      for (int i = 0; i < 8; ++i) q[i] = sT[(kc + i) * 65 + ns];
      u32x4 w = {cvtpk(q[0], q[1]), cvtpk(q[2], q[3]), cvtpk(q[4], q[5]), cvtpk(q[6], q[7])};
      *(u32x4*)(j.dst + (size_t)(j.n0 + nl) * j.ld_dst + j.k0 + kc) = w; }
    __syncthreads();
}
DI TJob win_job(const Params& p, int j) {
    TJob r; const int nt = j >> 5, kt = j & 31, n0 = nt * 64;
    r.src = p.in[2]; r.dst = (bf16_t*)((unsigned char*)p.out + DO_WINT); r.ld_src = NIN; r.ld_dst = DM; r.k0 = kt * 64; r.n0 = n0;
    r.perm = (n0 >= 4096 && n0 < 6656 && (n0 & 127) == 0) ? 1 : 0; r.pad_ = 0; return r;
}
DI TJob small_job(const Params& p, int j) {
    TJob r; constexpr int J_SQ = 32 * 32;
    if (j < 3 * J_SQ) { const int which = j >> 10, q = j & 1023, nt = q >> 5, kt = q & 31;
        r.src = p.in[11 + which]; r.dst = (bf16_t*)(p.ws + (which == 0 ? WS_WAT : which == 1 ? WS_WBT : WS_WOT)); r.ld_src = DM; r.ld_dst = DM; r.k0 = kt * 64; r.n0 = nt * 64; }
    else { const int jj = j - 3 * J_SQ, gate = jj >> 7, q = jj & 127, blk = q >> 2, sub = q & 3, d = blk >> 4, nb = blk & 15;
        r.src = p.in[gate == 0 ? 5 : 7] + (size_t)blk * 16384; r.dst = (bf16_t*)(p.ws + WS_LWT) + (size_t)((d * 2 + gate) * 16 + nb) * 16384;
        r.ld_src = 128; r.ld_dst = 128; r.k0 = (sub >> 1) * 64; r.n0 = (sub & 1) * 64; }
    r.perm = 0; r.pad_ = 0; return r;
}
DI void phase_prep(const Params& p, unsigned char* shm) {
    const int tid = threadIdx.x, wid = tid >> 6, lane = tid & 63;
    bf16_t* xn = (bf16_t*)((unsigned char*)p.out + DO_XN);
    {
        const float* x = p.in[0]; const float* nw = p.in[1];
        f32x4 w[8];
#pragma unroll
        for (int i = 0; i < 8; ++i) w[i] = *(const f32x4*)(nw + i * 256 + lane * 4);
        for (int row = (blockIdx.x * 8 + wid) * 2; row < S; row += gridDim.x * 16) {
            f32x4 v[2][8];
#pragma unroll
            for (int r = 0; r < 2; ++r)
#pragma unroll
                for (int i = 0; i < 8; ++i) v[r][i] = __builtin_nontemporal_load((const f32x4*)(x + (size_t)(row + r) * DM + i * 256 + lane * 4));
#pragma unroll
            for (int r = 0; r < 2; ++r) {
                float ss = 0.f;
#pragma unroll
                for (int i = 0; i < 8; ++i) ss += v[r][i][0] * v[r][i][0] + v[r][i][1] * v[r][i][1] + v[r][i][2] * v[r][i][2] + v[r][i][3] * v[r][i][3];
                ss = wave_sum(ss);
                const float rs = rsqrtf(ss * (1.f / DM) + EPS);
#pragma unroll
                for (int i = 0; i < 8; ++i) {
                    u32x2 o = {cvtpk(v[r][i][0] * rs * w[i][0], v[r][i][1] * rs * w[i][1]), cvtpk(v[r][i][2] * rs * w[i][2], v[r][i][3] * rs * w[i][3])};
                    *(u32x2*)(xn + (size_t)(row + r) * DM + i * 256 + lane * 4) = o; }
            }
        }
    }
    {
        float* cosT = (float*)(p.ws + WS_ROPE); float* sinT = cosT + (size_t)S * 16;
        for (int i = blockIdx.x * 512 + tid; i < S * 16; i += gridDim.x * 512) {
            const int pos = i >> 4, j = i & 15;
            const float ang = (float)pos * p.inv_freq[j];
            const double rev = (double)ang * 0.15915494309189535; const float fr = (float)(rev - rint(rev));
            cosT[i] = __builtin_amdgcn_cosf(fr); sinT[i] = __builtin_amdgcn_sinf(fr);
        }
    }
    {
        float* sT = (float*)shm; constexpr int NG = 208 * 8;
        const float* src = p.in[2]; bf16_t* dst = (bf16_t*)((unsigned char*)p.out + DO_WINT);
        const int t = threadIdx.x, kl = t >> 4, nl4 = (t & 15) * 4, onl = t >> 3, okc = (t & 7) * 8;
        int g = blockIdx.x;
        if (g < NG) {
            f32x4 v[8];
#pragma unroll
            for (int q = 0; q < 8; ++q) v[q] = __builtin_nontemporal_load((const f32x4*)(src + (size_t)((g & 7) * 256 + q * 32 + kl) * NIN + (g >> 3) * 64 + nl4));
            for (;;) {
                const int gn = g + (int)gridDim.x; const bool more = gn < NG; const int gl = more ? gn : g;
                f32x4 vn[8];
#pragma unroll
                for (int q = 0; q < 8; ++q) vn[q] = __builtin_nontemporal_load((const f32x4*)(src + (size_t)((gl & 7) * 256 + q * 32 + kl) * NIN + (gl >> 3) * 64 + nl4));
#pragma unroll
                for (int q = 0; q < 8; ++q) { float* d = sT + (q * 32 + kl) * 65 + nl4; d[0] = v[q][0]; d[1] = v[q][1]; d[2] = v[q][2]; d[3] = v[q][3]; }
                __syncthreads();
                { const int n0 = (g >> 3) * 64, k0 = (g & 7) * 256; int ns = onl;
                  if (n0 >= 4096 && n0 < 6656 && (n0 & 127) == 0 && onl < 32) ns = (onl & 1) ? 16 + (onl >> 1) : (onl >> 1);
#pragma unroll
                  for (int q = 0; q < 4; ++q) { float f[8];
#pragma unroll
                      for (int i = 0; i < 8; ++i) f[i] = sT[(q * 64 + okc + i) * 65 + ns];
                      *(u32x4*)(dst + (size_t)(n0 + onl) * DM + k0 + q * 64 + okc) = (u32x4){cvtpk(f[0], f[1]), cvtpk(f[2], f[3]), cvtpk(f[4], f[5]), cvtpk(f[6], f[7])}; } }
                __syncthreads();
                if (!more) break;
#pragma unroll
                for (int q = 0; q < 8; ++q) v[q] = vn[q];
                g = gn;
            }
        }
    }
}
DI void prep_small_weights(const Params& p, unsigned char* shm, int idx, int stride) {
    float* sT = (float*)shm; constexpr int NJ = 3 * 1024 + 256;
    int j = idx;
    if (j < NJ) {
        TJob cur = small_job(p, j); f32x4 v0, v1; tr_load(cur, v0, v1);
        for (;;) {
            const int jn = j + stride; const bool more = jn < NJ;
            const TJob nxt = small_job(p, more ? jn : j); f32x4 n0, n1; tr_load(nxt, n0, n1);
            tr_store(cur, v0, v1, sT);
            if (!more) break;
            cur = nxt; v0 = n0; v1 = n1; j = jn;
        }
    }
}

DI void lru_copy_out(const bf16_t* OS, bf16_t* dst_tile, int t) {
    const int row = t >> 2, seg = (t & 3) * 32;
#pragma unroll
    for (int k = 0; k < 4; ++k) { const u32x4 v = *(const u32x4*)(OS + row * 136 + seg + k * 8); *(u32x4*)(dst_tile + (size_t)row * 2048 + seg + k * 8) = v; }
}
DI void lru_tile(const Params& p, unsigned char* shm, int c, int nb) {
    int tid = threadIdx.x; asm volatile("" : "+v"(tid));
    const int wid = __builtin_amdgcn_readfirstlane(tid >> 6), lane = tid & 63;
    constexpr int LDU = 136;
    bf16_t* UB = (bf16_t*)shm;
    bf16_t* PS = (bf16_t*)(shm + 34816);
    bf16_t* OS = (bf16_t*)(shm + 2 * 34816);
    f32x2* AG = (f32x2*)(shm + 3 * 34816) + wid * 512;
    const bf16_t* ZU = (const bf16_t*)(p.ws + WS_ZU);
    {
        const int cgp = tid & 15, rg = tid >> 4, ch = nb * 128 + cgp * 8;
        const float* cw = p.in[3]; const float* cb = p.in[4];
        float w[4][8], bias[8];
#pragma unroll
        for (int tp = 0; tp < 4; ++tp) { const f32x4 a = *(const f32x4*)(cw + tp * 2048 + ch), b = *(const f32x4*)(cw + tp * 2048 + ch + 4);
            w[tp][0] = a[0]; w[tp][1] = a[1]; w[tp][2] = a[2]; w[tp][3] = a[3]; w[tp][4] = b[0]; w[tp][5] = b[1]; w[tp][6] = b[2]; w[tp][7] = b[3]; }
        { const f32x4 a = *(const f32x4*)(cb + ch), b = *(const f32x4*)(cb + ch + 4);
            bias[0] = a[0]; bias[1] = a[1]; bias[2] = a[2]; bias[3] = a[3]; bias[4] = b[0]; bias[5] = b[1]; bias[6] = b[2]; bias[7] = b[3]; }
        float xr[7][8];
#pragma unroll
        for (int k = 0; k < 7; ++k) { const int t = c * 128 + rg * 4 - 2 + k;
            u32x4 v = {0u, 0u, 0u, 0u};
            if (t >= 0 && t < S) v = *(const u32x4*)(ZU + (size_t)(nb >> 1) * S * 256 + (size_t)t * 256 + (nb & 1) * 128 + cgp * 8);
#pragma unroll
            for (int i = 0; i < 4; ++i) { xr[k][2 * i] = bflo(v[i]); xr[k][2 * i + 1] = bfhi(v[i]); } }
#pragma unroll
        for (int o = 0; o < 4; ++o) { float u8[8];
#pragma unroll
            for (int i = 0; i < 8; ++i) { float a = bias[i];
#pragma unroll
                for (int tp = 0; tp < 4; ++tp) a += xr[o + tp][i] * w[tp][i];
                u8[i] = a; }
            *(u32x4*)(UB + (rg * 4 + o) * LDU + cgp * 8) = (u32x4){cvtpk(u8[0], u8[1]), cvtpk(u8[2], u8[3]), cvtpk(u8[4], u8[5]), cvtpk(u8[6], u8[7])};
        }
    }
    __syncthreads();
    const int col = lane & 15, q = lane >> 4;
    const int chl = wid * 16 + col, chg = nb * 128 + chl;
    float hsum[8][4]; unsigned ppk[8][2];
    f32x2* AGG = (f32x2*)(p.ws + WS_AGG);
    const bf16_t* LWT = (const bf16_t*)(p.ws + WS_LWT);
#pragma unroll
    for (int d = 0; d < 2; ++d) {
        f32x4 acc[2][8];
#pragma unroll
        for (int a = 0; a < 2; ++a)
#pragma unroll
            for (int b = 0; b < 8; ++b) acc[a][b] = (f32x4){0.f, 0.f, 0.f, 0.f};
        bf16x8 bfr[4][2];
#pragma unroll
        for (int s = 0; s < 4; ++s)
#pragma unroll
            for (int gt = 0; gt < 2; ++gt) bfr[s][gt] = *(const bf16x8*)(LWT + ((size_t)((d * 2 + gt) * 16 + nb) * 128 + chl) * 128 + s * 32 + q * 8);
        const float br = p.in[6][d * 2048 + chg], bi = p.in[8][d * 2048 + chg], lam = p.in[9][d * 2048 + chg];
#pragma unroll
        for (int s = 0; s < 4; ++s) {
#pragma unroll
            for (int rt = 0; rt < 8; ++rt) {
                const bf16x8 af = *(const bf16x8*)(UB + (rt * 16 + col) * LDU + s * 32 + q * 8);
#pragma unroll
                for (int gt = 0; gt < 2; ++gt) acc[gt][rt] = __builtin_amdgcn_mfma_f32_16x16x32_bf16(af, bfr[s][gt], acc[gt][rt], 0, 0, 0);
            }
            __builtin_amdgcn_sched_barrier(0);
        }
        const float sp = log1pf(expf(-lam));
        const float cdec = -8.f * sp * LOG2E;
        const f32x2 nl2 = {-LOG2E, -LOG2E}, nbr2 = {-br * LOG2E, -br * LOG2E}, nbi2 = {-bi * LOG2E, -bi * LOG2E}, cd2 = {cdec, cdec}, one2 = {1.f, 1.f};
        float hl[8][4], pc[8][4];
#pragma unroll
        for (int rt = 0; rt < 8; ++rt) {
            float av[4], bv[4];
#pragma unroll
            for (int jp = 0; jp < 2; ++jp) {
                const f32x2 xr = {acc[0][rt][2 * jp], acc[0][rt][2 * jp + 1]}, xi = {acc[1][rt][2 * jp], acc[1][rt][2 * jp + 1]};
                f32x2 er = xr * nl2 + nbr2, ei = xi * nl2 + nbi2;
                er = (f32x2){ex2(er[0]), ex2(er[1])} + one2; ei = (f32x2){ex2(ei[0]), ex2(ei[1])} + one2;
                const f32x2 r = {rcpf_(er[0]), rcpf_(er[1])}, ig = {rcpf_(ei[0]), rcpf_(ei[1])};
                const f32x2 la = r * cd2;
                const f32x2 a = {ex2(la[0]), ex2(la[1])};
                const f32x2 om = one2 - a * a;
                const f32x2 sc = {__builtin_amdgcn_sqrtf(om[0]), __builtin_amdgcn_sqrtf(om[1])};
                const f32x2 u2 = {bf2f(UB[(rt * 16 + 4 * q + 2 * jp) * LDU + chl]), bf2f(UB[(rt * 16 + 4 * q + 2 * jp + 1) * LDU + chl])};
                const f32x2 b2 = sc * ig * u2;
                av[2 * jp] = a[0]; av[2 * jp + 1] = a[1]; bv[2 * jp] = b2[0]; bv[2 * jp + 1] = b2[1];
            }
            float h = 0.f, P = 1.f;
            if (d == 0) {
#pragma unroll
                for (int j = 0; j < 4; ++j) { h = fmaf(av[j], h, bv[j]); P *= av[j]; hl[rt][j] = h; pc[rt][j] = P; }
            } else {
#pragma unroll
                for (int j = 3; j >= 0; --j) { h = fmaf(av[j], h, bv[j]); P *= av[j]; hl[rt][j] = h; pc[rt][j] = P; }
            }
            AG[(rt * 4 + q) * 16 + col] = (f32x2){P, h};
            __builtin_amdgcn_sched_barrier(0);
        }
        asm volatile("s_waitcnt lgkmcnt(0)" ::: "memory");
        float carry[8], pref[8]; float cin = 0.f, pa = 1.f;
#pragma unroll
        for (int gi = 0; gi < 32; ++gi) {
            const int G = d == 0 ? gi : 31 - gi; const int rt = G >> 2, qq = G & 3;
            const f32x2 ah = AG[G * 16 + col];
            if (qq == q) { carry[rt] = cin; pref[rt] = pa; }
            cin = fmaf(ah[0], cin, ah[1]); pa *= ah[0];
        }
        if (q == 0) AGG[((size_t)d * 128 + c) * 2048 + chg] = (f32x2){pa, cin};
#pragma unroll
        for (int rt = 0; rt < 8; ++rt) {
            const f32x2 cr2 = {carry[rt], carry[rt]}, pf2 = {pref[rt] * 255.f, pref[rt] * 255.f}, half2 = {0.5f, 0.5f};
#pragma unroll
            for (int jp = 0; jp < 2; ++jp) {
                const f32x2 pc2 = {pc[rt][2 * jp], pc[rt][2 * jp + 1]}, hl2 = {hl[rt][2 * jp], hl[rt][2 * jp + 1]};
                const f32x2 hf = pc2 * cr2 + hl2, pq = pc2 * pf2 + half2;
                const unsigned q0 = (unsigned)pq[0], q1 = (unsigned)pq[1];
                if (d == 0) { hsum[rt][2 * jp] = hf[0]; hsum[rt][2 * jp + 1] = hf[1]; ppk[rt][jp] = q0 | (q1 << 16); }
                else {
                    const int lo = (rt * 16 + 4 * q + 2 * jp) * LDU + chl;
                    const unsigned w = cvtpk(hsum[rt][2 * jp] + hf[0], hsum[rt][2 * jp + 1] + hf[1]);
                    OS[lo] = (unsigned short)(w & 0xffffu); OS[lo + LDU] = (unsigned short)(w >> 16);
                    const unsigned pw = ppk[rt][jp] | (q0 << 8) | (q1 << 24);
                    PS[lo] = (unsigned short)(pw & 0xffffu); PS[lo + LDU] = (unsigned short)(pw >> 16);
                }
            }
            __builtin_amdgcn_sched_barrier(0);
        }
    }
    __syncthreads();
    lru_copy_out(OS, (bf16_t*)((unsigned char*)p.out + DO_ACF) + (size_t)c * 128 * 2048 + nb * 128, tid);
    lru_copy_out(PS, (bf16_t*)((unsigned char*)p.out + DO_ACB) + (size_t)c * 128 * 2048 + nb * 128, tid);
}

namespace att {
constexpr float SCALE = 0.088388347648318440f, THR = 8.f;
constexpr int SHM_V = 64 * 128 * 2, SHM_K = SHM_V, LDK = 3072;
#define KSWZ(row, colB) ((row) * 256 + ((colB) ^ (((row) & 7) << 4)))
#define SBAR() __builtin_amdgcn_sched_barrier(0)
DI int crow(int r, int hi) { return (r & 3) + 8 * (r >> 2) + 4 * hi; }
DI void maskT(f32x16& p0, f32x16& p1, int kt, int qw, int r32, int hi) {
    if ((kt - qw - 31 < -128) || (kt + 63 - qw > 128)) {
        const int db = kt - (qw + r32) + 4 * hi;
#pragma unroll
        for (int r = 0; r < 16; ++r) { const int d = db + (r & 3) + 8 * (r >> 2);
            p0[r] = (d >= -128 && d <= 128) ? p0[r] : -1e30f; p1[r] = (d + 32 >= -128 && d + 32 <= 128) ? p1[r] : -1e30f; }
    }
}
DI void partialSM(f32x16& p0, f32x16& p1, float& m_reg, float& mn, float& alpha) {
    constexpr float C = SCALE * 1.4426950408889634f;
    float pmax = p0[0];
#pragma unroll
    for (int r = 1; r < 16; ++r) pmax = fmaxf(pmax, p0[r]);
#pragma unroll
    for (int r = 0; r < 16; ++r) pmax = fmaxf(pmax, p1[r]);
    { auto rr = __builtin_amdgcn_permlane32_swap(__float_as_uint(pmax), __float_as_uint(pmax), false, false);
      pmax = fmaxf(__uint_as_float(rr[0]), __uint_as_float(rr[1])); }
    if (__builtin_expect(__all(pmax - m_reg <= THR / SCALE), 1)) { mn = m_reg; alpha = 1.f; }
    else { mn = fmaxf(m_reg, pmax); alpha = __builtin_amdgcn_exp2f((m_reg - mn) * C); m_reg = mn; }
    const float mnC = -mn * C;
#pragma unroll
    for (int r = 0; r < 16; ++r) p0[r] = fmaf(p0[r], C, mnC);
#pragma unroll
    for (int r = 0; r < 16; ++r) p1[r] = fmaf(p1[r], C, mnC);
#pragma unroll
    for (int r = 0; r < 16; ++r) p0[r] = __builtin_amdgcn_exp2f(p0[r]);
}
DI void finishSM(f32x16& p0, f32x16& p1, float alpha, float& l_reg, bf16x8& pa0, bf16x8& pa1, bf16x8& pa2, bf16x8& pa3) {
#pragma unroll
    for (int r = 0; r < 16; ++r) p1[r] = __builtin_amdgcn_exp2f(p1[r]);
    float ps = 0;
#pragma unroll
    for (int r = 0; r < 16; ++r) ps += p0[r];
#pragma unroll
    for (int r = 0; r < 16; ++r) ps += p1[r];
    { auto rr = __builtin_amdgcn_permlane32_swap(__float_as_uint(ps), __float_as_uint(ps), false, false);
      ps = __uint_as_float(rr[0]) + __uint_as_float(rr[1]); }
    l_reg = l_reg * alpha + ps;
#define PK4(P, BASE, OUT) do { unsigned a0 = cvtpk(P[BASE + 0], P[BASE + 1]), a1 = cvtpk(P[BASE + 2], P[BASE + 3]);   \
    unsigned b0 = cvtpk(P[BASE + 4], P[BASE + 5]), b1 = cvtpk(P[BASE + 6], P[BASE + 7]);                              \
    auto r0 = __builtin_amdgcn_permlane32_swap(a0, b0, false, false); auto r1 = __builtin_amdgcn_permlane32_swap(a1, b1, false, false); \
    u32x4 w = {r0[0], r1[0], r0[1], r1[1]}; OUT = __builtin_bit_cast(bf16x8, w); } while (0)
    PK4(p0, 0, pa0); PK4(p0, 8, pa1); PK4(p1, 0, pa2); PK4(p1, 8, pa3);
#undef PK4
}
DI void qkt(f32x16& p0, f32x16& p1, const char* Ks, const bf16x8* qr, int r32, int hi) {
#pragma unroll
    for (int i = 0; i < 16; ++i) { p0[i] = 0.f; p1[i] = 0.f; }
#pragma unroll
    for (int d0 = 0; d0 < 8; ++d0) { const int cb = (d0 * 16 + hi * 8) * 2;
        const bf16x8 b0 = *reinterpret_cast<const bf16x8*>(Ks + KSWZ(r32, cb));
        const bf16x8 b1 = *reinterpret_cast<const bf16x8*>(Ks + KSWZ(32 + r32, cb));
        p0 = __builtin_amdgcn_mfma_f32_32x32x16_bf16(b0, qr[d0], p0, 0, 0, 0);
        p1 = __builtin_amdgcn_mfma_f32_32x32x16_bf16(b1, qr[d0], p1, 0, 0, 0); }
}
DI int v_st(int k, int c) { const int kk = (k & ~0xC) | ((k & 4) << 1) | ((k & 8) >> 1); return ((kk >> 3) * 4 + (c >> 5)) * 512 + ((kk & 7) * 32 + (c & 31)) * 2; }
DI int v_rd_base(int lane) { return ((lane & 3) << 3) | (((lane >> 2) & 3) << 6) | (((lane >> 4) & 1) << 5) | (((lane >> 5) & 1) << 8); }
constexpr int v_rd_off(int d0, int ks, int half) { return d0 * 512 + ks * 4096 + half * 2048; }
template <int OFF> DI s16x4 tr_read(int vb) {
    s16x4 r; asm volatile("ds_read_b64_tr_b16 %0, %1 offset:%2" : "=&v"(r) : "v"(vb), "i"(OFF) : "memory"); return r;
}
template <int D0> DI void pv_one(f32x16& od, int vb, bf16x8 pa0, bf16x8 pa1, bf16x8 pa2, bf16x8 pa3) {
    const s16x4 l0 = tr_read<v_rd_off(D0, 0, 0)>(vb), h0 = tr_read<v_rd_off(D0, 0, 1)>(vb), l1 = tr_read<v_rd_off(D0, 1, 0)>(vb), h1 = tr_read<v_rd_off(D0, 1, 1)>(vb);
    const s16x4 l2 = tr_read<v_rd_off(D0, 2, 0)>(vb), h2 = tr_read<v_rd_off(D0, 2, 1)>(vb), l3 = tr_read<v_rd_off(D0, 3, 0)>(vb), h3 = tr_read<v_rd_off(D0, 3, 1)>(vb);
    asm volatile("s_waitcnt lgkmcnt(0)" ::: "memory"); SBAR();
#define PK(L, H) (bf16x8){L[0], L[1], L[2], L[3], H[0], H[1], H[2], H[3]}
    od = __builtin_amdgcn_mfma_f32_32x32x16_bf16(pa0, PK(l0, h0), od, 0, 0, 0);
    od = __builtin_amdgcn_mfma_f32_32x32x16_bf16(pa1, PK(l1, h1), od, 0, 0, 0);
    od = __builtin_amdgcn_mfma_f32_32x32x16_bf16(pa2, PK(l2, h2), od, 0, 0, 0);
    od = __builtin_amdgcn_mfma_f32_32x32x16_bf16(pa3, PK(l3, h3), od, 0, 0, 0);
#undef PK
}
DI void pv_d0(f32x16* o, int vb, bf16x8 pa0, bf16x8 pa1, bf16x8 pa2, bf16x8 pa3) {
    pv_one<0>(o[0], vb, pa0, pa1, pa2, pa3); pv_one<1>(o[1], vb, pa0, pa1, pa2, pa3); pv_one<2>(o[2], vb, pa0, pa1, pa2, pa3); pv_one<3>(o[3], vb, pa0, pa1, pa2, pa3);
}
DI void attn_item(const bf16_t* __restrict__ Qw_, const bf16_t* __restrict__ Kh, const bf16_t* __restrict__ Vh, const bf16_t* Gw, bf16_t* Ow,
                  int NT, int kt0, int qw, float sinkv, char* lds) {
    const int tid = threadIdx.x, wid = __builtin_amdgcn_readfirstlane(tid >> 6), lane = tid & 63, r32 = lane & 31, hi = lane >> 5;
    char* V_lds = lds; char* K_lds = lds + 2 * SHM_V;
    float* wsp = (float*)(lds + 2 * SHM_V + 2 * SHM_K) + wid * 64; float* li_l = wsp; float* al_l = wsp + 32;
    float m_reg = sinkv * (1.f / SCALE), l_reg = 1.f; f32x16 o[4]; bf16x8 qr[8];
#pragma unroll
    for (int d = 0; d < 4; ++d)
#pragma unroll
        for (int r = 0; r < 16; ++r) o[d][r] = 0.f;
    const bf16_t* Qw = Qw_ + (size_t)r32 * LDK + hi * 8;
#pragma unroll
    for (int d0 = 0; d0 < 8; ++d0) qr[d0] = *(const bf16x8*)(Qw + d0 * 16);
    const int sr = tid >> 4, sc = (tid & 15) * 8, vst0 = v_st(sr, sc), vst1 = v_st(32 + sr, sc);
    const int vb0 = (int)(uintptr_t)V_lds + v_rd_base(lane);
    struct { bf16x8 vs0, vs1, ks0, ks1; } sr_[2];
#define SLOAD(i, k0) do { sr_[i].vs0 = *(const bf16x8*)(&Vh[(size_t)((k0) + sr) * LDK + sc]); sr_[i].vs1 = *(const bf16x8*)(&Vh[(size_t)((k0) + 32 + sr) * LDK + sc]); \
    sr_[i].ks0 = *(const bf16x8*)(&Kh[(size_t)((k0) + sr) * LDK + sc]); sr_[i].ks1 = *(const bf16x8*)(&Kh[(size_t)((k0) + 32 + sr) * LDK + sc]); } while (0)
#define SWRITE(b, i) do { *(bf16x8*)(V_lds + (b) * SHM_V + vst0) = sr_[i].vs0;          \
    *(bf16x8*)(V_lds + (b) * SHM_V + vst1) = sr_[i].vs1; const int kc = sc * 2;               \
    *(bf16x8*)(K_lds + (b) * SHM_K + KSWZ(sr, kc)) = sr_[i].ks0;                       \
    *(bf16x8*)(K_lds + (b) * SHM_K + KSWZ(32 + sr, kc)) = sr_[i].ks1; } while (0)
#define SWAIT() asm volatile("s_waitcnt vmcnt(4)" ::: "memory")
#define RESC(a) do { if (__any((a) < 1.f)) { if (hi == 0) al_l[r32] = (a); asm volatile("s_waitcnt lgkmcnt(0)" ::: "memory"); \
    _Pragma("unroll") for (int d = 0; d < 4; ++d) _Pragma("unroll") for (int r = 0; r < 16; ++r) o[d][r] *= al_l[crow(r, hi)]; } } while (0)
    f32x16 pA0, pA1, pB0, pB1; float mnA, mnB, alA, alB; bf16x8 pa0, pa1, pa2, pa3;
    constexpr int SE = 0, SO = 1;
    SLOAD(SE, 0); asm volatile("s_waitcnt vmcnt(0)" ::: "memory"); SWRITE(0, SE); __syncthreads();
    qkt(pA0, pA1, K_lds, qr, r32, hi); maskT(pA0, pA1, kt0, qw, r32, hi); partialSM(pA0, pA1, m_reg, mnA, alA);
    SLOAD(SO, 64); if (2 < NT) SLOAD(SE, 128);
    SWAIT(); SWRITE(1, SO); __syncthreads();
    for (int j = 1; j + 1 < NT; j += 2) {
        SBAR(); qkt(pB0, pB1, K_lds + SHM_K, qr, r32, hi);
        finishSM(pA0, pA1, alA, l_reg, pa0, pa1, pa2, pa3); SBAR();
        SLOAD(SO, (j + 2) * 64); SBAR();
        pv_d0(o, vb0, pa0, pa1, pa2, pa3); maskT(pB0, pB1, kt0 + 64 * j, qw, r32, hi); partialSM(pB0, pB1, m_reg, mnB, alB);
        __syncthreads(); SWAIT(); SWRITE(0, SE);
        RESC(alB); __syncthreads();
        SBAR(); qkt(pA0, pA1, K_lds, qr, r32, hi);
        finishSM(pB0, pB1, alB, l_reg, pa0, pa1, pa2, pa3); SBAR();
        if (j + 3 < NT) SLOAD(SE, (j + 3) * 64); SBAR();
        pv_d0(o, vb0 + SHM_V, pa0, pa1, pa2, pa3); maskT(pA0, pA1, kt0 + 64 * (j + 1), qw, r32, hi); partialSM(pA0, pA1, m_reg, mnA, alA);
        __syncthreads(); SWAIT(); SWRITE(1, SO);
        RESC(alA); __syncthreads();
    }
    SBAR(); qkt(pB0, pB1, K_lds + SHM_K, qr, r32, hi);
    finishSM(pA0, pA1, alA, l_reg, pa0, pa1, pa2, pa3); SBAR();
    pv_d0(o, vb0, pa0, pa1, pa2, pa3); maskT(pB0, pB1, kt0 + 64 * (NT - 1), qw, r32, hi); partialSM(pB0, pB1, m_reg, mnB, alB);
    __syncthreads(); RESC(alB);
    finishSM(pB0, pB1, alB, l_reg, pa0, pa1, pa2, pa3); SBAR();
    pv_d0(o, vb0 + SHM_V, pa0, pa1, pa2, pa3);
    int lane2 = threadIdx.x & 63; asm volatile("" : "+v"(lane2));
    const int ec = lane2 & 15, er = lane2 >> 4;
    if (hi == 0) li_l[r32] = l_reg; asm volatile("s_waitcnt lgkmcnt(0)" ::: "memory");
    bf16_t* OT = (bf16_t*)(lds + 67584 + wid * 8704);
#pragma unroll
    for (int r = 0; r < 16; ++r) { const int orow = crow(r, hi); const float rl = __builtin_amdgcn_rcpf(li_l[orow]);
#pragma unroll
        for (int d0 = 0; d0 < 4; ++d0) OT[orow * 136 + d0 * 32 + r32] = f2bf(o[d0][r] * rl); }
    __builtin_amdgcn_sched_barrier(0);
    u32x4 gv[8];
#pragma unroll
    for (int k = 0; k < 8; ++k) gv[k] = __builtin_nontemporal_load((const u32x4*)(Gw + (size_t)(er + 4 * k) * 2048 + ec * 8));
    asm volatile("s_waitcnt lgkmcnt(0)" ::: "memory");
#pragma unroll
    for (int k = 0; k < 8; ++k) {
        const u32x4 ov = *(const u32x4*)(OT + (er + 4 * k) * 136 + ec * 8); u32x4 w;
#pragma unroll
        for (int i = 0; i < 4; ++i) { const float g0 = bflo(gv[k][i]), g1 = bfhi(gv[k][i]); w[i] = cvtpk(bflo(ov[i]) * g0 * sigm(g0), bfhi(ov[i]) * g1 * sigm(g1)); }
        *(u32x4*)(Ow + (size_t)(er + 4 * k) * 2048 + ec * 8) = w;
    }
#undef SLOAD
#undef SWRITE
#undef SWAIT
#undef RESC
}
}

DI void phase_lru(const Params& p, unsigned char* shm) {
    for (int it = blockIdx.x; it < 2048; it += gridDim.x) lru_tile(p, shm, it >> 4, it & 15);
    __syncthreads();
}
DI void phase_att(const Params& p, unsigned char* shm) {
    const int wid = __builtin_amdgcn_readfirstlane(threadIdx.x >> 6);
    const bf16_t* Z = (const bf16_t*)(p.ws + WS_ZQKV); const bf16_t* GA = (const bf16_t*)(p.ws + WS_ZGA); bf16_t* YB = (bf16_t*)(p.ws + WS_YB);
    for (int it = blockIdx.x; it < 1024; it += gridDim.x) {
        const int hp = it & 1, g = (it >> 1) & 3, n = it >> 3;
        const int head = g * 4 + hp * 2 + (wid >> 2), qw = 32 * (wid & 3);
        const int kfirst = n == 0 ? 0 : (n - 1) * 128, NT = (n == 0 || n == 127) ? 4 : 6, kt0 = kfirst - n * 128;
        __syncthreads();
        const size_t go = (size_t)(n * 128 + qw) * 2048 + head * 128;
        att::attn_item(Z + (size_t)(n * 128 + qw) * 3072 + head * 128, Z + (size_t)kfirst * 3072 + 2048 + g * 128, Z + (size_t)kfirst * 3072 + 2560 + g * 128,
                       GA + go, YB + go, NT, kt0, qw, p.in[10][head], (char*)shm);
    }
    __syncthreads();
}
DI void phase_mixers(const Params& p, unsigned char* shm) { if (p.mix_mask & 1) phase_lru(p, shm); if (p.mix_mask & 2) phase_att(p, shm); }

DI void phase_carry(const Params& p) {
    const int tid = threadIdx.x;
    if (tid >= 64) return;
    const f32x2* AGG = (const f32x2*)(p.ws + WS_AGG); float* CAR = (float*)(p.ws + WS_CAR);
    for (int w = blockIdx.x; w < 64; w += gridDim.x) {
        const int id = w * 64 + tid, d = id >> 11, ch = id & 2047;
        const f32x2* ag = AGG + (size_t)d * 128 * 2048 + ch; float* car = CAR + (size_t)d * 128 * 2048 + ch;
        float cin = 0.f;
        for (int b = 0; b < 4; ++b) {
            f32x2 v[32];
#pragma unroll
            for (int u = 0; u < 32; ++u) { const int k = b * 32 + u, cc = d == 0 ? k : 127 - k; v[u] = ag[(size_t)cc * 2048]; }
#pragma unroll
            for (int u = 0; u < 32; ++u) { const int k = b * 32 + u, cc = d == 0 ? k : 127 - k; car[(size_t)cc * 2048] = cin; cin = fmaf(v[u][0], cin, v[u][1]); }
        }
    }
}
DI void phase_fixup(const Params& p) {
    const int tid = threadIdx.x, ch = (tid & 255) * 8, r2 = tid >> 8;
    const float* CAR = (const float*)(p.ws + WS_CAR);
    bf16_t* ZG = (bf16_t*)(p.ws + WS_ZG);
    const bf16_t* HLp = (const bf16_t*)((unsigned char*)p.out + DO_ACF); const bf16_t* PPp = (const bf16_t*)((unsigned char*)p.out + DO_ACB);
    for (int it = blockIdx.x; it < 512; it += gridDim.x) {
        const int c = it >> 2, rq = it & 3;
        float cf[8], cb[8];
        { const f32x4 a0 = *(const f32x4*)(CAR + (size_t)c * 2048 + ch), a1 = *(const f32x4*)(CAR + (size_t)c * 2048 + ch + 4);
          const f32x4 b0 = *(const f32x4*)(CAR + (size_t)(128 + c) * 2048 + ch), b1 = *(const f32x4*)(CAR + (size_t)(128 + c) * 2048 + ch + 4);
#pragma unroll
          for (int i = 0; i < 4; ++i) { cf[i] = a0[i] * (1.f / 255.f); cf[4 + i] = a1[i] * (1.f / 255.f); cb[i] = b0[i] * (1.f / 255.f); cb[4 + i] = b1[i] * (1.f / 255.f); } }
#pragma unroll 8
        for (int i = 0; i < 16; ++i) {
            const size_t off = (size_t)(c * 128 + rq * 32 + 2 * i + r2) * 2048 + ch;
            const u32x4 g = __builtin_nontemporal_load((const u32x4*)(ZG + off)), h = __builtin_nontemporal_load((const u32x4*)(HLp + off)), pp = __builtin_nontemporal_load((const u32x4*)(PPp + off));
            u32x4 o;
#pragma unroll
            for (int k = 0; k < 4; ++k) {
                const float g0 = bflo(g[k]), g1 = bfhi(g[k]);
                const float y0 = (bflo(h[k]) + ub(pp[k], 0) * cf[2 * k] + ub(pp[k], 1) * cb[2 * k]) * g0 * sigm(g0);
                const float y1 = (bfhi(h[k]) + ub(pp[k], 2) * cf[2 * k + 1] + ub(pp[k], 3) * cb[2 * k + 1]) * g1 * sigm(g1);
                o[k] = cvtpk(y0, y1);
            }
            *(u32x4*)(ZG + off) = o;
        }
    }
}

DI void phase_final(const Params& p) {
    const int tid = threadIdx.x, wid = tid >> 6, lane = tid & 63;
    const float* x = p.in[0]; const float* nw = p.in[14]; const bf16_t* o2 = (const bf16_t*)(p.ws + WS_OUT2); const float* ssq = (const float*)(p.ws + WS_SSQ);
    f32x4 w[8];
#pragma unroll
    for (int i = 0; i < 8; ++i) w[i] = *(const f32x4*)(nw + i * 256 + lane * 4);
    for (int row = (blockIdx.x * 8 + wid) * 2; row < S; row += gridDim.x * 16) {
        f32x4 xv[2][8]; u32x2 yv[2][8]; float sq[2];
#pragma unroll
        for (int r = 0; r < 2; ++r) {
            sq[r] = lane < 32 ? ssq[(size_t)(row + r) * 32 + lane] : 0.f;
#pragma unroll
            for (int i = 0; i < 8; ++i) { const size_t off = (size_t)(row + r) * DM + i * 256 + lane * 4; xv[r][i] = __builtin_nontemporal_load((const f32x4*)(x + off)); yv[r][i] = __builtin_nontemporal_load((const u32x2*)(o2 + off)); }
        }
#pragma unroll
        for (int r = 0; r < 2; ++r) {
            const float rs = rsqrtf(wave_sum(sq[r]) * (1.f / DM) + EPS);
#pragma unroll
            for (int i = 0; i < 8; ++i) { const size_t off = (size_t)(row + r) * DM + i * 256 + lane * 4;
                const f32x4 ov = {xv[r][i][0] + bflo(yv[r][i][0]) * rs * w[i][0], xv[r][i][1] + bfhi(yv[r][i][0]) * rs * w[i][1],
                                  xv[r][i][2] + bflo(yv[r][i][1]) * rs * w[i][2], xv[r][i][3] + bfhi(yv[r][i][1]) * rs * w[i][3]};
                __builtin_nontemporal_store(ov, (f32x4*)(p.out + off)); }
        }
    }
}

#define XB_TMO      128
#define XB_XCNT(j)  (256  + 64 * (j))
#define XB_XSUB(j)  (1280 + 64 * (j))
#define XB_XGEN(j)  (2304 + 64 * (j))
#define XB_TOP      3328
#define XB_TOPGEN   3392
#define XCD_BAR_WORDS 3456
#define XB_SPIN_CAP (1u << 18)

__device__ __forceinline__ unsigned xb_ld(unsigned* p)              { return __hip_atomic_load(p, __ATOMIC_RELAXED, __HIP_MEMORY_SCOPE_AGENT); }
__device__ __forceinline__ unsigned xb_add(unsigned* p, unsigned v) { return __hip_atomic_fetch_add(p, v, __ATOMIC_RELAXED, __HIP_MEMORY_SCOPE_AGENT); }
__device__ __forceinline__ unsigned xb_xcc_id() { return (unsigned)__builtin_amdgcn_s_getreg((3 << 11) | 20) & 0xFu; }
#define XB_SPIN(cond, bar) do { unsigned _sp = 0; while (cond) { __builtin_amdgcn_s_sleep(1); \
    if ((++_sp & 255u) == 0u) { if (xb_ld(&(bar)[XB_TMO])) break; if (_sp > XB_SPIN_CAP) { atomicAdd(&(bar)[XB_TMO], 1u); break; } } } } while (0)

struct XcdBarrier {
    unsigned* bar; unsigned x;
    volatile LAS unsigned* st;
};

__device__ __forceinline__ XcdBarrier xcd_barrier_post(unsigned* bar, volatile LAS unsigned* st) {
    XcdBarrier b; b.bar = bar; b.x = xb_xcc_id(); b.st = st;
    if (threadIdx.x == 0) (void)xb_add(&bar[XB_XCNT(b.x)], 1u);
    return b;
}
__device__ __forceinline__ void xcd_barrier_complete(unsigned* bar, unsigned x, unsigned& nloc, unsigned& nx) {
    const unsigned G = gridDim.x * gridDim.y * gridDim.z;
    unsigned sum, cnt, mine, sp = 0u;
    for (;;) {
        sum = 0u; cnt = 0u; mine = 0u;
#pragma unroll
        for (unsigned j = 0; j < 16; ++j) { const unsigned c = xb_ld(&bar[XB_XCNT(j)]); sum += c; cnt += (c > 0u) ? 1u : 0u; mine = (j == x) ? c : mine; }
        if (sum == G) break;
        __builtin_amdgcn_s_sleep(1);
        if ((++sp & 255u) == 0u) { if (xb_ld(&bar[XB_TMO])) break; if (sp > XB_SPIN_CAP) { atomicAdd(&bar[XB_TMO], 1u); break; } }
    }
    nloc = mine > 0u ? mine : 1u; nx = cnt > 0u ? cnt : 1u;
}

__device__ __forceinline__ void xcd_barrier(const XcdBarrier& b) {
    asm volatile("s_waitcnt vmcnt(0)" ::: "memory");
    __syncthreads();
    if (threadIdx.x == 0) {
        unsigned* bar = b.bar;
        __builtin_amdgcn_s_waitcnt(0);
        unsigned nloc = b.st[0], nx = b.st[1];
        if (nloc == 0u) { xcd_barrier_complete(bar, b.x, nloc, nx); b.st[0] = nloc; b.st[1] = nx; }
        const unsigned old = xb_add(&bar[XB_XSUB(b.x)], 1u);
        const unsigned gen = old / nloc;
        if (old + 1u == (gen + 1u) * nloc) {
            __builtin_amdgcn_fence(__ATOMIC_RELEASE, "agent");
            asm volatile("s_waitcnt vmcnt(0)" ::: "memory");
            const unsigned og = xb_add(&bar[XB_TOP], 1u);
            const unsigned tg = og / nx;
            if (og + 1u == (tg + 1u) * nx) xb_add(&bar[XB_TOPGEN], 1u);
            else XB_SPIN(xb_ld(&bar[XB_TOPGEN]) == tg, bar);
            __builtin_amdgcn_fence(__ATOMIC_ACQUIRE, "agent");
            xb_add(&bar[XB_XGEN(b.x)], 1u);
            asm volatile("s_waitcnt vmcnt(0)" ::: "memory");
        } else {
            XB_SPIN(xb_ld(&bar[XB_XGEN(b.x)]) == gen, bar);
            __builtin_amdgcn_fence(__ATOMIC_ACQUIRE, "agent");
            asm volatile("s_waitcnt vmcnt(0)" ::: "memory");
        }
    }
    __syncthreads();
}

__global__ void __launch_bounds__(512, 2) mega(Params p) {
    extern __shared__ __attribute__((aligned(16))) unsigned char shm[];
    cg::grid_group grid = cg::this_grid();
    volatile LAS unsigned* bst = (volatile LAS unsigned*)((LAS unsigned char*)shm + LDS_BAR_ST);
    if (threadIdx.x < 4) bst[threadIdx.x] = 0u;
    __syncthreads();
    XcdBarrier xbar; xbar.bar = (unsigned*)(p.ws + WS_BAR); xbar.x = 0; xbar.st = bst;
    if (p.ph_hi - p.ph_lo > 1) xbar = xcd_barrier_post((unsigned*)(p.ws + WS_BAR), bst);
    if (p.ph_lo > 64) grid.sync();
#ifndef PHMASK
#define PHMASK 0xff
#endif
#define PH(i) (((PHMASK >> (i)) & 1) && p.ph_lo <= (i) && (i) < p.ph_hi)
#define SEAM(i) do { if (p.ph_lo <= (i) && (i) + 1 < p.ph_hi) xcd_barrier(xbar); } while (0)
    if (PH(0)) phase_prep(p, shm);
    SEAM(0);
    if (PH(1)) {
        pg8::Gemm g; g.A0 = (const bf16_t*)((unsigned char*)p.out + DO_XN); g.A1 = g.A0; g.B0 = (const bf16_t*)((unsigned char*)p.out + DO_WINT); g.B1 = g.B0;
        g.lda = DM; g.ldb = DM; g.M = S; g.N = NIN; g.K = DM; g.ksplit = DM / 64;
        pg8::StaticOrder so; so.init(g.M, g.N, (int)gridDim.x, (int)blockIdx.x);
        EpiZ e; e.ws = p.ws;
        if (gridDim.x >= 16 && (gridDim.x & 15) == 0) { if ((blockIdx.x >> 3) & 1) prep_small_weights(p, shm, (int)((blockIdx.x >> 4) * 8 + (blockIdx.x & 7)), (int)(gridDim.x / 2)); }
        else prep_small_weights(p, shm, (int)blockIdx.x, (int)gridDim.x);
        pg8::gemm_phase<EpiZ>((LAS unsigned char*)shm, g, so, e);
    }
    SEAM(1);
#if PROBE_SPLIT
    if (PH(2)) phase_lru(p, shm);
    if (p.ph_lo == 8) phase_att(p, shm);
#else
    if (PH(2)) phase_mixers(p, shm);
#endif
    SEAM(2);
    if (PH(3)) phase_carry(p);
    SEAM(3);
    if (PH(4)) phase_fixup(p);
    SEAM(4);
    if (PH(5)) {
        pg8::Gemm g; g.A0 = (const bf16_t*)(p.ws + WS_ZG); g.A1 = (const bf16_t*)(p.ws + WS_YB) - 2048; g.B0 = (const bf16_t*)(p.ws + WS_WAT); g.B1 = (const bf16_t*)(p.ws + WS_WBT) - 2048;
        g.lda = DM; g.ldb = DM; g.M = S; g.N = DM; g.K = 2 * DM; g.ksplit = DM / 64;
        pg8::StaticOrder so; so.init(g.M, g.N, (int)gridDim.x, (int)blockIdx.x);
        EpiMergeMid e; e.ws = p.ws;
        pg8::gemm_phase<EpiMergeMid>((LAS unsigned char*)shm, g, so, e);
    }
    SEAM(5);
    if (PH(6)) {
        pg8::Gemm g; g.A0 = (const bf16_t*)(p.ws + WS_MRG); g.A1 = g.A0; g.B0 = (const bf16_t*)(p.ws + WS_WOT); g.B1 = g.B0;
        g.lda = DM; g.ldb = DM; g.M = S; g.N = DM; g.K = DM; g.ksplit = DM / 64;
        pg8::StaticOrder so; so.init(g.M, g.N, (int)gridDim.x, (int)blockIdx.x);
        EpiOut e; e.ws = p.ws;
        pg8::gemm_phase<EpiOut>((LAS unsigned char*)shm, g, so, e);
    }
    SEAM(6);
    if (PH(7)) phase_final(p);
}

extern "C" void kernel_launch(void* const* d_in, const int* in_sizes, int n_in, void* d_out, int out_size, void* d_ws, size_t ws_size, hipStream_t stream) {
    static int grid = 0;
    if (grid == 0) {
        if (n_in != 15 || in_sizes[0] != S * DM || out_size != S * DM || ws_size < WS_END) {
            fprintf(stderr, "kernel_launch: unexpected shapes (n_in %d, in0 %d, out %d, ws %zu; need ws >= %zu)\n", n_in, n_in > 0 ? in_sizes[0] : -1, out_size, ws_size, (size_t)WS_END); grid = -1; return; }
        int dev = 0, cus = 0, per_cu = 0;
        (void)hipGetDevice(&dev); (void)hipDeviceGetAttribute(&cus, hipDeviceAttributeMultiprocessorCount, dev);
        if (hipFuncSetAttribute((const void*)mega, hipFuncAttributeMaxDynamicSharedMemorySize, LDS_BYTES) != hipSuccess) { fprintf(stderr, "kernel_launch: hipFuncSetAttribute failed\n"); grid = -1; return; }
        if (hipOccupancyMaxActiveBlocksPerMultiprocessor(&per_cu, (const void*)mega, 512, LDS_BYTES) != hipSuccess || per_cu < 1) { fprintf(stderr, "kernel_launch: occupancy query gave %d\n", per_cu); per_cu = 1; }
        (void)hipGetLastError();
        grid = cus * per_cu;
    }
    if (grid < 0) return;
    Params p{};
    for (int i = 0; i < 15; ++i) p.in[i] = (const float*)d_in[i];
    p.out = (float*)d_out; p.ws = (unsigned char*)d_ws;
    for (int j = 0; j < 16; ++j) p.inv_freq[j] = (float)pow(500000.0, -(double)j / 16.0);
    p.mix_mask = 3;
#if MK_SINGLE
    p.ph_lo = 0; p.ph_hi = 8;
    if (hipMemsetAsync((unsigned char*)d_ws + WS_BAR, 0, XCD_BAR_WORDS * sizeof(unsigned), stream) != hipSuccess) { fprintf(stderr, "kernel_launch: memset of barrier words failed\n"); return; }
    void* args[] = {&p};
    hipError_t e = hipLaunchCooperativeKernel((const void*)mega, dim3(grid), dim3(512), args, LDS_BYTES, stream);
    if (e != hipSuccess) fprintf(stderr, "kernel_launch: cooperative launch failed: %s (grid %d)\n", hipGetErrorString(e), grid);
#else
#ifndef REPMASK
#define REPMASK 0
#endif
#ifndef HALFMASK
#define HALFMASK 0
#endif
    static const int lph[9] = {0, 1, 2, 2, 3, 4, 5, 6, 7}; static const int lmix[9] = {3, 3, 1, 2, 3, 3, 3, 3, 3};
    for (int li = 0; li < 9; ++li) {
        p.ph_lo = lph[li]; p.ph_hi = lph[li] + 1; p.mix_mask = lmix[li];
#ifndef REPMASK
#define REPMASK 0
#endif
        for (int rep = 0; rep < (((REPMASK >> li) & 1) ? 2 : 1); ++rep)
        hipLaunchKernelGGL(mega, dim3(((HALFMASK >> li) & 1) ? grid / 2 : grid), dim3(512), LDS_BYTES, stream, p);
    }
#endif
}
```

```cpp
#include <hip/hip_runtime.h>
#include <hip/hip_cooperative_groups.h>
#include <cstdio>
#include <cstdint>
#include <cmath>
namespace cg = cooperative_groups;

#ifndef MK_SINGLE
#define MK_SINGLE 1
#endif

#define LAS __attribute__((address_space(3)))
#define DI __device__ __forceinline__
typedef unsigned short bf16_t;
typedef short bf16x8 __attribute__((ext_vector_type(8)));
typedef short s16x4 __attribute__((ext_vector_type(4)));
typedef float f32x2 __attribute__((ext_vector_type(2)));
typedef float f32x4 __attribute__((ext_vector_type(4)));
typedef float f32x16 __attribute__((ext_vector_type(16)));
typedef unsigned u32x2 __attribute__((ext_vector_type(2)));
typedef unsigned u32x4 __attribute__((ext_vector_type(4)));

constexpr int S = 16384, DM = 2048, NIN = 13312;
constexpr float EPS = 1e-6f;
constexpr float LOG2E = 1.4426950408889634f;
constexpr size_t MiB = (size_t)1 << 20;
constexpr size_t WS_ZU = 0, WS_MERGED = 0;
constexpr size_t WS_ZG = 64 * MiB;
constexpr size_t WS_ZQKV = 128 * MiB;
constexpr size_t WS_ZGA = 224 * MiB;
constexpr size_t WS_ZM = 288 * MiB, WS_OUT2 = 288 * MiB;
constexpr size_t WS_WAT = 416 * MiB, WS_WBT = 424 * MiB, WS_WOT = 432 * MiB;
constexpr size_t WS_ROPE = 440 * MiB;
constexpr size_t WS_AGG = 442 * MiB;
constexpr size_t WS_SSQ = 446 * MiB;
constexpr size_t WS_LWT = 448 * MiB;
constexpr size_t WS_CAR = 450 * MiB;
constexpr size_t WS_BAR = 452 * MiB;
constexpr size_t WS_END = 453 * MiB;
constexpr size_t DO_XN = 0, DO_WINT = 64 * MiB;
constexpr size_t DO_ACF = 0, DO_ACB = 64 * MiB;
#ifndef PROBE_SPLIT
#define PROBE_SPLIT 0
#endif
constexpr size_t WS_YB = PROBE_SPLIT ? WS_ZU : WS_ZGA;
constexpr size_t WS_MRG = PROBE_SPLIT ? WS_ZQKV : WS_MERGED;
constexpr int LDS_BAR_ST = 137216;
constexpr int LDS_BYTES = 137232;

struct Params {
    const float* in[15];
    float* out; unsigned char* ws;
    float inv_freq[16];
    int ph_lo, ph_hi, mix_mask, pad_;
};

DI unsigned cvtpk(float lo, float hi) { unsigned r; asm volatile("v_cvt_pk_bf16_f32 %0, %1, %2" : "=v"(r) : "v"(lo), "v"(hi)); return r; }
DI float bf2f(unsigned short b) { return __uint_as_float(((unsigned)b) << 16); }
DI float bflo(unsigned w) { return __uint_as_float(w << 16); }
DI float bfhi(unsigned w) { return __uint_as_float(w & 0xffff0000u); }
DI unsigned short f2bf(float f) { return (unsigned short)(cvtpk(f, f) & 0xffffu); }
DI float ex2(float x) { return __builtin_amdgcn_exp2f(x); }
DI float rcpf_(float x) { return __builtin_amdgcn_rcpf(x); }
DI float sigm(float x) { return rcpf_(1.f + ex2(-x * LOG2E)); }
DI float wave_sum(float v) {
#pragma unroll
    for (int o = 32; o >= 1; o >>= 1) v += __shfl_xor(v, o);
    return v;
}

namespace pg8 {
constexpr int BM = 256, BK = 64, HALF = 128, HTB = HALF * BK * 2, STAGE_BYTES = 8 * HTB, NXCD = 8, WGM = 8;
DI int lds_byte(int r, int c) { const int st = (r >> 4) * 2 + (c >> 5), rr = r & 15, cc = c & 31, ob = rr * 64 + cc * 2; return st * 1024 + (ob ^ (((ob >> 9) & 1) << 5)); }
DI void stage_rc(int b, int& R, int& C) { const int st = b / 1024, sb = b % 1024, swz = sb ^ (((sb >> 9) & 1) << 5); R = (st >> 1) * 16 + swz / 64; C = (st & 1) * 32 + (swz % 64) / 2; }
DI int perm32(int rho) { const int n = rho >> 4, i = rho & 15; return 8 * (i >> 2) + 4 * n + (i & 3); }
struct Unit { int pm, pn; };
struct Gemm { const bf16_t* A0; const bf16_t* A1; const bf16_t* B0; const bf16_t* B1; int lda, ldb, M, N, K, ksplit; };
struct StaticOrder {
    int nM, nN, nwg, G, c;
    DI void init(int M, int N, int G_, int c_) { nM = M / BM; nN = N / BM; nwg = nM * nN; G = G_; c = c_; }
    DI bool next(int i, Unit& u) const {
        const long L = (long)i * G + c; if (L >= nwg) return false;
        int wgid = (int)L; { const int q = nwg / NXCD, r = nwg % NXCD, xcd = wgid % NXCD, off = wgid / NXCD; wgid = (xcd < r ? xcd * (q + 1) : r * (q + 1) + (xcd - r) * q) + off; }
        const int nig = WGM * nN, gid = wgid / nig, fm = gid * WGM, gsz = (nM - fm) < WGM ? (nM - fm) : WGM;
        u.pm = fm + ((wgid % nig) % gsz); u.pn = (wgid % nig) / gsz; return true;
    }
};

template <class Epi>
DI void gemm_phase(LAS unsigned char* lds, const Gemm g, const StaticOrder& S_, const Epi& E) {
    const int tid = threadIdx.x, wid = __builtin_amdgcn_readfirstlane(tid >> 6), lane = tid & 63, wr = wid >> 2, wc = wid & 3, fr = lane & 15, fq = lane >> 4;
    const int K = g.K, nt = K / BK, ksplit = g.ksplit;
    unsigned voffA[2], voffB[2];
#pragma unroll
    for (int i = 0; i < 2; ++i) { int R, C; stage_rc(tid * 16 + i * 8192, R, C); const int Rb = Epi::PERM ? ((R & ~31) + perm32(R & 31)) : R;
        voffA[i] = (unsigned)(R * g.lda + C) * 2u; voffB[i] = (unsigned)(Rb * g.ldb + C) * 2u; }
    const size_t kstep = (size_t)(BK * 2);
    const size_t hstepA = (size_t)HALF * g.lda * 2, hstepB = (size_t)HALF * g.ldb * 2;
    const size_t tstepA = 2 * hstepA, tstepB = 2 * hstepB;
    const unsigned ldsw = (unsigned)wid * 1024u;
    const int aoff = lds_byte(wr * 64 + fr, fq * 8), boff = lds_byte(wc * 32 + fr, fq * 8);
#define PG8_SA(b, h) (((b) * 2 + (h)) * HTB)
#define PG8_SB(b, h) ((4 + (b) * 2 + (h)) * HTB)
#define PG8_STAGE(bufoff, gbase, voff) do { _Pragma("unroll") for (int _i = 0; _i < 2; ++_i) \
        __builtin_amdgcn_global_load_lds((const unsigned*)((const char*)(gbase) + (voff)[_i]), (LAS unsigned*)(lds + (bufoff) + ldsw + _i * 8192), 16, 0, 0); } while (0)
#define PG8_LDA(dst, b, h) do { _Pragma("unroll") for (int m = 0; m < 4; ++m) _Pragma("unroll") for (int k = 0; k < 2; ++k) dst[m][k] = *(const LAS bf16x8*)(lds + PG8_SA(b, h) + aoff + m * 2048 + k * 1024); } while (0)
#define PG8_LDB(dst, b, h) do { _Pragma("unroll") for (int n = 0; n < 2; ++n) _Pragma("unroll") for (int k = 0; k < 2; ++k) dst[n][k] = *(const LAS bf16x8*)(lds + PG8_SB(b, h) + boff + n * 2048 + k * 1024); } while (0)
#define PG8_MMA(ai, bj, At, Bt) do { __builtin_amdgcn_s_setprio(1); _Pragma("unroll") for (int m = 0; m < 4; ++m) _Pragma("unroll") for (int n = 0; n < 2; ++n) _Pragma("unroll") for (int k = 0; k < 2; ++k) \
        acc[ai][bj][m][n] = __builtin_amdgcn_mfma_f32_16x16x32_bf16(Bt[n][k], At[m][k], acc[ai][bj][m][n], 0, 0, 0); __builtin_amdgcn_s_setprio(0); } while (0)
#define PG8_WAIT_V(n) asm volatile("s_waitcnt vmcnt(" #n ")" ::: "memory")
#define PG8_WAIT_L(n) asm volatile("s_waitcnt lgkmcnt(" #n ")" ::: "memory")
#define PG8_BAR __builtin_amdgcn_s_barrier()
#define PG8_SCHED __builtin_amdgcn_sched_barrier(0)
    Unit cur, nxt; int ui = 0;
    if (!S_.next(0, cur)) return;
    f32x4 acc[2][2][4][2];
#pragma unroll
    for (int a = 0; a < 2; ++a)
#pragma unroll
        for (int b = 0; b < 2; ++b)
#pragma unroll
            for (int m = 0; m < 4; ++m)
#pragma unroll
                for (int n = 0; n < 2; ++n) acc[a][b][m][n] = (f32x4){0.f, 0.f, 0.f, 0.f};
    bf16x8 At[4][2], B0[2][2], B1[2][2];
    const char* cA0 = (const char*)g.A0 + (size_t)cur.pm * tstepA; const char* cA1 = (const char*)g.A1 + (size_t)cur.pm * tstepA;
    const char* cB0 = (const char*)g.B0 + (size_t)cur.pn * tstepB; const char* cB1 = (const char*)g.B1 + (size_t)cur.pn * tstepB;
    PG8_STAGE(PG8_SB(0, 0), cB0, voffB); PG8_STAGE(PG8_SA(0, 0), cA0, voffA); PG8_STAGE(PG8_SB(0, 1), cB0 + hstepB, voffB); PG8_STAGE(PG8_SA(0, 1), cA0 + hstepA, voffA);
    if (wr == 1) PG8_BAR;
    PG8_WAIT_V(4); PG8_BAR;
    PG8_STAGE(PG8_SB(1, 0), cB0 + kstep, voffB); PG8_STAGE(PG8_SA(1, 0), cA0 + kstep, voffA); PG8_STAGE(PG8_SB(1, 1), cB0 + hstepB + kstep, voffB);
    PG8_WAIT_V(6); PG8_BAR;
    for (;;) {
        const bool has_next = S_.next(ui + 1, nxt);
        const char* nA0 = has_next ? (const char*)g.A0 + (size_t)nxt.pm * tstepA : cA0; const char* nB0 = has_next ? (const char*)g.B0 + (size_t)nxt.pn * tstepB : cB0;
        for (int hf = 0; hf < (Epi::MID ? 2 : 1); ++hf) {
        const int tb = Epi::MID ? hf * ksplit : 0, te = Epi::MID ? (hf + 1) * ksplit : nt;
        for (int t = tb; t < te; t += 2) {
            const bool last = (t == nt - 2);
            const bool hA = (t >= ksplit), hB = (t + 2 >= ksplit);
            const char* a1 = (hA ? cA1 : cA0) + (size_t)(t + 1) * kstep;
            const char* a2 = last ? nA0 : (hB ? cA1 : cA0) + (size_t)(t + 2) * kstep; const char* b2 = last ? nB0 : (hB ? cB1 : cB0) + (size_t)(t + 2) * kstep;
            const char* a3 = a2 + kstep; const char* b3 = b2 + kstep;
            PG8_LDB(B0, 0, 0); PG8_SCHED; PG8_LDA(At, 0, 0); PG8_STAGE(PG8_SA(1, 1), a1 + hstepA, voffA);
            PG8_WAIT_L(8); PG8_BAR; PG8_WAIT_L(0); PG8_MMA(0, 0, At, B0); PG8_BAR; PG8_SCHED;
            PG8_LDB(B1, 0, 1); PG8_STAGE(PG8_SB(0, 0), b2, voffB);
            PG8_BAR; PG8_WAIT_L(0); PG8_MMA(0, 1, At, B1); PG8_BAR;
            PG8_LDA(At, 0, 1); PG8_STAGE(PG8_SA(0, 0), a2, voffA);
            PG8_BAR; PG8_WAIT_L(0); PG8_MMA(1, 0, At, B0); PG8_BAR; PG8_SCHED;
            PG8_STAGE(PG8_SB(0, 1), b2 + hstepB, voffB);
            PG8_WAIT_V(6); PG8_BAR; PG8_MMA(1, 1, At, B1); PG8_BAR;
            PG8_LDB(B0, 1, 0); PG8_SCHED; PG8_LDA(At, 1, 0); PG8_STAGE(PG8_SA(0, 1), a2 + hstepA, voffA);
            PG8_WAIT_L(8); PG8_BAR; PG8_WAIT_L(0); PG8_MMA(0, 0, At, B0); PG8_BAR; PG8_SCHED;
            PG8_LDB(B1, 1, 1); PG8_STAGE(PG8_SB(1, 0), b3, voffB);
            PG8_BAR; PG8_WAIT_L(0); PG8_MMA(0, 1, At, B1); PG8_BAR;
            PG8_LDA(At, 1, 1); PG8_STAGE(PG8_SA(1, 0), a3, voffA);
            PG8_BAR; PG8_WAIT_L(0); PG8_MMA(1, 0, At, B0); PG8_BAR; PG8_SCHED;
            PG8_STAGE(PG8_SB(1, 1), b3 + hstepB, voffB);
            PG8_WAIT_V(6); PG8_BAR; PG8_MMA(1, 1, At, B1); PG8_BAR;
        }
        if constexpr (Epi::MID) { if (hf == 0) E.mid(acc, cur, wr, wc, fr, fq); }
        }
        E(acc, cur, wr, wc, fr, fq);
        if (!has_next) break;
#pragma unroll
        for (int a = 0; a < 2; ++a)
#pragma unroll
            for (int b = 0; b < 2; ++b)
#pragma unroll
                for (int m = 0; m < 4; ++m)
#pragma unroll
                    for (int n = 0; n < 2; ++n) acc[a][b][m][n] = (f32x4){0.f, 0.f, 0.f, 0.f};
        cur = nxt; ++ui;
        cA0 = (const char*)g.A0 + (size_t)cur.pm * tstepA; cA1 = (const char*)g.A1 + (size_t)cur.pm * tstepA;
        cB0 = (const char*)g.B0 + (size_t)cur.pn * tstepB; cB1 = (const char*)g.B1 + (size_t)cur.pn * tstepB;
    }
    PG8_WAIT_V(0);
    if (wr == 0) PG8_BAR;
    PG8_BAR;
#undef PG8_SA
#undef PG8_SB
#undef PG8_STAGE
#undef PG8_LDA
#undef PG8_LDB
#undef PG8_MMA
#undef PG8_WAIT_V
#undef PG8_WAIT_L
#undef PG8_BAR
#undef PG8_SCHED
}
}

struct EpiZ {
    static constexpr bool PERM = true, MID = false;
    unsigned char* ws;
    DI void operator()(const f32x4 (&acc)[2][2][4][2], const pg8::Unit& u, int wr, int wc, int fr, int fq) const {
        const int pn = u.pn; bf16_t* base; int ld, colt;
        if (pn < 8) { base = (bf16_t*)(ws + WS_ZU) + (size_t)pn * S * 256; ld = 256; colt = 0; }
        else if (pn < 16) { base = (bf16_t*)(ws + WS_ZG); ld = 2048; colt = (pn - 8) * 256; }
        else if (pn < 28) { base = (bf16_t*)(ws + WS_ZQKV); ld = 3072; colt = (pn - 16) * 256; }
        else if (pn < 36) { base = (bf16_t*)(ws + WS_ZGA); ld = 2048; colt = (pn - 28) * 256; }
        else { base = (bf16_t*)(ws + WS_ZM) + (size_t)(pn - 36) * S * 256; ld = 256; colt = 0; }
        const bool rope = (pn >= 16 && pn < 26 && wc == 0);
        const int row0 = u.pm * 256 + wr * 64 + fr, col0 = colt + wc * 32 + 8 * fq;
        if (rope) {
            const float* cosT = (const float*)(ws + WS_ROPE) + (size_t)row0 * 16 + 4 * fq; const float* sinT = cosT + (size_t)S * 16;
            f32x4 cs[8], sn[8];
#pragma unroll
            for (int k = 0; k < 8; ++k) { cs[k] = *(const f32x4*)(cosT + ((k >> 2) * 128 + (k & 3) * 16) * 16); sn[k] = *(const f32x4*)(sinT + ((k >> 2) * 128 + (k & 3) * 16) * 16); }
#pragma unroll
            for (int ai = 0; ai < 2; ++ai)
#pragma unroll
                for (int m = 0; m < 4; ++m) {
                    const int row = row0 + ai * 128 + m * 16; const f32x4 c4 = cs[ai * 4 + m], s4 = sn[ai * 4 + m];
#pragma unroll
                    for (int bj = 0; bj < 2; ++bj) {
                        const f32x4 v0 = acc[ai][bj][m][0], v1 = acc[ai][bj][m][1]; f32x4 w0, w1;
                        w0[0] = v0[0] * c4[0] - v0[1] * s4[0]; w0[1] = v0[1] * c4[0] + v0[0] * s4[0];
                        w0[2] = v0[2] * c4[1] - v0[3] * s4[1]; w0[3] = v0[3] * c4[1] + v0[2] * s4[1];
                        w1[0] = v1[0] * c4[2] - v1[1] * s4[2]; w1[1] = v1[1] * c4[2] + v1[0] * s4[2];
                        w1[2] = v1[2] * c4[3] - v1[3] * s4[3]; w1[3] = v1[3] * c4[3] + v1[2] * s4[3];
                        u32x4 w = {cvtpk(w0[0], w0[1]), cvtpk(w0[2], w0[3]), cvtpk(w1[0], w1[1]), cvtpk(w1[2], w1[3])};
                        __builtin_nontemporal_store(w, (u32x4*)(base + (size_t)row * ld + col0 + bj * 128));
                    }
                }
        } else if (pn >= 36) {
            unsigned char* gb = ws + WS_ZM + (size_t)(pn - 36) * S * 256 + (size_t)row0 * 256 + wc * 32 + 8 * fq;
#pragma unroll
            for (int ai = 0; ai < 2; ++ai)
#pragma unroll
                for (int m = 0; m < 4; ++m)
#pragma unroll
                    for (int bj = 0; bj < 2; ++bj) {
                        const f32x4 v0 = acc[ai][bj][m][0], v1 = acc[ai][bj][m][1]; unsigned q[8];
#pragma unroll
                        for (int i = 0; i < 4; ++i) { q[i] = (unsigned)fmaxf(sigm(v0[i]) * 255.f + 0.5f, 1.f); q[4 + i] = (unsigned)fmaxf(sigm(v1[i]) * 255.f + 0.5f, 1.f); }
                        const u32x2 w = {q[0] | (q[1] << 8) | (q[2] << 16) | (q[3] << 24), q[4] | (q[5] << 8) | (q[6] << 16) | (q[7] << 24)};
                        __builtin_nontemporal_store(w, (u32x2*)(gb + (size_t)(ai * 128 + m * 16) * 256 + bj * 128));
                    }
        } else {
#pragma unroll
            for (int ai = 0; ai < 2; ++ai)
#pragma unroll
                for (int m = 0; m < 4; ++m) {
                    const int row = row0 + ai * 128 + m * 16;
#pragma unroll
                    for (int bj = 0; bj < 2; ++bj) {
                        const f32x4 v0 = acc[ai][bj][m][0], v1 = acc[ai][bj][m][1];
                        u32x4 w = {cvtpk(v0[0], v0[1]), cvtpk(v0[2], v0[3]), cvtpk(v1[0], v1[1]), cvtpk(v1[2], v1[3])};
                        __builtin_nontemporal_store(w, (u32x4*)(base + (size_t)row * ld + col0 + bj * 128));
                    }
                }
        }
    }
};
DI u32x4 ldg128(const void* base, unsigned boff) { return *(const u32x4*)((const char*)base + boff); }
DI void stg128(void* base, unsigned boff, u32x4 v) { *(u32x4*)((char*)base + boff) = v; }
template <int STEP> struct EpiMerge {
    static constexpr bool PERM = true, MID = false;
    unsigned char* ws; unsigned char* tbuf;
    DI void operator()(const f32x4 (&acc)[2][2][4][2], const pg8::Unit& u, int wr, int wc, int fr, int fq) const {
        const unsigned char* zm = ws + WS_ZM; unsigned char* mg = ws + WS_MRG;
        const unsigned r0_ = (unsigned)(u.pm * 256 + wr * 64 + fr), c0_ = (unsigned)(u.pn * 256 + wc * 32 + 8 * fq);
#pragma unroll
        for (int ai = 0; ai < 2; ++ai)
#pragma unroll
            for (int m = 0; m < 4; ++m) {
                const unsigned row = r0_ + ai * 128 + m * 16;
#pragma unroll
                for (int bj = 0; bj < 2; ++bj) {
                    const unsigned col = c0_ + bj * 128;
                    const u32x4 g = ldg128(zm, row * 8192u + (STEP ? 4096u : 0u) + col * 2u);
                    float v[8];
#pragma unroll
                    for (int i = 0; i < 4; ++i) {
                        v[2 * i] = acc[ai][bj][m][i >> 1][(i & 1) * 2] * sigm(bflo(g[i]));
                        v[2 * i + 1] = acc[ai][bj][m][i >> 1][(i & 1) * 2 + 1] * sigm(bfhi(g[i]));
                    }
                    const unsigned tb = row * 8192u + col * 4u;
                    if (STEP == 0) {
                        stg128(tbuf, tb, __builtin_bit_cast(u32x4, (f32x4){v[0], v[1], v[2], v[3]}));
                        stg128(tbuf, tb + 16u, __builtin_bit_cast(u32x4, (f32x4){v[4], v[5], v[6], v[7]}));
                    } else {
                        const f32x4 t0 = __builtin_bit_cast(f32x4, ldg128(tbuf, tb)), t1 = __builtin_bit_cast(f32x4, ldg128(tbuf, tb + 16u));
                        u32x4 w = {cvtpk(v[0] + t0[0], v[1] + t0[1]), cvtpk(v[2] + t0[2], v[3] + t0[3]), cvtpk(v[4] + t1[0], v[5] + t1[1]), cvtpk(v[6] + t1[2], v[7] + t1[3])};
                        stg128(mg, row * 4096u + col * 2u, w);
                    }
                }
                asm volatile("" ::: "memory");
            }
    }
};

DI float ub(unsigned w, int i) { return (float)((w >> (8 * i)) & 0xffu); }
struct EpiMergeMid {
    static constexpr bool PERM = true, MID = true;
    unsigned char* ws;
    DI void mid(f32x4 (&acc)[2][2][4][2], const pg8::Unit& u, int wr, int wc, int fr, int fq) const {
        const unsigned char* zm = ws + WS_ZM;
        unsigned b0_ = (unsigned)u.pn * (unsigned)(S * 256) + (unsigned)(u.pm * 256 + wr * 64 + fr) * 256u + (unsigned)(wc * 32 + 8 * fq);
        asm volatile("" : "+v"(b0_));
        u32x2 g1[2][4][2], g2[2][4][2];
#pragma unroll
        for (int ai = 0; ai < 2; ++ai)
#pragma unroll
            for (int m = 0; m < 4; ++m)
#pragma unroll
                for (int bj = 0; bj < 2; ++bj) { const unsigned bo = b0_ + (unsigned)(ai * 128 + m * 16) * 256u + bj * 128u;
                    g1[ai][m][bj] = *(const u32x2*)(zm + bo); g2[ai][m][bj] = *(const u32x2*)(zm + bo + (unsigned)(8 * S * 256)); }
#pragma unroll
        for (int ai = 0; ai < 2; ++ai)
#pragma unroll
            for (int m = 0; m < 4; ++m)
#pragma unroll
                for (int bj = 0; bj < 2; ++bj)
#pragma unroll
                    for (int e = 0; e < 8; ++e)
                        acc[ai][bj][m][e >> 2][e & 3] *= ub(g1[ai][m][bj][e >> 2], e & 3) * rcpf_(ub(g2[ai][m][bj][e >> 2], e & 3));
    }
    DI void operator()(const f32x4 (&acc)[2][2][4][2], const pg8::Unit& u, int wr, int wc, int fr, int fq) const {
        const unsigned char* zm = ws + WS_ZM; unsigned char* mg = ws + WS_MRG;
        unsigned r0_ = (unsigned)(u.pm * 256 + wr * 64 + fr), c0_ = (unsigned)(wc * 32 + 8 * fq);
        asm volatile("" : "+v"(r0_), "+v"(c0_));
        u32x2 g2[2][4][2];
#pragma unroll
        for (int ai = 0; ai < 2; ++ai)
#pragma unroll
            for (int m = 0; m < 4; ++m)
#pragma unroll
                for (int bj = 0; bj < 2; ++bj) g2[ai][m][bj] = *(const u32x2*)(zm + (unsigned)(8 + u.pn) * (unsigned)(S * 256) + (r0_ + ai * 128 + m * 16) * 256u + c0_ + bj * 128u);
#pragma unroll
        for (int ai = 0; ai < 2; ++ai)
#pragma unroll
            for (int m = 0; m < 4; ++m) {
                const unsigned row = r0_ + ai * 128 + m * 16;
#pragma unroll
                for (int bj = 0; bj < 2; ++bj) {
                    float v[8];
#pragma unroll
                    for (int e = 0; e < 8; ++e) v[e] = acc[ai][bj][m][e >> 2][e & 3] * (ub(g2[ai][m][bj][e >> 2], e & 3) * (1.f / 255.f));
                    u32x4 w = {cvtpk(v[0], v[1]), cvtpk(v[2], v[3]), cvtpk(v[4], v[5]), cvtpk(v[6], v[7])};
                    stg128(mg, row * 4096u + ((unsigned)u.pn * 256u + c0_) * 2u + bj * 256u, w);
                }
            }
    }
};
struct EpiOut {
    static constexpr bool PERM = true, MID = false;
    unsigned char* ws;
    DI void operator()(const f32x4 (&acc)[2][2][4][2], const pg8::Unit& u, int wr, int wc, int fr, int fq) const {
        unsigned char* o2 = ws + WS_OUT2; float* ssq = (float*)(ws + WS_SSQ);
        const unsigned r0_ = (unsigned)(u.pm * 256 + wr * 64 + fr), c0_ = (unsigned)(u.pn * 256 + wc * 32 + 8 * fq) * 2u;
#pragma unroll
        for (int ai = 0; ai < 2; ++ai)
#pragma unroll
            for (int m = 0; m < 4; ++m) {
                const unsigned row = r0_ + ai * 128 + m * 16; float s = 0.f;
#pragma unroll
                for (int bj = 0; bj < 2; ++bj) {
                    const f32x4 v0 = acc[ai][bj][m][0], v1 = acc[ai][bj][m][1];
                    s += v0[0] * v0[0] + v0[1] * v0[1] + v0[2] * v0[2] + v0[3] * v0[3] + v1[0] * v1[0] + v1[1] * v1[1] + v1[2] * v1[2] + v1[3] * v1[3];
                    u32x4 w = {cvtpk(v0[0], v0[1]), cvtpk(v0[2], v0[3]), cvtpk(v1[0], v1[1]), cvtpk(v1[2], v1[3])};
                    stg128(o2, row * 4096u + c0_ + bj * 256u, w);
                }
                s += __shfl_xor(s, 16); s += __shfl_xor(s, 32);
                if (fq == 0) ssq[(size_t)row * 32 + u.pn * 4 + wc] = s;
            }
    }
};

struct TJob { const float* src; bf16_t* dst; int ld_src, ld_dst, k0, n0, perm, pad_; };
DI void tr_load(const TJob& j, f32x4& v0, f32x4& v1) {
    const int t = threadIdx.x, kl = t >> 4, nl = (t & 15) * 4;
    v0 = *(const f32x4*)(j.src + (size_t)(j.k0 + kl) * j.ld_src + j.n0 + nl);
    v1 = *(const f32x4*)(j.src + (size_t)(j.k0 + kl + 32) * j.ld_src + j.n0 + nl);
}
DI void tr_store(const TJob& j, const f32x4 v0, const f32x4 v1, float* sT) {
    const int t = threadIdx.x;
    { const int kl = t >> 4, nl = (t & 15) * 4;
      sT[kl * 65 + nl] = v0[0]; sT[kl * 65 + nl + 1] = v0[1]; sT[kl * 65 + nl + 2] = v0[2]; sT[kl * 65 + nl + 3] = v0[3];
      sT[(kl + 32) * 65 + nl] = v1[0]; sT[(kl + 32) * 65 + nl + 1] = v1[1]; sT[(kl + 32) * 65 + nl + 2] = v1[2]; sT[(kl + 32) * 65 + nl + 3] = v1[3]; }
    __syncthreads();
    { const int nl = t >> 3, kc = (t & 7) * 8; int ns = nl;
      if (j.perm && nl < 32) ns = (nl & 1) ? 16 + (nl >> 1) : (nl >> 1);
      float q[8];
#pragma unroll
      for (int i = 0; i < 8; ++i) q[i] = sT[(kc + i) * 65 + ns];
      u32x4 w = {cvtpk(q[0], q[1]), cvtpk(q[2], q[3]), cvtpk(q[4], q[5]), cvtpk(q[6], q[7])};
      *(u32x4*)(j.dst + (size_t)(j.n0 + nl) * j.ld_dst + j.k0 + kc) = w; }
    __syncthreads();
}
DI TJob win_job(const Params& p, int j) {
    TJob r; const int nt = j >> 5, kt = j & 31, n0 = nt * 64;
    r.src = p.in[2]; r.dst = (bf16_t*)((unsigned char*)p.out + DO_WINT); r.ld_src = NIN; r.ld_dst = DM; r.k0 = kt * 64; r.n0 = n0;
    r.perm = (n0 >= 4096 && n0 < 6656 && (n0 & 127) == 0) ? 1 : 0; r.pad_ = 0; return r;
}
DI TJob small_job(const Params& p, int j) {
    TJob r; constexpr int J_SQ = 32 * 32;
    if (j < 3 * J_SQ) { const int which = j >> 10, q = j & 1023, nt = q >> 5, kt = q & 31;
        r.src = p.in[11 + which]; r.dst = (bf16_t*)(p.ws + (which == 0 ? WS_WAT : which == 1 ? WS_WBT : WS_WOT)); r.ld_src = DM; r.ld_dst = DM; r.k0 = kt * 64; r.n0 = nt * 64; }
    else { const int jj = j - 3 * J_SQ, gate = jj >> 7, q = jj & 127, blk = q >> 2, sub = q & 3, d = blk >> 4, nb = blk & 15;
        r.src = p.in[gate == 0 ? 5 : 7] + (size_t)blk * 16384; r.dst = (bf16_t*)(p.ws + WS_LWT) + (size_t)((d * 2 + gate) * 16 + nb) * 16384;
        r.ld_src = 128; r.ld_dst = 128; r.k0 = (sub >> 1) * 64; r.n0 = (sub & 1) * 64; }
    r.perm = 0; r.pad_ = 0; return r;
}
DI void phase_prep(const Params& p, unsigned char* shm) {
    const int tid = threadIdx.x, wid = tid >> 6, lane = tid & 63;
    bf16_t* xn = (bf16_t*)((unsigned char*)p.out + DO_XN);
    {
        const float* x = p.in[0]; const float* nw = p.in[1];
        f32x4 w[8];
#pragma unroll
        for (int i = 0; i < 8; ++i) w[i] = *(const f32x4*)(nw + i * 256 + lane * 4);
        for (int row = (blockIdx.x * 8 + wid) * 2; row < S; row += gridDim.x * 16) {
            f32x4 v[2][8];
#pragma unroll
            for (int r = 0; r < 2; ++r)
#pragma unroll
                for (int i = 0; i < 8; ++i) v[r][i] = __builtin_nontemporal_load((const f32x4*)(x + (size_t)(row + r) * DM + i * 256 + lane * 4));
#pragma unroll
            for (int r = 0; r < 2; ++r) {
                float ss = 0.f;
#pragma unroll
                for (int i = 0; i < 8; ++i) ss += v[r][i][0] * v[r][i][0] + v[r][i][1] * v[r][i][1] + v[r][i][2] * v[r][i][2] + v[r][i][3] * v[r][i][3];
                ss = wave_sum(ss);
                const float rs = rsqrtf(ss * (1.f / DM) + EPS);
#pragma unroll
                for (int i = 0; i < 8; ++i) {
                    u32x2 o = {cvtpk(v[r][i][0] * rs * w[i][0], v[r][i][1] * rs * w[i][1]), cvtpk(v[r][i][2] * rs * w[i][2], v[r][i][3] * rs * w[i][3])};
                    *(u32x2*)(xn + (size_t)(row + r) * DM + i * 256 + lane * 4) = o; }
            }
        }
    }
    {
        float* cosT = (float*)(p.ws + WS_ROPE); float* sinT = cosT + (size_t)S * 16;
        for (int i = blockIdx.x * 512 + tid; i < S * 16; i += gridDim.x * 512) {
            const int pos = i >> 4, j = i & 15;
            const float ang = (float)pos * p.inv_freq[j];
            const double rev = (double)ang * 0.15915494309189535; const float fr = (float)(rev - rint(rev));
            cosT[i] = __builtin_amdgcn_cosf(fr); sinT[i] = __builtin_amdgcn_sinf(fr);
        }
    }
    {
        float* sT = (float*)shm; constexpr int NG = 208 * 8;
        const float* src = p.in[2]; bf16_t* dst = (bf16_t*)((unsigned char*)p.out + DO_WINT);
        const int t = threadIdx.x, kl = t >> 4, nl4 = (t & 15) * 4, onl = t >> 3, okc = (t & 7) * 8;
        int g = blockIdx.x;
        if (g < NG) {
            f32x4 v[8];
#pragma unroll
            for (int q = 0; q < 8; ++q) v[q] = __builtin_nontemporal_load((const f32x4*)(src + (size_t)((g & 7) * 256 + q * 32 + kl) * NIN + (g >> 3) * 64 + nl4));
            for (;;) {
                const int gn = g + (int)gridDim.x; const bool more = gn < NG; const int gl = more ? gn : g;
                f32x4 vn[8];
#pragma unroll
                for (int q = 0; q < 8; ++q) vn[q] = __builtin_nontemporal_load((const f32x4*)(src + (size_t)((gl & 7) * 256 + q * 32 + kl) * NIN + (gl >> 3) * 64 + nl4));
#pragma unroll
                for (int q = 0; q < 8; ++q) { float* d = sT + (q * 32 + kl) * 65 + nl4; d[0] = v[q][0]; d[1] = v[q][1]; d[2] = v[q][2]; d[3] = v[q][3]; }
                __syncthreads();
                { const int n0 = (g >> 3) * 64, k0 = (g & 7) * 256; int ns = onl;
                  if (n0 >= 4096 && n0 < 6656 && (n0 & 127) == 0 && onl < 32) ns = (onl & 1) ? 16 + (onl >> 1) : (onl >> 1);
#pragma unroll
                  for (int q = 0; q < 4; ++q) { float f[8];
#pragma unroll
                      for (int i = 0; i < 8; ++i) f[i] = sT[(q * 64 + okc + i) * 65 + ns];
                      *(u32x4*)(dst + (size_t)(n0 + onl) * DM + k0 + q * 64 + okc) = (u32x4){cvtpk(f[0], f[1]), cvtpk(f[2], f[3]), cvtpk(f[4], f[5]), cvtpk(f[6], f[7])}; } }
                __syncthreads();
                if (!more) break;
#pragma unroll
                for (int q = 0; q < 8; ++q) v[q] = vn[q];
                g = gn;
            }
        }
    }
}
DI void prep_small_weights(const Params& p, unsigned char* shm, int idx, int stride) {
    float* sT = (float*)shm; constexpr int NJ = 3 * 1024 + 256;
    int j = idx;
    if (j < NJ) {
        TJob cur = small_job(p, j); f32x4 v0, v1; tr_load(cur, v0, v1);
        for (;;) {
            const int jn = j + stride; const bool more = jn < NJ;
            const TJob nxt = small_job(p, more ? jn : j); f32x4 n0, n1; tr_load(nxt, n0, n1);
            tr_store(cur, v0, v1, sT);
            if (!more) break;
            cur = nxt; v0 = n0; v1 = n1; j = jn;
        }
    }
}

DI void lru_copy_out(const bf16_t* OS, bf16_t* dst_tile, int t) {
    const int row = t >> 2, seg = (t & 3) * 32;
#pragma unroll
    for (int k = 0; k < 4; ++k) { const u32x4 v = *(const u32x4*)(OS + row * 136 + seg + k * 8); *(u32x4*)(dst_tile + (size_t)row * 2048 + seg + k * 8) = v; }
}
DI void lru_tile(const Params& p, unsigned char* shm, int c, int nb) {
    int tid = threadIdx.x; asm volatile("" : "+v"(tid));
    const int wid = __builtin_amdgcn_readfirstlane(tid >> 6), lane = tid & 63;
    constexpr int LDU = 136;
    bf16_t* UB = (bf16_t*)shm;
    bf16_t* PS = (bf16_t*)(shm + 34816);
    bf16_t* OS = (bf16_t*)(shm + 2 * 34816);
    f32x2* AG = (f32x2*)(shm + 3 * 34816) + wid * 512;
    const bf16_t* ZU = (const bf16_t*)(p.ws + WS_ZU);
    {
        const int cgp = tid & 15, rg = tid >> 4, ch = nb * 128 + cgp * 8;
        const float* cw = p.in[3]; const float* cb = p.in[4];
        float w[4][8], bias[8];
#pragma unroll
        for (int tp = 0; tp < 4; ++tp) { const f32x4 a = *(const f32x4*)(cw + tp * 2048 + ch), b = *(const f32x4*)(cw + tp * 2048 + ch + 4);
            w[tp][0] = a[0]; w[tp][1] = a[1]; w[tp][2] = a[2]; w[tp][3] = a[3]; w[tp][4] = b[0]; w[tp][5] = b[1]; w[tp][6] = b[2]; w[tp][7] = b[3]; }
        { const f32x4 a = *(const f32x4*)(cb + ch), b = *(const f32x4*)(cb + ch + 4);
            bias[0] = a[0]; bias[1] = a[1]; bias[2] = a[2]; bias[3] = a[3]; bias[4] = b[0]; bias[5] = b[1]; bias[6] = b[2]; bias[7] = b[3]; }
        float xr[7][8];
#pragma unroll
        for (int k = 0; k < 7; ++k) { const int t = c * 128 + rg * 4 - 2 + k;
            u32x4 v = {0u, 0u, 0u, 0u};
            if (t >= 0 && t < S) v = *(const u32x4*)(ZU + (size_t)(nb >> 1) * S * 256 + (size_t)t * 256 + (nb & 1) * 128 + cgp * 8);
#pragma unroll
            for (int i = 0; i < 4; ++i) { xr[k][2 * i] = bflo(v[i]); xr[k][2 * i + 1] = bfhi(v[i]); } }
#pragma unroll
        for (int o = 0; o < 4; ++o) { float u8[8];
#pragma unroll
            for (int i = 0; i < 8; ++i) { float a = bias[i];
#pragma unroll
                for (int tp = 0; tp < 4; ++tp) a += xr[o + tp][i] * w[tp][i];
                u8[i] = a; }
            *(u32x4*)(UB + (rg * 4 + o) * LDU + cgp * 8) = (u32x4){cvtpk(u8[0], u8[1]), cvtpk(u8[2], u8[3]), cvtpk(u8[4], u8[5]), cvtpk(u8[6], u8[7])};
        }
    }
    __syncthreads();
    const int col = lane & 15, q = lane >> 4;
    const int chl = wid * 16 + col, chg = nb * 128 + chl;
    float hsum[8][4]; unsigned ppk[8][2];
    f32x2* AGG = (f32x2*)(p.ws + WS_AGG);
    const bf16_t* LWT = (const bf16_t*)(p.ws + WS_LWT);
#pragma unroll
    for (int d = 0; d < 2; ++d) {
        f32x4 acc[2][8];
#pragma unroll
        for (int a = 0; a < 2; ++a)
#pragma unroll
            for (int b = 0; b < 8; ++b) acc[a][b] = (f32x4){0.f, 0.f, 0.f, 0.f};
        bf16x8 bfr[4][2];
#pragma unroll
        for (int s = 0; s < 4; ++s)
#pragma unroll
            for (int gt = 0; gt < 2; ++gt) bfr[s][gt] = *(const bf16x8*)(LWT + ((size_t)((d * 2 + gt) * 16 + nb) * 128 + chl) * 128 + s * 32 + q * 8);
        const float br = p.in[6][d * 2048 + chg], bi = p.in[8][d * 2048 + chg], lam = p.in[9][d * 2048 + chg];
#pragma unroll
        for (int s = 0; s < 4; ++s) {
#pragma unroll
            for (int rt = 0; rt < 8; ++rt) {
                const bf16x8 af = *(const bf16x8*)(UB + (rt * 16 + col) * LDU + s * 32 + q * 8);
#pragma unroll
                for (int gt = 0; gt < 2; ++gt) acc[gt][rt] = __builtin_amdgcn_mfma_f32_16x16x32_bf16(af, bfr[s][gt], acc[gt][rt], 0, 0, 0);
            }
            __builtin_amdgcn_sched_barrier(0);
        }
        const float sp = log1pf(expf(-lam));
        const float cdec = -8.f * sp * LOG2E;
        const f32x2 nl2 = {-LOG2E, -LOG2E}, nbr2 = {-br * LOG2E, -br * LOG2E}, nbi2 = {-bi * LOG2E, -bi * LOG2E}, cd2 = {cdec, cdec}, one2 = {1.f, 1.f};
        float hl[8][4], pc[8][4];
#pragma unroll
        for (int rt = 0; rt < 8; ++rt) {
            float av[4], bv[4];
#pragma unroll
            for (int jp = 0; jp < 2; ++jp) {
                const f32x2 xr = {acc[0][rt][2 * jp], acc[0][rt][2 * jp + 1]}, xi = {acc[1][rt][2 * jp], acc[1][rt][2 * jp + 1]};
                f32x2 er = xr * nl2 + nbr2, ei = xi * nl2 + nbi2;
                er = (f32x2){ex2(er[0]), ex2(er[1])} + one2; ei = (f32x2){ex2(ei[0]), ex2(ei[1])} + one2;
                const f32x2 r = {rcpf_(er[0]), rcpf_(er[1])}, ig = {rcpf_(ei[0]), rcpf_(ei[1])};
                const f32x2 la = r * cd2;
                const f32x2 a = {ex2(la[0]), ex2(la[1])};
                const f32x2 om = one2 - a * a;
                const f32x2 sc = {__builtin_amdgcn_sqrtf(om[0]), __builtin_amdgcn_sqrtf(om[1])};
                const f32x2 u2 = {bf2f(UB[(rt * 16 + 4 * q + 2 * jp) * LDU + chl]), bf2f(UB[(rt * 16 + 4 * q + 2 * jp + 1) * LDU + chl])};
                const f32x2 b2 = sc * ig * u2;
                av[2 * jp] = a[0]; av[2 * jp + 1] = a[1]; bv[2 * jp] = b2[0]; bv[2 * jp + 1] = b2[1];
            }
            float h = 0.f, P = 1.f;
            if (d == 0) {
#pragma unroll
                for (int j = 0; j < 4; ++j) { h = fmaf(av[j], h, bv[j]); P *= av[j]; hl[rt][j] = h; pc[rt][j] = P; }
            } else {
#pragma unroll
                for (int j = 3; j >= 0; --j) { h = fmaf(av[j], h, bv[j]); P *= av[j]; hl[rt][j] = h; pc[rt][j] = P; }
            }
            AG[(rt * 4 + q) * 16 + col] = (f32x2){P, h};
            __builtin_amdgcn_sched_barrier(0);
        }
        asm volatile("s_waitcnt lgkmcnt(0)" ::: "memory");
        float carry[8], pref[8]; float cin = 0.f, pa = 1.f;
#pragma unroll
        for (int gi = 0; gi < 32; ++gi) {
            const int G = d == 0 ? gi : 31 - gi; const int rt = G >> 2, qq = G & 3;
            const f32x2 ah = AG[G * 16 + col];
            if (qq == q) { carry[rt] = cin; pref[rt] = pa; }
            cin = fmaf(ah[0], cin, ah[1]); pa *= ah[0];
        }
        if (q == 0) AGG[((size_t)d * 128 + c) * 2048 + chg] = (f32x2){pa, cin};
#pragma unroll
        for (int rt = 0; rt < 8; ++rt) {
            const f32x2 cr2 = {carry[rt], carry[rt]}, pf2 = {pref[rt] * 255.f, pref[rt] * 255.f}, half2 = {0.5f, 0.5f};
#pragma unroll
            for (int jp = 0; jp < 2; ++jp) {
                const f32x2 pc2 = {pc[rt][2 * jp], pc[rt][2 * jp + 1]}, hl2 = {hl[rt][2 * jp], hl[rt][2 * jp + 1]};
                const f32x2 hf = pc2 * cr2 + hl2, pq = pc2 * pf2 + half2;
                const unsigned q0 = (unsigned)pq[0], q1 = (unsigned)pq[1];
                if (d == 0) { hsum[rt][2 * jp] = hf[0]; hsum[rt][2 * jp + 1] = hf[1]; ppk[rt][jp] = q0 | (q1 << 16); }
                else {
                    const int lo = (rt * 16 + 4 * q + 2 * jp) * LDU + chl;
                    const unsigned w = cvtpk(hsum[rt][2 * jp] + hf[0], hsum[rt][2 * jp + 1] + hf[1]);
                    OS[lo] = (unsigned short)(w & 0xffffu); OS[lo + LDU] = (unsigned short)(w >> 16);
                    const unsigned pw = ppk[rt][jp] | (q0 << 8) | (q1 << 24);
                    PS[lo] = (unsigned short)(pw & 0xffffu); PS[lo + LDU] = (unsigned short)(pw >> 16);
                }
            }
            __builtin_amdgcn_sched_barrier(0);
        }
    }
    __syncthreads();
    lru_copy_out(OS, (bf16_t*)((unsigned char*)p.out + DO_ACF) + (size_t)c * 128 * 2048 + nb * 128, tid);
    lru_copy_out(PS, (bf16_t*)((unsigned char*)p.out + DO_ACB) + (size_t)c * 128 * 2048 + nb * 128, tid);
}

namespace att {
constexpr float SCALE = 0.088388347648318440f, THR = 8.f;
constexpr int SHM_V = 64 * 128 * 2, SHM_K = SHM_V, LDK = 3072;
#define KSWZ(row, colB) ((row) * 256 + ((colB) ^ (((row) & 7) << 4)))
#define SBAR() __builtin_amdgcn_sched_barrier(0)
DI int crow(int r, int hi) { return (r & 3) + 8 * (r >> 2) + 4 * hi; }
DI void maskT(f32x16& p0, f32x16& p1, int kt, int qw, int r32, int hi) {
    if ((kt - qw - 31 < -128) || (kt + 63 - qw > 128)) {
        const int db = kt - (qw + r32) + 4 * hi;
#pragma unroll
        for (int r = 0; r < 16; ++r) { const int d = db + (r & 3) + 8 * (r >> 2);
            p0[r] = (d >= -128 && d <= 128) ? p0[r] : -1e30f; p1[r] = (d + 32 >= -128 && d + 32 <= 128) ? p1[r] : -1e30f; }
    }
}
DI void partialSM(f32x16& p0, f32x16& p1, float& m_reg, float& mn, float& alpha) {
    constexpr float C = SCALE * 1.4426950408889634f;
    float pmax = p0[0];
#pragma unroll
    for (int r = 1; r < 16; ++r) pmax = fmaxf(pmax, p0[r]);
#pragma unroll
    for (int r = 0; r < 16; ++r) pmax = fmaxf(pmax, p1[r]);
    { auto rr = __builtin_amdgcn_permlane32_swap(__float_as_uint(pmax), __float_as_uint(pmax), false, false);
      pmax = fmaxf(__uint_as_float(rr[0]), __uint_as_float(rr[1])); }
    if (__builtin_expect(__all(pmax - m_reg <= THR / SCALE), 1)) { mn = m_reg; alpha = 1.f; }
    else { mn = fmaxf(m_reg, pmax); alpha = __builtin_amdgcn_exp2f((m_reg - mn) * C); m_reg = mn; }
    const float mnC = -mn * C;
#pragma unroll
    for (int r = 0; r < 16; ++r) p0[r] = fmaf(p0[r], C, mnC);
#pragma unroll
    for (int r = 0; r < 16; ++r) p1[r] = fmaf(p1[r], C, mnC);
#pragma unroll
    for (int r = 0; r < 16; ++r) p0[r] = __builtin_amdgcn_exp2f(p0[r]);
}
DI void finishSM(f32x16& p0, f32x16& p1, float alpha, float& l_reg, bf16x8& pa0, bf16x8& pa1, bf16x8& pa2, bf16x8& pa3) {
#pragma unroll
    for (int r = 0; r < 16; ++r) p1[r] = __builtin_amdgcn_exp2f(p1[r]);
    float ps = 0;
#pragma unroll
    for (int r = 0; r < 16; ++r) ps += p0[r];
#pragma unroll
    for (int r = 0; r < 16; ++r) ps += p1[r];
    { auto rr = __builtin_amdgcn_permlane32_swap(__float_as_uint(ps), __float_as_uint(ps), false, false);
      ps = __uint_as_float(rr[0]) + __uint_as_float(rr[1]); }
    l_reg = l_reg * alpha + ps;
#define PK4(P, BASE, OUT) do { unsigned a0 = cvtpk(P[BASE + 0], P[BASE + 1]), a1 = cvtpk(P[BASE + 2], P[BASE + 3]);   \
    unsigned b0 = cvtpk(P[BASE + 4], P[BASE + 5]), b1 = cvtpk(P[BASE + 6], P[BASE + 7]);                              \
    auto r0 = __builtin_amdgcn_permlane32_swap(a0, b0, false, false); auto r1 = __builtin_amdgcn_permlane32_swap(a1, b1, false, false); \
    u32x4 w = {r0[0], r1[0], r0[1], r1[1]}; OUT = __builtin_bit_cast(bf16x8, w); } while (0)
    PK4(p0, 0, pa0); PK4(p0, 8, pa1); PK4(p1, 0, pa2); PK4(p1, 8, pa3);
#undef PK4
}
DI void qkt(f32x16& p0, f32x16& p1, const char* Ks, const bf16x8* qr, int r32, int hi) {
#pragma unroll
    for (int i = 0; i < 16; ++i) { p0[i] = 0.f; p1[i] = 0.f; }
#pragma unroll
    for (int d0 = 0; d0 < 8; ++d0) { const int cb = (d0 * 16 + hi * 8) * 2;
        const bf16x8 b0 = *reinterpret_cast<const bf16x8*>(Ks + KSWZ(r32, cb));
        const bf16x8 b1 = *reinterpret_cast<const bf16x8*>(Ks + KSWZ(32 + r32, cb));
        p0 = __builtin_amdgcn_mfma_f32_32x32x16_bf16(b0, qr[d0], p0, 0, 0, 0);
        p1 = __builtin_amdgcn_mfma_f32_32x32x16_bf16(b1, qr[d0], p1, 0, 0, 0); }
}
DI int v_st(int k, int c) { const int kk = (k & ~0xC) | ((k & 4) << 1) | ((k & 8) >> 1); return ((kk >> 3) * 4 + (c >> 5)) * 512 + ((kk & 7) * 32 + (c & 31)) * 2; }
DI int v_rd_base(int lane) { return ((lane & 3) << 3) | (((lane >> 2) & 3) << 6) | (((lane >> 4) & 1) << 5) | (((lane >> 5) & 1) << 8); }
constexpr int v_rd_off(int d0, int ks, int half) { return d0 * 512 + ks * 4096 + half * 2048; }
template <int OFF> DI s16x4 tr_read(int vb) {
    s16x4 r; asm volatile("ds_read_b64_tr_b16 %0, %1 offset:%2" : "=&v"(r) : "v"(vb), "i"(OFF) : "memory"); return r;
}
template <int D0> DI void pv_one(f32x16& od, int vb, bf16x8 pa0, bf16x8 pa1, bf16x8 pa2, bf16x8 pa3) {
    const s16x4 l0 = tr_read<v_rd_off(D0, 0, 0)>(vb), h0 = tr_read<v_rd_off(D0, 0, 1)>(vb), l1 = tr_read<v_rd_off(D0, 1, 0)>(vb), h1 = tr_read<v_rd_off(D0, 1, 1)>(vb);
    const s16x4 l2 = tr_read<v_rd_off(D0, 2, 0)>(vb), h2 = tr_read<v_rd_off(D0, 2, 1)>(vb), l3 = tr_read<v_rd_off(D0, 3, 0)>(vb), h3 = tr_read<v_rd_off(D0, 3, 1)>(vb);
    asm volatile("s_waitcnt lgkmcnt(0)" ::: "memory"); SBAR();
#define PK(L, H) (bf16x8){L[0], L[1], L[2], L[3], H[0], H[1], H[2], H[3]}
    od = __builtin_amdgcn_mfma_f32_32x32x16_bf16(pa0, PK(l0, h0), od, 0, 0, 0);
    od = __builtin_amdgcn_mfma_f32_32x32x16_bf16(pa1, PK(l1, h1), od, 0, 0, 0);
    od = __builtin_amdgcn_mfma_f32_32x32x16_bf16(pa2, PK(l2, h2), od, 0, 0, 0);
    od = __builtin_amdgcn_mfma_f32_32x32x16_bf16(pa3, PK(l3, h3), od, 0, 0, 0);
#undef PK
}
DI void pv_d0(f32x16* o, int vb, bf16x8 pa0, bf16x8 pa1, bf16x8 pa2, bf16x8 pa3) {
    pv_one<0>(o[0], vb, pa0, pa1, pa2, pa3); pv_one<1>(o[1], vb, pa0, pa1, pa2, pa3); pv_one<2>(o[2], vb, pa0, pa1, pa2, pa3); pv_one<3>(o[3], vb, pa0, pa1, pa2, pa3);
}
DI void attn_item(const bf16_t* __restrict__ Qw_, const bf16_t* __restrict__ Kh, const bf16_t* __restrict__ Vh, const bf16_t* Gw, bf16_t* Ow,
                  int NT, int kt0, int qw, float sinkv, char* lds) {
    const int tid = threadIdx.x, wid = __builtin_amdgcn_readfirstlane(tid >> 6), lane = tid & 63, r32 = lane & 31, hi = lane >> 5;
    char* V_lds = lds; char* K_lds = lds + 2 * SHM_V;
    float* wsp = (float*)(lds + 2 * SHM_V + 2 * SHM_K) + wid * 64; float* li_l = wsp; float* al_l = wsp + 32;
    float m_reg = sinkv * (1.f / SCALE), l_reg = 1.f; f32x16 o[4]; bf16x8 qr[8];
#pragma unroll
    for (int d = 0; d < 4; ++d)
#pragma unroll
        for (int r = 0; r < 16; ++r) o[d][r] = 0.f;
    const bf16_t* Qw = Qw_ + (size_t)r32 * LDK + hi * 8;
#pragma unroll
    for (int d0 = 0; d0 < 8; ++d0) qr[d0] = *(const bf16x8*)(Qw + d0 * 16);
    const int sr = tid >> 4, sc = (tid & 15) * 8, vst0 = v_st(sr, sc), vst1 = v_st(32 + sr, sc);
    const int vb0 = (int)(uintptr_t)V_lds + v_rd_base(lane);
    struct { bf16x8 vs0, vs1, ks0, ks1; } sr_[2];
#define SLOAD(i, k0) do { sr_[i].vs0 = *(const bf16x8*)(&Vh[(size_t)((k0) + sr) * LDK + sc]); sr_[i].vs1 = *(const bf16x8*)(&Vh[(size_t)((k0) + 32 + sr) * LDK + sc]); \
    sr_[i].ks0 = *(const bf16x8*)(&Kh[(size_t)((k0) + sr) * LDK + sc]); sr_[i].ks1 = *(const bf16x8*)(&Kh[(size_t)((k0) + 32 + sr) * LDK + sc]); } while (0)
#define SWRITE(b, i) do { *(bf16x8*)(V_lds + (b) * SHM_V + vst0) = sr_[i].vs0;          \
    *(bf16x8*)(V_lds + (b) * SHM_V + vst1) = sr_[i].vs1; const int kc = sc * 2;               \
    *(bf16x8*)(K_lds + (b) * SHM_K + KSWZ(sr, kc)) = sr_[i].ks0;                       \
    *(bf16x8*)(K_lds + (b) * SHM_K + KSWZ(32 + sr, kc)) = sr_[i].ks1; } while (0)
#define SWAIT() asm volatile("s_waitcnt vmcnt(4)" ::: "memory")
#define RESC(a) do { if (__any((a) < 1.f)) { if (hi == 0) al_l[r32] = (a); asm volatile("s_waitcnt lgkmcnt(0)" ::: "memory"); \
    _Pragma("unroll") for (int d = 0; d < 4; ++d) _Pragma("unroll") for (int r = 0; r < 16; ++r) o[d][r] *= al_l[crow(r, hi)]; } } while (0)
    f32x16 pA0, pA1, pB0, pB1; float mnA, mnB, alA, alB; bf16x8 pa0, pa1, pa2, pa3;
    constexpr int SE = 0, SO = 1;
    SLOAD(SE, 0); asm volatile("s_waitcnt vmcnt(0)" ::: "memory"); SWRITE(0, SE); __syncthreads();
    qkt(pA0, pA1, K_lds, qr, r32, hi); maskT(pA0, pA1, kt0, qw, r32, hi); partialSM(pA0, pA1, m_reg, mnA, alA);
    SLOAD(SO, 64); if (2 < NT) SLOAD(SE, 128);
    SWAIT(); SWRITE(1, SO); __syncthreads();
    for (int j = 1; j + 1 < NT; j += 2) {
        SBAR(); qkt(pB0, pB1, K_lds + SHM_K, qr, r32, hi);
        finishSM(pA0, pA1, alA, l_reg, pa0, pa1, pa2, pa3); SBAR();
        SLOAD(SO, (j + 2) * 64); SBAR();
        pv_d0(o, vb0, pa0, pa1, pa2, pa3); maskT(pB0, pB1, kt0 + 64 * j, qw, r32, hi); partialSM(pB0, pB1, m_reg, mnB, alB);
        __syncthreads(); SWAIT(); SWRITE(0, SE);
        RESC(alB); __syncthreads();
        SBAR(); qkt(pA0, pA1, K_lds, qr, r32, hi);
        finishSM(pB0, pB1, alB, l_reg, pa0, pa1, pa2, pa3); SBAR();
        if (j + 3 < NT) SLOAD(SE, (j + 3) * 64); SBAR();
        pv_d0(o, vb0 + SHM_V, pa0, pa1, pa2, pa3); maskT(pA0, pA1, kt0 + 64 * (j + 1), qw, r32, hi); partialSM(pA0, pA1, m_reg, mnA, alA);
        __syncthreads(); SWAIT(); SWRITE(1, SO);
        RESC(alA); __syncthreads();
    }
    SBAR(); qkt(pB0, pB1, K_lds + SHM_K, qr, r32, hi);
    finishSM(pA0, pA1, alA, l_reg, pa0, pa1, pa2, pa3); SBAR();
    pv_d0(o, vb0, pa0, pa1, pa2, pa3); maskT(pB0, pB1, kt0 + 64 * (NT - 1), qw, r32, hi); partialSM(pB0, pB1, m_reg, mnB, alB);
    __syncthreads(); RESC(alB);
    finishSM(pB0, pB1, alB, l_reg, pa0, pa1, pa2, pa3); SBAR();
    pv_d0(o, vb0 + SHM_V, pa0, pa1, pa2, pa3);
    int lane2 = threadIdx.x & 63; asm volatile("" : "+v"(lane2));
    const int ec = lane2 & 15, er = lane2 >> 4;
    if (hi == 0) li_l[r32] = l_reg; asm volatile("s_waitcnt lgkmcnt(0)" ::: "memory");
    bf16_t* OT = (bf16_t*)(lds + 67584 + wid * 8704);
#pragma unroll
    for (int r = 0; r < 16; ++r) { const int orow = crow(r, hi); const float rl = __builtin_amdgcn_rcpf(li_l[orow]);
#pragma unroll
        for (int d0 = 0; d0 < 4; ++d0) OT[orow * 136 + d0 * 32 + r32] = f2bf(o[d0][r] * rl); }
    __builtin_amdgcn_sched_barrier(0);
    u32x4 gv[8];
#pragma unroll
    for (int k = 0; k < 8; ++k) gv[k] = __builtin_nontemporal_load((const u32x4*)(Gw + (size_t)(er + 4 * k) * 2048 + ec * 8));
    asm volatile("s_waitcnt lgkmcnt(0)" ::: "memory");
#pragma unroll
    for (int k = 0; k < 8; ++k) {
        const u32x4 ov = *(const u32x4*)(OT + (er + 4 * k) * 136 + ec * 8); u32x4 w;
#pragma unroll
        for (int i = 0; i < 4; ++i) { const float g0 = bflo(gv[k][i]), g1 = bfhi(gv[k][i]); w[i] = cvtpk(bflo(ov[i]) * g0 * sigm(g0), bfhi(ov[i]) * g1 * sigm(g1)); }
        __builtin_nontemporal_store(w, (u32x4*)(Ow + (size_t)(er + 4 * k) * 2048 + ec * 8));
    }
#undef SLOAD
#undef SWRITE
#undef SWAIT
#undef RESC
}
}

DI void phase_lru(const Params& p, unsigned char* shm) {
    for (int it = blockIdx.x; it < 2048; it += gridDim.x) lru_tile(p, shm, it >> 4, it & 15);
    __syncthreads();
}
DI void phase_att(const Params& p, unsigned char* shm) {
    const int wid = __builtin_amdgcn_readfirstlane(threadIdx.x >> 6);
    const bf16_t* Z = (const bf16_t*)(p.ws + WS_ZQKV); const bf16_t* GA = (const bf16_t*)(p.ws + WS_ZGA); bf16_t* YB = (bf16_t*)(p.ws + WS_YB);
    for (int it = blockIdx.x; it < 1024; it += gridDim.x) {
        const int hp = it & 1, g = (it >> 1) & 3, n = it >> 3;
        const int head = g * 4 + hp * 2 + (wid >> 2), qw = 32 * (wid & 3);
        const int kfirst = n == 0 ? 0 : (n - 1) * 128, NT = (n == 0 || n == 127) ? 4 : 6, kt0 = kfirst - n * 128;
        __syncthreads();
        const size_t go = (size_t)(n * 128 + qw) * 2048 + head * 128;
        att::attn_item(Z + (size_t)(n * 128 + qw) * 3072 + head * 128, Z + (size_t)kfirst * 3072 + 2048 + g * 128, Z + (size_t)kfirst * 3072 + 2560 + g * 128,
                       GA + go, YB + go, NT, kt0, qw, p.in[10][head], (char*)shm);
    }
    __syncthreads();
}
DI void phase_mixers(const Params& p, unsigned char* shm) { if (p.mix_mask & 1) phase_lru(p, shm); if (p.mix_mask & 2) phase_att(p, shm); }

DI void phase_carry(const Params& p) {
    const int tid = threadIdx.x;
    if (tid >= 64) return;
    const f32x2* AGG = (const f32x2*)(p.ws + WS_AGG); float* CAR = (float*)(p.ws + WS_CAR);
    for (int w = blockIdx.x; w < 64; w += gridDim.x) {
        const int id = w * 64 + tid, d = id >> 11, ch = id & 2047;
        const f32x2* ag = AGG + (size_t)d * 128 * 2048 + ch; float* car = CAR + (size_t)d * 128 * 2048 + ch;
        float cin = 0.f;
        for (int b = 0; b < 4; ++b) {
            f32x2 v[32];
#pragma unroll
            for (int u = 0; u < 32; ++u) { const int k = b * 32 + u, cc = d == 0 ? k : 127 - k; v[u] = ag[(size_t)cc * 2048]; }
#pragma unroll
            for (int u = 0; u < 32; ++u) { const int k = b * 32 + u, cc = d == 0 ? k : 127 - k; car[(size_t)cc * 2048] = cin; cin = fmaf(v[u][0], cin, v[u][1]); }
        }
    }
}
DI void phase_fixup(const Params& p) {
    const int tid = threadIdx.x, ch = (tid & 255) * 8, r2 = tid >> 8;
    const float* CAR = (const float*)(p.ws + WS_CAR);
    bf16_t* ZG = (bf16_t*)(p.ws + WS_ZG);
    const bf16_t* HLp = (const bf16_t*)((unsigned char*)p.out + DO_ACF); const bf16_t* PPp = (const bf16_t*)((unsigned char*)p.out + DO_ACB);
    for (int it = blockIdx.x; it < 512; it += gridDim.x) {
        const int c = it >> 2, rq = it & 3;
        float cf[8], cb[8];
        { const f32x4 a0 = *(const f32x4*)(CAR + (size_t)c * 2048 + ch), a1 = *(const f32x4*)(CAR + (size_t)c * 2048 + ch + 4);
          const f32x4 b0 = *(const f32x4*)(CAR + (size_t)(128 + c) * 2048 + ch), b1 = *(const f32x4*)(CAR + (size_t)(128 + c) * 2048 + ch + 4);
#pragma unroll
          for (int i = 0; i < 4; ++i) { cf[i] = a0[i] * (1.f / 255.f); cf[4 + i] = a1[i] * (1.f / 255.f); cb[i] = b0[i] * (1.f / 255.f); cb[4 + i] = b1[i] * (1.f / 255.f); } }
#pragma unroll 8
        for (int i = 0; i < 16; ++i) {
            const size_t off = (size_t)(c * 128 + rq * 32 + 2 * i + r2) * 2048 + ch;
            const u32x4 g = __builtin_nontemporal_load((const u32x4*)(ZG + off)), h = __builtin_nontemporal_load((const u32x4*)(HLp + off)), pp = __builtin_nontemporal_load((const u32x4*)(PPp + off));
            u32x4 o;
#pragma unroll
            for (int k = 0; k < 4; ++k) {
                const float g0 = bflo(g[k]), g1 = bfhi(g[k]);
                const float y0 = (bflo(h[k]) + ub(pp[k], 0) * cf[2 * k] + ub(pp[k], 1) * cb[2 * k]) * g0 * sigm(g0);
                const float y1 = (bfhi(h[k]) + ub(pp[k], 2) * cf[2 * k + 1] + ub(pp[k], 3) * cb[2 * k + 1]) * g1 * sigm(g1);
                o[k] = cvtpk(y0, y1);
            }
            *(u32x4*)(ZG + off) = o;
        }
    }
}

DI void phase_final(const Params& p) {
    const int tid = threadIdx.x, wid = tid >> 6, lane = tid & 63;
    const float* x = p.in[0]; const float* nw = p.in[14]; const bf16_t* o2 = (const bf16_t*)(p.ws + WS_OUT2); const float* ssq = (const float*)(p.ws + WS_SSQ);
    f32x4 w[8];
#pragma unroll
    for (int i = 0; i < 8; ++i) w[i] = *(const f32x4*)(nw + i * 256 + lane * 4);
    for (int row = (blockIdx.x * 8 + wid) * 2; row < S; row += gridDim.x * 16) {
        f32x4 xv[2][8]; u32x2 yv[2][8]; float sq[2];
#pragma unroll
        for (int r = 0; r < 2; ++r) {
            sq[r] = lane < 32 ? ssq[(size_t)(row + r) * 32 + lane] : 0.f;
#pragma unroll
            for (int i = 0; i < 8; ++i) { const size_t off = (size_t)(row + r) * DM + i * 256 + lane * 4; xv[r][i] = __builtin_nontemporal_load((const f32x4*)(x + off)); yv[r][i] = __builtin_nontemporal_load((const u32x2*)(o2 + off)); }
        }
#pragma unroll
        for (int r = 0; r < 2; ++r) {
            const float rs = rsqrtf(wave_sum(sq[r]) * (1.f / DM) + EPS);
#pragma unroll
            for (int i = 0; i < 8; ++i) { const size_t off = (size_t)(row + r) * DM + i * 256 + lane * 4;
                const f32x4 ov = {xv[r][i][0] + bflo(yv[r][i][0]) * rs * w[i][0], xv[r][i][1] + bfhi(yv[r][i][0]) * rs * w[i][1],
                                  xv[r][i][2] + bflo(yv[r][i][1]) * rs * w[i][2], xv[r][i][3] + bfhi(yv[r][i][1]) * rs * w[i][3]};
                __builtin_nontemporal_store(ov, (f32x4*)(p.out + off)); }
        }
    }
}

#define XB_TMO      128
#define XB_XCNT(j)  (256  + 64 * (j))
#define XB_XSUB(j)  (1280 + 64 * (j))
#define XB_XGEN(j)  (2304 + 64 * (j))
#define XB_TOP      3328
#define XB_TOPGEN   3392
#define XCD_BAR_WORDS 3456
#define XB_SPIN_CAP (1u << 18)

__device__ __forceinline__ unsigned xb_ld(unsigned* p)              { return __hip_atomic_load(p, __ATOMIC_RELAXED, __HIP_MEMORY_SCOPE_AGENT); }
__device__ __forceinline__ unsigned xb_add(unsigned* p, unsigned v) { return __hip_atomic_fetch_add(p, v, __ATOMIC_RELAXED, __HIP_MEMORY_SCOPE_AGENT); }
__device__ __forceinline__ unsigned xb_xcc_id() { return (unsigned)__builtin_amdgcn_s_getreg((3 << 11) | 20) & 0xFu; }
#define XB_SPIN(cond, bar) do { unsigned _sp = 0; while (cond) { __builtin_amdgcn_s_sleep(1); \
    if ((++_sp & 255u) == 0u) { if (xb_ld(&(bar)[XB_TMO])) break; if (_sp > XB_SPIN_CAP) { atomicAdd(&(bar)[XB_TMO], 1u); break; } } } } while (0)

struct XcdBarrier {
    unsigned* bar; unsigned x;
    volatile LAS unsigned* st;
};

__device__ __forceinline__ XcdBarrier xcd_barrier_post(unsigned* bar, volatile LAS unsigned* st) {
    XcdBarrier b; b.bar = bar; b.x = xb_xcc_id(); b.st = st;
    if (threadIdx.x == 0) (void)xb_add(&bar[XB_XCNT(b.x)], 1u);
    return b;
}
__device__ __forceinline__ void xcd_barrier_complete(unsigned* bar, unsigned x, unsigned& nloc, unsigned& nx) {
    const unsigned G = gridDim.x * gridDim.y * gridDim.z;
    unsigned sum, cnt, mine, sp = 0u;
    for (;;) {
        sum = 0u; cnt = 0u; mine = 0u;
#pragma unroll
        for (unsigned j = 0; j < 16; ++j) { const unsigned c = xb_ld(&bar[XB_XCNT(j)]); sum += c; cnt += (c > 0u) ? 1u : 0u; mine = (j == x) ? c : mine; }
        if (sum == G) break;
        __builtin_amdgcn_s_sleep(1);
        if ((++sp & 255u) == 0u) { if (xb_ld(&bar[XB_TMO])) break; if (sp > XB_SPIN_CAP) { atomicAdd(&bar[XB_TMO], 1u); break; } }
    }
    nloc = mine > 0u ? mine : 1u; nx = cnt > 0u ? cnt : 1u;
}

__device__ __forceinline__ void xcd_barrier(const XcdBarrier& b) {
    asm volatile("s_waitcnt vmcnt(0)" ::: "memory");
    __syncthreads();
    if (threadIdx.x == 0) {
        unsigned* bar = b.bar;
        __builtin_amdgcn_s_waitcnt(0);
        unsigned nloc = b.st[0], nx = b.st[1];
        if (nloc == 0u) { xcd_barrier_complete(bar, b.x, nloc, nx); b.st[0] = nloc; b.st[1] = nx; }
        const unsigned old = xb_add(&bar[XB_XSUB(b.x)], 1u);
        const unsigned gen = old / nloc;
        if (old + 1u == (gen + 1u) * nloc) {
            __builtin_amdgcn_fence(__ATOMIC_RELEASE, "agent");
            asm volatile("s_waitcnt vmcnt(0)" ::: "memory");
            const unsigned og = xb_add(&bar[XB_TOP], 1u);
            const unsigned tg = og / nx;
            if (og + 1u == (tg + 1u) * nx) xb_add(&bar[XB_TOPGEN], 1u);
            else XB_SPIN(xb_ld(&bar[XB_TOPGEN]) == tg, bar);
            __builtin_amdgcn_fence(__ATOMIC_ACQUIRE, "agent");
            xb_add(&bar[XB_XGEN(b.x)], 1u);
            asm volatile("s_waitcnt vmcnt(0)" ::: "memory");
        } else {
            XB_SPIN(xb_ld(&bar[XB_XGEN(b.x)]) == gen, bar);
            __builtin_amdgcn_fence(__ATOMIC_ACQUIRE, "agent");
            asm volatile("s_waitcnt vmcnt(0)" ::: "memory");
        }
    }
    __syncthreads();
}

__global__ void __launch_bounds__(512, 2) mega(Params p) {
    extern __shared__ __attribute__((aligned(16))) unsigned char shm[];
    cg::grid_group grid = cg::this_grid();
    volatile LAS unsigned* bst = (volatile LAS unsigned*)((LAS unsigned char*)shm + LDS_BAR_ST);
    if (threadIdx.x < 4) bst[threadIdx.x] = 0u;
    __syncthreads();
    XcdBarrier xbar; xbar.bar = (unsigned*)(p.ws + WS_BAR); xbar.x = 0; xbar.st = bst;
    if (p.ph_hi - p.ph_lo > 1) xbar = xcd_barrier_post((unsigned*)(p.ws + WS_BAR), bst);
    if (p.ph_lo > 64) grid.sync();
#ifndef PHMASK
#define PHMASK 0xff
#endif
#define PH(i) (((PHMASK >> (i)) & 1) && p.ph_lo <= (i) && (i) < p.ph_hi)
#define SEAM(i) do { if (p.ph_lo <= (i) && (i) + 1 < p.ph_hi) xcd_barrier(xbar); } while (0)
    if (PH(0)) phase_prep(p, shm);
    SEAM(0);
    if (PH(1)) {
        pg8::Gemm g; g.A0 = (const bf16_t*)((unsigned char*)p.out + DO_XN); g.A1 = g.A0; g.B0 = (const bf16_t*)((unsigned char*)p.out + DO_WINT); g.B1 = g.B0;
        g.lda = DM; g.ldb = DM; g.M = S; g.N = NIN; g.K = DM; g.ksplit = DM / 64;
        pg8::StaticOrder so; so.init(g.M, g.N, (int)gridDim.x, (int)blockIdx.x);
        EpiZ e; e.ws = p.ws;
        if (gridDim.x >= 16 && (gridDim.x & 15) == 0) { if ((blockIdx.x >> 3) & 1) prep_small_weights(p, shm, (int)((blockIdx.x >> 4) * 8 + (blockIdx.x & 7)), (int)(gridDim.x / 2)); }
        else prep_small_weights(p, shm, (int)blockIdx.x, (int)gridDim.x);
        pg8::gemm_phase<EpiZ>((LAS unsigned char*)shm, g, so, e);
    }
    SEAM(1);
#if PROBE_SPLIT
    if (PH(2)) phase_lru(p, shm);
    if (p.ph_lo == 8) phase_att(p, shm);
#else
    if (PH(2)) phase_mixers(p, shm);
#endif
    SEAM(2);
    if (PH(3)) phase_carry(p);
    SEAM(3);
    if (PH(4)) phase_fixup(p);
    SEAM(4);
    if (PH(5)) {
        pg8::Gemm g; g.A0 = (const bf16_t*)(p.ws + WS_ZG); g.A1 = (const bf16_t*)(p.ws + WS_YB) - 2048; g.B0 = (const bf16_t*)(p.ws + WS_WAT); g.B1 = (const bf16_t*)(p.ws + WS_WBT) - 2048;
        g.lda = DM; g.ldb = DM; g.M = S; g.N = DM; g.K = 2 * DM; g.ksplit = DM / 64;
        pg8::StaticOrder so; so.init(g.M, g.N, (int)gridDim.x, (int)blockIdx.x);
        EpiMergeMid e; e.ws = p.ws;
        pg8::gemm_phase<EpiMergeMid>((LAS unsigned char*)shm, g, so, e);
    }
    SEAM(5);
    if (PH(6)) {
        pg8::Gemm g; g.A0 = (const bf16_t*)(p.ws + WS_MRG); g.A1 = g.A0; g.B0 = (const bf16_t*)(p.ws + WS_WOT); g.B1 = g.B0;
        g.lda = DM; g.ldb = DM; g.M = S; g.N = DM; g.K = DM; g.ksplit = DM / 64;
        pg8::StaticOrder so; so.init(g.M, g.N, (int)gridDim.x, (int)blockIdx.x);
        EpiOut e; e.ws = p.ws;
        pg8::gemm_phase<EpiOut>((LAS unsigned char*)shm, g, so, e);
    }
    SEAM(6);
    if (PH(7)) phase_final(p);
}

extern "C" void kernel_launch(void* const* d_in, const int* in_sizes, int n_in, void* d_out, int out_size, void* d_ws, size_t ws_size, hipStream_t stream) {
    static int grid = 0;
    if (grid == 0) {
        if (n_in != 15 || in_sizes[0] != S * DM || out_size != S * DM || ws_size < WS_END) {
            fprintf(stderr, "kernel_launch: unexpected shapes (n_in %d, in0 %d, out %d, ws %zu; need ws >= %zu)\n", n_in, n_in > 0 ? in_sizes[0] : -1, out_size, ws_size, (size_t)WS_END); grid = -1; return; }
        int dev = 0, cus = 0, per_cu = 0;
        (void)hipGetDevice(&dev); (void)hipDeviceGetAttribute(&cus, hipDeviceAttributeMultiprocessorCount, dev);
        if (hipFuncSetAttribute((const void*)mega, hipFuncAttributeMaxDynamicSharedMemorySize, LDS_BYTES) != hipSuccess) { fprintf(stderr, "kernel_launch: hipFuncSetAttribute failed\n"); grid = -1; return; }
        if (hipOccupancyMaxActiveBlocksPerMultiprocessor(&per_cu, (const void*)mega, 512, LDS_BYTES) != hipSuccess || per_cu < 1) { fprintf(stderr, "kernel_launch: occupancy query gave %d\n", per_cu); per_cu = 1; }
        (void)hipGetLastError();
        grid = cus * per_cu;
    }
    if (grid < 0) return;
    Params p{};
    for (int i = 0; i < 15; ++i) p.in[i] = (const float*)d_in[i];
    p.out = (float*)d_out; p.ws = (unsigned char*)d_ws;
    for (int j = 0; j < 16; ++j) p.inv_freq[j] = (float)pow(500000.0, -(double)j / 16.0);
    p.mix_mask = 3;
#if MK_SINGLE
    p.ph_lo = 0; p.ph_hi = 8;
    if (hipMemsetAsync((unsigned char*)d_ws + WS_BAR, 0, XCD_BAR_WORDS * sizeof(unsigned), stream) != hipSuccess) { fprintf(stderr, "kernel_launch: memset of barrier words failed\n"); return; }
    void* args[] = {&p};
    hipError_t e = hipLaunchCooperativeKernel((const void*)mega, dim3(grid), dim3(512), args, LDS_BYTES, stream);
    if (e != hipSuccess) fprintf(stderr, "kernel_launch: cooperative launch failed: %s (grid %d)\n", hipGetErrorString(e), grid);
#else
#ifndef REPMASK
#define REPMASK 0
#endif
#ifndef HALFMASK
#define HALFMASK 0
#endif
    static const int lph[9] = {0, 1, 2, 2, 3, 4, 5, 6, 7}; static const int lmix[9] = {3, 3, 1, 2, 3, 3, 3, 3, 3};
    for (int li = 0; li < 9; ++li) {
        p.ph_lo = lph[li]; p.ph_hi = lph[li] + 1; p.mix_mask = lmix[li];
#ifndef REPMASK
#define REPMASK 0
#endif
        for (int rep = 0; rep < (((REPMASK >> li) & 1) ? 2 : 1); ++rep)
        hipLaunchKernelGGL(mega, dim3(((HALFMASK >> li) & 1) ? grid / 2 : grid), dim3(512), LDS_BYTES, stream, p);
    }
#endif
}
```

```cpp
#include <hip/hip_runtime.h>
#include <hip/hip_cooperative_groups.h>
#include <cstdio>
#include <cstdint>
#include <cmath>
namespace cg = cooperative_groups;

#ifndef MK_SINGLE
#define MK_SINGLE 1
#endif

#define LAS __attribute__((address_space(3)))
#define DI __device__ __forceinline__
typedef unsigned short bf16_t;
typedef short bf16x8 __attribute__((ext_vector_type(8)));
typedef short s16x4 __attribute__((ext_vector_type(4)));
typedef float f32x2 __attribute__((ext_vector_type(2)));
typedef float f32x4 __attribute__((ext_vector_type(4)));
typedef float f32x16 __attribute__((ext_vector_type(16)));
typedef unsigned u32x2 __attribute__((ext_vector_type(2)));
typedef unsigned u32x4 __attribute__((ext_vector_type(4)));

constexpr int S = 16384, DM = 2048, NIN = 13312;
constexpr float EPS = 1e-6f;
constexpr float LOG2E = 1.4426950408889634f;
constexpr size_t MiB = (size_t)1 << 20;
constexpr size_t WS_ZU = 0, WS_MERGED = 0;
constexpr size_t WS_ZG = 64 * MiB;
constexpr size_t WS_ZQKV = 128 * MiB;
constexpr size_t WS_ZGA = 224 * MiB;
constexpr size_t WS_ZM = 288 * MiB, WS_OUT2 = 288 * MiB;
constexpr size_t WS_WAT = 416 * MiB, WS_WBT = 424 * MiB, WS_WOT = 432 * MiB;
constexpr size_t WS_ROPE = 440 * MiB;
constexpr size_t WS_AGG = 442 * MiB;
constexpr size_t WS_SSQ = 446 * MiB;
constexpr size_t WS_LWT = 448 * MiB;
constexpr size_t WS_CAR = 450 * MiB;
constexpr size_t WS_BAR = 452 * MiB;
constexpr size_t WS_END = 453 * MiB;
constexpr size_t DO_XN = 0, DO_WINT = 64 * MiB;
constexpr size_t DO_ACF = 0, DO_ACB = 64 * MiB;
#ifndef PROBE_SPLIT
#define PROBE_SPLIT 0
#endif
constexpr size_t WS_YB = PROBE_SPLIT ? WS_ZU : WS_ZGA;
constexpr size_t WS_MRG = PROBE_SPLIT ? WS_ZQKV : WS_MERGED;
constexpr int LDS_BAR_ST = 137216;
constexpr int LDS_BYTES = 137232;

struct Params {
    const float* in[15];
    float* out; unsigned char* ws;
    float inv_freq[16];
    int ph_lo, ph_hi, mix_mask, pad_;
};

DI unsigned cvtpk(float lo, float hi) { unsigned r; asm volatile("v_cvt_pk_bf16_f32 %0, %1, %2" : "=v"(r) : "v"(lo), "v"(hi)); return r; }
DI float bf2f(unsigned short b) { return __uint_as_float(((unsigned)b) << 16); }
DI float bflo(unsigned w) { return __uint_as_float(w << 16); }
DI float bfhi(unsigned w) { return __uint_as_float(w & 0xffff0000u); }
DI unsigned short f2bf(float f) { return (unsigned short)(cvtpk(f, f) & 0xffffu); }
DI float ex2(float x) { return __builtin_amdgcn_exp2f(x); }
DI float rcpf_(float x) { return __builtin_amdgcn_rcpf(x); }
DI float sigm(float x) { return rcpf_(1.f + ex2(-x * LOG2E)); }
DI float wave_sum(float v) {
#pragma unroll
    for (int o = 32; o >= 1; o >>= 1) v += __shfl_xor(v, o);
    return v;
}

namespace pg8 {
constexpr int BM = 256, BK = 64, HALF = 128, HTB = HALF * BK * 2, STAGE_BYTES = 8 * HTB, NXCD = 8, WGM = 8;
DI int lds_byte(int r, int c) { const int st = (r >> 4) * 2 + (c >> 5), rr = r & 15, cc = c & 31, ob = rr * 64 + cc * 2; return st * 1024 + (ob ^ (((ob >> 9) & 1) << 5)); }
DI void stage_rc(int b, int& R, int& C) { const int st = b / 1024, sb = b % 1024, swz = sb ^ (((sb >> 9) & 1) << 5); R = (st >> 1) * 16 + swz / 64; C = (st & 1) * 32 + (swz % 64) / 2; }
DI int perm32(int rho) { const int n = rho >> 4, i = rho & 15; return 8 * (i >> 2) + 4 * n + (i & 3); }
struct Unit { int pm, pn; };
struct Gemm { const bf16_t* A0; const bf16_t* A1; const bf16_t* B0; const bf16_t* B1; int lda, ldb, M, N, K, ksplit; };
struct StaticOrder {
    int nM, nN, nwg, G, c;
    DI void init(int M, int N, int G_, int c_) { nM = M / BM; nN = N / BM; nwg = nM * nN; G = G_; c = c_; }
    DI bool next(int i, Unit& u) const {
        const long L = (long)i * G + c; if (L >= nwg) return false;
        int wgid = (int)L; { const int q = nwg / NXCD, r = nwg % NXCD, xcd = wgid % NXCD, off = wgid / NXCD; wgid = (xcd < r ? xcd * (q + 1) : r * (q + 1) + (xcd - r) * q) + off; }
        const int nig = WGM * nN, gid = wgid / nig, fm = gid * WGM, gsz = (nM - fm) < WGM ? (nM - fm) : WGM;
        u.pm = fm + ((wgid % nig) % gsz); u.pn = (wgid % nig) / gsz; return true;
    }
};

template <class Epi>
DI void gemm_phase(LAS unsigned char* lds, const Gemm g, const StaticOrder& S_, const Epi& E) {
    const int tid = threadIdx.x, wid = __builtin_amdgcn_readfirstlane(tid >> 6), lane = tid & 63, wr = wid >> 2, wc = wid & 3, fr = lane & 15, fq = lane >> 4;
    const int K = g.K, nt = K / BK, ksplit = g.ksplit;
    unsigned voffA[2], voffB[2];
#pragma unroll
    for (int i = 0; i < 2; ++i) { int R, C; stage_rc(tid * 16 + i * 8192, R, C); const int Rb = Epi::PERM ? ((R & ~31) + perm32(R & 31)) : R;
        voffA[i] = (unsigned)(R * g.lda + C) * 2u; voffB[i] = (unsigned)(Rb * g.ldb + C) * 2u; }
    const size_t kstep = (size_t)(BK * 2);
    const size_t hstepA = (size_t)HALF * g.lda * 2, hstepB = (size_t)HALF * g.ldb * 2;
    const size_t tstepA = 2 * hstepA, tstepB = 2 * hstepB;
    const unsigned ldsw = (unsigned)wid * 1024u;
    const int aoff = lds_byte(wr * 64 + fr, fq * 8), boff = lds_byte(wc * 32 + fr, fq * 8);
#define PG8_SA(b, h) (((b) * 2 + (h)) * HTB)
#define PG8_SB(b, h) ((4 + (b) * 2 + (h)) * HTB)
#define PG8_STAGE(bufoff, gbase, voff) do { _Pragma("unroll") for (int _i = 0; _i < 2; ++_i) \
        __builtin_amdgcn_global_load_lds((const unsigned*)((const char*)(gbase) + (voff)[_i]), (LAS unsigned*)(lds + (bufoff) + ldsw + _i * 8192), 16, 0, 0); } while (0)
#define PG8_LDA(dst, b, h) do { _Pragma("unroll") for (int m = 0; m < 4; ++m) _Pragma("unroll") for (int k = 0; k < 2; ++k) dst[m][k] = *(const LAS bf16x8*)(lds + PG8_SA(b, h) + aoff + m * 2048 + k * 1024); } while (0)
#define PG8_LDB(dst, b, h) do { _Pragma("unroll") for (int n = 0; n < 2; ++n) _Pragma("unroll") for (int k = 0; k < 2; ++k) dst[n][k] = *(const LAS bf16x8*)(lds + PG8_SB(b, h) + boff + n * 2048 + k * 1024); } while (0)
#define PG8_MMA(ai, bj, At, Bt) do { __builtin_amdgcn_s_setprio(1); _Pragma("unroll") for (int m = 0; m < 4; ++m) _Pragma("unroll") for (int n = 0; n < 2; ++n) _Pragma("unroll") for (int k = 0; k < 2; ++k) \
        acc[ai][bj][m][n] = __builtin_amdgcn_mfma_f32_16x16x32_bf16(Bt[n][k], At[m][k], acc[ai][bj][m][n], 0, 0, 0); __builtin_amdgcn_s_setprio(0); } while (0)
#define PG8_WAIT_V(n) asm volatile("s_waitcnt vmcnt(" #n ")" ::: "memory")
#define PG8_WAIT_L(n) asm volatile("s_waitcnt lgkmcnt(" #n ")" ::: "memory")
#define PG8_BAR __builtin_amdgcn_s_barrier()
#define PG8_SCHED __builtin_amdgcn_sched_barrier(0)
    Unit cur, nxt; int ui = 0;
    if (!S_.next(0, cur)) return;
    f32x4 acc[2][2][4][2];
#pragma unroll
    for (int a = 0; a < 2; ++a)
#pragma unroll
        for (int b = 0; b < 2; ++b)
#pragma unroll
            for (int m = 0; m < 4; ++m)
#pragma unroll
                for (int n = 0; n < 2; ++n) acc[a][b][m][n] = (f32x4){0.f, 0.f, 0.f, 0.f};
    bf16x8 At[4][2], B0[2][2], B1[2][2];
    const char* cA0 = (const char*)g.A0 + (size_t)cur.pm * tstepA; const char* cA1 = (const char*)g.A1 + (size_t)cur.pm * tstepA;
    const char* cB0 = (const char*)g.B0 + (size_t)cur.pn * tstepB; const char* cB1 = (const char*)g.B1 + (size_t)cur.pn * tstepB;
    PG8_STAGE(PG8_SB(0, 0), cB0, voffB); PG8_STAGE(PG8_SA(0, 0), cA0, voffA); PG8_STAGE(PG8_SB(0, 1), cB0 + hstepB, voffB); PG8_STAGE(PG8_SA(0, 1), cA0 + hstepA, voffA);
    if (wr == 1) PG8_BAR;
    PG8_WAIT_V(4); PG8_BAR;
    PG8_STAGE(PG8_SB(1, 0), cB0 + kstep, voffB); PG8_STAGE(PG8_SA(1, 0), cA0 + kstep, voffA); PG8_STAGE(PG8_SB(1, 1), cB0 + hstepB + kstep, voffB);
    PG8_WAIT_V(6); PG8_BAR;
    for (;;) {
        const bool has_next = S_.next(ui + 1, nxt);
        const char* nA0 = has_next ? (const char*)g.A0 + (size_t)nxt.pm * tstepA : cA0; const char* nB0 = has_next ? (const char*)g.B0 + (size_t)nxt.pn * tstepB : cB0;
        for (int hf = 0; hf < (Epi::MID ? 2 : 1); ++hf) {
        const int tb = Epi::MID ? hf * ksplit : 0, te = Epi::MID ? (hf + 1) * ksplit : nt;
        for (int t = tb; t < te; t += 2) {
            const bool last = (t == nt - 2);
            const bool hA = (t >= ksplit), hB = (t + 2 >= ksplit);
            const char* a1 = (hA ? cA1 : cA0) + (size_t)(t + 1) * kstep;
            const char* a2 = last ? nA0 : (hB ? cA1 : cA0) + (size_t)(t + 2) * kstep; const char* b2 = last ? nB0 : (hB ? cB1 : cB0) + (size_t)(t + 2) * kstep;
            const char* a3 = a2 + kstep; const char* b3 = b2 + kstep;
            PG8_LDB(B0, 0, 0); PG8_SCHED; PG8_LDA(At, 0, 0); PG8_STAGE(PG8_SA(1, 1), a1 + hstepA, voffA);
            PG8_WAIT_L(8); PG8_BAR; PG8_WAIT_L(0); PG8_MMA(0, 0, At, B0); PG8_BAR; PG8_SCHED;
            PG8_LDB(B1, 0, 1); PG8_STAGE(PG8_SB(0, 0), b2, voffB);
            PG8_BAR; PG8_WAIT_L(0); PG8_MMA(0, 1, At, B1); PG8_BAR;
            PG8_LDA(At, 0, 1); PG8_STAGE(PG8_SA(0, 0), a2, voffA);
            PG8_BAR; PG8_WAIT_L(0); PG8_MMA(1, 0, At, B0); PG8_BAR; PG8_SCHED;
            PG8_STAGE(PG8_SB(0, 1), b2 + hstepB, voffB);
            PG8_WAIT_V(6); PG8_BAR; PG8_MMA(1, 1, At, B1); PG8_BAR;
            PG8_LDB(B0, 1, 0); PG8_SCHED; PG8_LDA(At, 1, 0); PG8_STAGE(PG8_SA(0, 1), a2 + hstepA, voffA);
            PG8_WAIT_L(8); PG8_BAR; PG8_WAIT_L(0); PG8_MMA(0, 0, At, B0); PG8_BAR; PG8_SCHED;
            PG8_LDB(B1, 1, 1); PG8_STAGE(PG8_SB(1, 0), b3, voffB);
            PG8_BAR; PG8_WAIT_L(0); PG8_MMA(0, 1, At, B1); PG8_BAR;
            PG8_LDA(At, 1, 1); PG8_STAGE(PG8_SA(1, 0), a3, voffA);
            PG8_BAR; PG8_WAIT_L(0); PG8_MMA(1, 0, At, B0); PG8_BAR; PG8_SCHED;
            PG8_STAGE(PG8_SB(1, 1), b3 + hstepB, voffB);
            PG8_WAIT_V(6); PG8_BAR; PG8_MMA(1, 1, At, B1); PG8_BAR;
        }
        if constexpr (Epi::MID) { if (hf == 0) E.mid(acc, cur, wr, wc, fr, fq); }
        }
        E(acc, cur, wr, wc, fr, fq);
        if (!has_next) break;
#pragma unroll
        for (int a = 0; a < 2; ++a)
#pragma unroll
            for (int b = 0; b < 2; ++b)
#pragma unroll
                for (int m = 0; m < 4; ++m)
#pragma unroll
                    for (int n = 0; n < 2; ++n) acc[a][b][m][n] = (f32x4){0.f, 0.f, 0.f, 0.f};
        cur = nxt; ++ui;
        cA0 = (const char*)g.A0 + (size_t)cur.pm * tstepA; cA1 = (const char*)g.A1 + (size_t)cur.pm * tstepA;
        cB0 = (const char*)g.B0 + (size_t)cur.pn * tstepB; cB1 = (const char*)g.B1 + (size_t)cur.pn * tstepB;
    }
    PG8_WAIT_V(0);
    if (wr == 0) PG8_BAR;
    PG8_BAR;
#undef PG8_SA
#undef PG8_SB
#undef PG8_STAGE
#undef PG8_LDA
#undef PG8_LDB
#undef PG8_MMA
#undef PG8_WAIT_V
#undef PG8_WAIT_L
#undef PG8_BAR
#undef PG8_SCHED
}
}

struct EpiZ {
    static constexpr bool PERM = true, MID = false;
    unsigned char* ws;
    DI void operator()(const f32x4 (&acc)[2][2][4][2], const pg8::Unit& u, int wr, int wc, int fr, int fq) const {
        const int pn = u.pn; bf16_t* base; int ld, colt;
        if (pn < 8) { base = (bf16_t*)(ws + WS_ZU) + (size_t)pn * S * 256; ld = 256; colt = 0; }
        else if (pn < 16) { base = (bf16_t*)(ws + WS_ZG); ld = 2048; colt = (pn - 8) * 256; }
        else if (pn < 28) { base = (bf16_t*)(ws + WS_ZQKV); ld = 3072; colt = (pn - 16) * 256; }
        else if (pn < 36) { base = (bf16_t*)(ws + WS_ZGA); ld = 2048; colt = (pn - 28) * 256; }
        else { base = (bf16_t*)(ws + WS_ZM) + (size_t)(pn - 36) * S * 256; ld = 256; colt = 0; }
        const bool rope = (pn >= 16 && pn < 26 && wc == 0);
        const int row0 = u.pm * 256 + wr * 64 + fr, col0 = colt + wc * 32 + 8 * fq;
        if (rope) {
            const float* cosT = (const float*)(ws + WS_ROPE) + (size_t)row0 * 16 + 4 * fq; const float* sinT = cosT + (size_t)S * 16;
            f32x4 cs[8], sn[8];
#pragma unroll
            for (int k = 0; k < 8; ++k) { cs[k] = *(const f32x4*)(cosT + ((k >> 2) * 128 + (k & 3) * 16) * 16); sn[k] = *(const f32x4*)(sinT + ((k >> 2) * 128 + (k & 3) * 16) * 16); }
#pragma unroll
            for (int ai = 0; ai < 2; ++ai)
#pragma unroll
                for (int m = 0; m < 4; ++m) {
                    const int row = row0 + ai * 128 + m * 16; const f32x4 c4 = cs[ai * 4 + m], s4 = sn[ai * 4 + m];
#pragma unroll
                    for (int bj = 0; bj < 2; ++bj) {
                        const f32x4 v0 = acc[ai][bj][m][0], v1 = acc[ai][bj][m][1]; f32x4 w0, w1;
                        w0[0] = v0[0] * c4[0] - v0[1] * s4[0]; w0[1] = v0[1] * c4[0] + v0[0] * s4[0];
                        w0[2] = v0[2] * c4[1] - v0[3] * s4[1]; w0[3] = v0[3] * c4[1] + v0[2] * s4[1];
                        w1[0] = v1[0] * c4[2] - v1[1] * s4[2]; w1[1] = v1[1] * c4[2] + v1[0] * s4[2];
                        w1[2] = v1[2] * c4[3] - v1[3] * s4[3]; w1[3] = v1[3] * c4[3] + v1[2] * s4[3];
                        u32x4 w = {cvtpk(w0[0], w0[1]), cvtpk(w0[2], w0[3]), cvtpk(w1[0], w1[1]), cvtpk(w1[2], w1[3])};
                        __builtin_nontemporal_store(w, (u32x4*)(base + (size_t)row * ld + col0 + bj * 128));
                    }
                }
        } else if (pn >= 36) {
            unsigned char* gb = ws + WS_ZM + (size_t)(pn - 36) * S * 256 + (size_t)row0 * 256 + wc * 32 + 8 * fq;
#pragma unroll
            for (int ai = 0; ai < 2; ++ai)
#pragma unroll
                for (int m = 0; m < 4; ++m)
#pragma unroll
                    for (int bj = 0; bj < 2; ++bj) {
                        const f32x4 v0 = acc[ai][bj][m][0], v1 = acc[ai][bj][m][1]; unsigned q[8];
#pragma unroll
                        for (int i = 0; i < 4; ++i) { q[i] = (unsigned)fmaxf(sigm(v0[i]) * 255.f + 0.5f, 1.f); q[4 + i] = (unsigned)fmaxf(sigm(v1[i]) * 255.f + 0.5f, 1.f); }
                        const u32x2 w = {q[0] | (q[1] << 8) | (q[2] << 16) | (q[3] << 24), q[4] | (q[5] << 8) | (q[6] << 16) | (q[7] << 24)};
                        __builtin_nontemporal_store(w, (u32x2*)(gb + (size_t)(ai * 128 + m * 16) * 256 + bj * 128));
                    }
        } else {
#pragma unroll
            for (int ai = 0; ai < 2; ++ai)
#pragma unroll
                for (int m = 0; m < 4; ++m) {
                    const int row = row0 + ai * 128 + m * 16;
#pragma unroll
                    for (int bj = 0; bj < 2; ++bj) {
                        const f32x4 v0 = acc[ai][bj][m][0], v1 = acc[ai][bj][m][1];
                        u32x4 w = {cvtpk(v0[0], v0[1]), cvtpk(v0[2], v0[3]), cvtpk(v1[0], v1[1]), cvtpk(v1[2], v1[3])};
                        __builtin_nontemporal_store(w, (u32x4*)(base + (size_t)row * ld + col0 + bj * 128));
                    }
                }
        }
    }
};
DI u32x4 ldg128(const void* base, unsigned boff) { return *(const u32x4*)((const char*)base + boff); }
DI void stg128(void* base, unsigned boff, u32x4 v) { *(u32x4*)((char*)base + boff) = v; }
template <int STEP> struct EpiMerge {
    static constexpr bool PERM = true, MID = false;
    unsigned char* ws; unsigned char* tbuf;
    DI void operator()(const f32x4 (&acc)[2][2][4][2], const pg8::Unit& u, int wr, int wc, int fr, int fq) const {
        const unsigned char* zm = ws + WS_ZM; unsigned char* mg = ws + WS_MRG;
        const unsigned r0_ = (unsigned)(u.pm * 256 + wr * 64 + fr), c0_ = (unsigned)(u.pn * 256 + wc * 32 + 8 * fq);
#pragma unroll
        for (int ai = 0; ai < 2; ++ai)
#pragma unroll
            for (int m = 0; m < 4; ++m) {
                const unsigned row = r0_ + ai * 128 + m * 16;
#pragma unroll
                for (int bj = 0; bj < 2; ++bj) {
                    const unsigned col = c0_ + bj * 128;
                    const u32x4 g = ldg128(zm, row * 8192u + (STEP ? 4096u : 0u) + col * 2u);
                    float v[8];
#pragma unroll
                    for (int i = 0; i < 4; ++i) {
                        v[2 * i] = acc[ai][bj][m][i >> 1][(i & 1) * 2] * sigm(bflo(g[i]));
                        v[2 * i + 1] = acc[ai][bj][m][i >> 1][(i & 1) * 2 + 1] * sigm(bfhi(g[i]));
                    }
                    const unsigned tb = row * 8192u + col * 4u;
                    if (STEP == 0) {
                        stg128(tbuf, tb, __builtin_bit_cast(u32x4, (f32x4){v[0], v[1], v[2], v[3]}));
                        stg128(tbuf, tb + 16u, __builtin_bit_cast(u32x4, (f32x4){v[4], v[5], v[6], v[7]}));
                    } else {
                        const f32x4 t0 = __builtin_bit_cast(f32x4, ldg128(tbuf, tb)), t1 = __builtin_bit_cast(f32x4, ldg128(tbuf, tb + 16u));
                        u32x4 w = {cvtpk(v[0] + t0[0], v[1] + t0[1]), cvtpk(v[2] + t0[2], v[3] + t0[3]), cvtpk(v[4] + t1[0], v[5] + t1[1]), cvtpk(v[6] + t1[2], v[7] + t1[3])};
                        stg128(mg, row * 4096u + col * 2u, w);
                    }
                }
                asm volatile("" ::: "memory");
            }
    }
};

DI float ub(unsigned w, int i) { return (float)((w >> (8 * i)) & 0xffu); }
struct EpiMergeMid {
    static constexpr bool PERM = true, MID = true;
    unsigned char* ws;
    DI void mid(f32x4 (&acc)[2][2][4][2], const pg8::Unit& u, int wr, int wc, int fr, int fq) const {
        const unsigned char* zm = ws + WS_ZM;
        unsigned b0_ = (unsigned)u.pn * (unsigned)(S * 256) + (unsigned)(u.pm * 256 + wr * 64 + fr) * 256u + (unsigned)(wc * 32 + 8 * fq);
        asm volatile("" : "+v"(b0_));
        u32x2 g1[2][4][2], g2[2][4][2];
#pragma unroll
        for (int ai = 0; ai < 2; ++ai)
#pragma unroll
            for (int m = 0; m < 4; ++m)
#pragma unroll
                for (int bj = 0; bj < 2; ++bj) { const unsigned bo = b0_ + (unsigned)(ai * 128 + m * 16) * 256u + bj * 128u;
                    g1[ai][m][bj] = *(const u32x2*)(zm + bo); g2[ai][m][bj] = *(const u32x2*)(zm + bo + (unsigned)(8 * S * 256)); }
#pragma unroll
        for (int ai = 0; ai < 2; ++ai)
#pragma unroll
            for (int m = 0; m < 4; ++m)
#pragma unroll
                for (int bj = 0; bj < 2; ++bj)
#pragma unroll
                    for (int e = 0; e < 8; ++e)
                        acc[ai][bj][m][e >> 2][e & 3] *= ub(g1[ai][m][bj][e >> 2], e & 3) * rcpf_(ub(g2[ai][m][bj][e >> 2], e & 3));
    }
    DI void operator()(const f32x4 (&acc)[2][2][4][2], const pg8::Unit& u, int wr, int wc, int fr, int fq) const {
        const unsigned char* zm = ws + WS_ZM; unsigned char* mg = ws + WS_MRG;
        unsigned r0_ = (unsigned)(u.pm * 256 + wr * 64 + fr), c0_ = (unsigned)(wc * 32 + 8 * fq);
        asm volatile("" : "+v"(r0_), "+v"(c0_));
        u32x2 g2[2][4][2];
#pragma unroll
        for (int ai = 0; ai < 2; ++ai)
#pragma unroll
            for (int m = 0; m < 4; ++m)
#pragma unroll
                for (int bj = 0; bj < 2; ++bj) g2[ai][m][bj] = *(const u32x2*)(zm + (unsigned)(8 + u.pn) * (unsigned)(S * 256) + (r0_ + ai * 128 + m * 16) * 256u + c0_ + bj * 128u);
#pragma unroll
        for (int ai = 0; ai < 2; ++ai)
#pragma unroll
            for (int m = 0; m < 4; ++m) {
                const unsigned row = r0_ + ai * 128 + m * 16;
#pragma unroll
                for (int bj = 0; bj < 2; ++bj) {
                    float v[8];
#pragma unroll
                    for (int e = 0; e < 8; ++e) v[e] = acc[ai][bj][m][e >> 2][e & 3] * (ub(g2[ai][m][bj][e >> 2], e & 3) * (1.f / 255.f));
                    u32x4 w = {cvtpk(v[0], v[1]), cvtpk(v[2], v[3]), cvtpk(v[4], v[5]), cvtpk(v[6], v[7])};
                    stg128(mg, row * 4096u + ((unsigned)u.pn * 256u + c0_) * 2u + bj * 256u, w);
                }
            }
    }
};
struct EpiOut {
    static constexpr bool PERM = true, MID = false;
    unsigned char* ws;
    DI void operator()(const f32x4 (&acc)[2][2][4][2], const pg8::Unit& u, int wr, int wc, int fr, int fq) const {
        unsigned char* o2 = ws + WS_OUT2; float* ssq = (float*)(ws + WS_SSQ);
        const unsigned r0_ = (unsigned)(u.pm * 256 + wr * 64 + fr), c0_ = (unsigned)(u.pn * 256 + wc * 32 + 8 * fq) * 2u;
#pragma unroll
        for (int ai = 0; ai < 2; ++ai)
#pragma unroll
            for (int m = 0; m < 4; ++m) {
                const unsigned row = r0_ + ai * 128 + m * 16; float s = 0.f;
#pragma unroll
                for (int bj = 0; bj < 2; ++bj) {
                    const f32x4 v0 = acc[ai][bj][m][0], v1 = acc[ai][bj][m][1];
                    s += v0[0] * v0[0] + v0[1] * v0[1] + v0[2] * v0[2] + v0[3] * v0[3] + v1[0] * v1[0] + v1[1] * v1[1] + v1[2] * v1[2] + v1[3] * v1[3];
                    u32x4 w = {cvtpk(v0[0], v0[1]), cvtpk(v0[2], v0[3]), cvtpk(v1[0], v1[1]), cvtpk(v1[2], v1[3])};
                    stg128(o2, row * 4096u + c0_ + bj * 256u, w);
                }
                s += __shfl_xor(s, 16); s += __shfl_xor(s, 32);
                if (fq == 0) ssq[(size_t)row * 32 + u.pn * 4 + wc] = s;
            }
    }
};

struct TJob { const float* src; bf16_t* dst; int ld_src, ld_dst, k0, n0, perm, pad_; };
DI void tr_load(const TJob& j, f32x4& v0, f32x4& v1) {
    const int t = threadIdx.x, kl = t >> 4, nl = (t & 15) * 4;
    v0 = *(const f32x4*)(j.src + (size_t)(j.k0 + kl) * j.ld_src + j.n0 + nl);
    v1 = *(const f32x4*)(j.src + (size_t)(j.k0 + kl + 32) * j.ld_src + j.n0 + nl);
}
DI void tr_store(const TJob& j, const f32x4 v0, const f32x4 v1, float* sT) {
    const int t = threadIdx.x;
    { const int kl = t >> 4, nl = (t & 15) * 4;
      sT[kl * 65 + nl] = v0[0]; sT[kl * 65 + nl + 1] = v0[1]; sT[kl * 65 + nl + 2] = v0[2]; sT[kl * 65 + nl + 3] = v0[3];
      sT[(kl + 32) * 65 + nl] = v1[0]; sT[(kl + 32) * 65 + nl + 1] = v1[1]; sT[(kl + 32) * 65 + nl + 2] = v1[2]; sT[(kl + 32) * 65 + nl + 3] = v1[3]; }
    __syncthreads();
    { const int nl = t >> 3, kc = (t & 7) * 8; int ns = nl;
      if (j.perm && nl < 32) ns = (nl & 1) ? 16 + (nl >> 1) : (nl >> 1);
      float q[8];
#pragma unroll
      for (int i = 0; i < 8; ++i) q[i] = sT[(kc + i) * 65 + ns];
      u32x4 w = {cvtpk(q[0], q[1]), cvtpk(q[2], q[3]), cvtpk(q[4], q[5]), cvtpk(q[6], q[7])};
      *(u32x4*)(j.dst + (size_t)(j.n0 + nl) * j.ld_dst + j.k0 + kc) = w; }
    __syncthreads();
}
DI TJob win_job(const Params& p, int j) {
    TJob r; const int nt = j >> 5, kt = j & 31, n0 = nt * 64;
    r.src = p.in[2]; r.dst = (bf16_t*)((unsigned char*)p.out + DO_WINT); r.ld_src = NIN; r.ld_dst = DM; r.k0 = kt * 64; r.n0 = n0;
    r.perm = (n0 >= 4096 && n0 < 6656 && (n0 & 127) == 0) ? 1 : 0; r.pad_ = 0; return r;
}
DI TJob small_job(const Params& p, int j) {
    TJob r; constexpr int J_SQ = 32 * 32;
    if (j < 3 * J_SQ) { const int which = j >> 10, q = j & 1023, nt = q >> 5, kt = q & 31;
        r.src = p.in[11 + which]; r.dst = (bf16_t*)(p.ws + (which == 0 ? WS_WAT : which == 1 ? WS_WBT : WS_WOT)); r.ld_src = DM; r.ld_dst = DM; r.k0 = kt * 64; r.n0 = nt * 64; }
    else { const int jj = j - 3 * J_SQ, gate = jj >> 7, q = jj & 127, blk = q >> 2, sub = q & 3, d = blk >> 4, nb = blk & 15;
        r.src = p.in[gate == 0 ? 5 : 7] + (size_t)blk * 16384; r.dst = (bf16_t*)(p.ws + WS_LWT) + (size_t)((d * 2 + gate) * 16 + nb) * 16384;
        r.ld_src = 128; r.ld_dst = 128; r.k0 = (sub >> 1) * 64; r.n0 = (sub & 1) * 64; }
    r.perm = 0; r.pad_ = 0; return r;
}
DI void phase_prep(const Params& p, unsigned char* shm) {
    const int tid = threadIdx.x, wid = tid >> 6, lane = tid & 63;
    bf16_t* xn = (bf16_t*)((unsigned char*)p.out + DO_XN);
    {
        const float* x = p.in[0]; const float* nw = p.in[1];
        f32x4 w[8];
#pragma unroll
        for (int i = 0; i < 8; ++i) w[i] = *(const f32x4*)(nw + i * 256 + lane * 4);
        for (int row = (blockIdx.x * 8 + wid) * 2; row < S; row += gridDim.x * 16) {
            f32x4 v[2][8];
#pragma unroll
            for (int r = 0; r < 2; ++r)
#pragma unroll
                for (int i = 0; i < 8; ++i) v[r][i] = __builtin_nontemporal_load((const f32x4*)(x + (size_t)(row + r) * DM + i * 256 + lane * 4));
#pragma unroll
            for (int r = 0; r < 2; ++r) {
                float ss = 0.f;
#pragma unroll
                for (int i = 0; i < 8; ++i) ss += v[r][i][0] * v[r][i][0] + v[r][i][1] * v[r][i][1] + v[r][i][2] * v[r][i][2] + v[r][i][3] * v[r][i][3];
                ss = wave_sum(ss);
                const float rs = rsqrtf(ss * (1.f / DM) + EPS);
#pragma unroll
                for (int i = 0; i < 8; ++i) {
                    u32x2 o = {cvtpk(v[r][i][0] * rs * w[i][0], v[r][i][1] * rs * w[i][1]), cvtpk(v[r][i][2] * rs * w[i][2], v[r][i][3] * rs * w[i][3])};
                    *(u32x2*)(xn + (size_t)(row + r) * DM + i * 256 + lane * 4) = o; }
            }
        }
    }
    {
        float* cosT = (float*)(p.ws + WS_ROPE); float* sinT = cosT + (size_t)S * 16;
        for (int i = blockIdx.x * 512 + tid; i < S * 16; i += gridDim.x * 512) {
            const int pos = i >> 4, j = i & 15;
            const float ang = (float)pos * p.inv_freq[j];
            const double rev = (double)ang * 0.15915494309189535; const float fr = (float)(rev - rint(rev));
            cosT[i] = __builtin_amdgcn_cosf(fr); sinT[i] = __builtin_amdgcn_sinf(fr);
        }
    }
    {
        float* sT = (float*)shm; constexpr int NG = 208 * 8;
        const float* src = p.in[2]; bf16_t* dst = (bf16_t*)((unsigned char*)p.out + DO_WINT);
        const int t = threadIdx.x, kl = t >> 4, nl4 = (t & 15) * 4, onl = t >> 3, okc = (t & 7) * 8;
        int g = blockIdx.x;
        if (g < NG) {
            f32x4 v[8];
#pragma unroll
            for (int q = 0; q < 8; ++q) v[q] = __builtin_nontemporal_load((const f32x4*)(src + (size_t)((g & 7) * 256 + q * 32 + kl) * NIN + (g >> 3) * 64 + nl4));
            for (;;) {
                const int gn = g + (int)gridDim.x; const bool more = gn < NG; const int gl = more ? gn : g;
                f32x4 vn[8];
#pragma unroll
                for (int q = 0; q < 8; ++q) vn[q] = __builtin_nontemporal_load((const f32x4*)(src + (size_t)((gl & 7) * 256 + q * 32 + kl) * NIN + (gl >> 3) * 64 + nl4));
#pragma unroll
                for (int q = 0; q < 8; ++q) { float* d = sT + (q * 32 + kl) * 65 + nl4; d[0] = v[q][0]; d[1] = v[q][1]; d[2] = v[q][2]; d[3] = v[q][3]; }
                __syncthreads();
                { const int n0 = (g >> 3) * 64, k0 = (g & 7) * 256; int ns = onl;
                  if (n0 >= 4096 && n0 < 6656 && (n0 & 127) == 0 && onl < 32) ns = (onl & 1) ? 16 + (onl >> 1) : (onl >> 1);
#pragma unroll
                  for (int q = 0; q < 4; ++q) { float f[8];
#pragma unroll
                      for (int i = 0; i < 8; ++i) f[i] = sT[(q * 64 + okc + i) * 65 + ns];
                      *(u32x4*)(dst + (size_t)(n0 + onl) * DM + k0 + q * 64 + okc) = (u32x4){cvtpk(f[0], f[1]), cvtpk(f[2], f[3]), cvtpk(f[4], f[5]), cvtpk(f[6], f[7])}; } }
                __syncthreads();
                if (!more) break;
#pragma unroll
                for (int q = 0; q < 8; ++q) v[q] = vn[q];
                g = gn;
            }
        }
    }
}
DI void prep_small_weights(const Params& p, unsigned char* shm, int idx, int stride) {
    float* sT = (float*)shm; constexpr int NJ = 3 * 1024 + 256;
    int j = idx;
    if (j < NJ) {
        TJob cur = small_job(p, j); f32x4 v0, v1; tr_load(cur, v0, v1);
        for (;;) {
            const int jn = j + stride; const bool more = jn < NJ;
            const TJob nxt = small_job(p, more ? jn : j); f32x4 n0, n1; tr_load(nxt, n0, n1);
            tr_store(cur, v0, v1, sT);
            if (!more) break;
            cur = nxt; v0 = n0; v1 = n1; j = jn;
        }
    }
}

DI void lru_copy_out(const bf16_t* OS, bf16_t* dst_tile, int t) {
    const int row = t >> 2, seg = (t & 3) * 32;
#pragma unroll
    for (int k = 0; k < 4; ++k) { const u32x4 v = *(const u32x4*)(OS + row * 136 + seg + k * 8); *(u32x4*)(dst_tile + (size_t)row * 2048 + seg + k * 8) = v; }
}
struct LruPar { float nbr[2], nbi[2], cdec[2]; };
DI LruPar lru_params(const Params& p, int nb) {
    const int chg = nb * 128 + (int)(threadIdx.x >> 6) * 16 + (int)(threadIdx.x & 15); LruPar r;
#pragma unroll
    for (int d = 0; d < 2; ++d) { const float br = p.in[6][d * 2048 + chg], bi = p.in[8][d * 2048 + chg], lam = p.in[9][d * 2048 + chg];
        r.nbr[d] = -br * LOG2E; r.nbi[d] = -bi * LOG2E; r.cdec[d] = -8.f * log1pf(expf(-lam)) * LOG2E; }
    return r;
}
DI void lru_tile(const Params& p, unsigned char* shm, int c, int nb, const LruPar par) {
    int tid = threadIdx.x; asm volatile("" : "+v"(tid));
    const int wid = __builtin_amdgcn_readfirstlane(tid >> 6), lane = tid & 63;
    constexpr int LDU = 136;
    bf16_t* UB = (bf16_t*)shm;
    bf16_t* PS = (bf16_t*)(shm + 34816);
    bf16_t* OS = (bf16_t*)(shm + 2 * 34816);
    f32x2* AG = (f32x2*)(shm + 3 * 34816) + wid * 512;
    const bf16_t* ZU = (const bf16_t*)(p.ws + WS_ZU);
    {
        const int cgp = tid & 15, rg = tid >> 4, ch = nb * 128 + cgp * 8;
        const float* cw = p.in[3]; const float* cb = p.in[4];
        float w[4][8], bias[8];
#pragma unroll
        for (int tp = 0; tp < 4; ++tp) { const f32x4 a = *(const f32x4*)(cw + tp * 2048 + ch), b = *(const f32x4*)(cw + tp * 2048 + ch + 4);
            w[tp][0] = a[0]; w[tp][1] = a[1]; w[tp][2] = a[2]; w[tp][3] = a[3]; w[tp][4] = b[0]; w[tp][5] = b[1]; w[tp][6] = b[2]; w[tp][7] = b[3]; }
        { const f32x4 a = *(const f32x4*)(cb + ch), b = *(const f32x4*)(cb + ch + 4);
            bias[0] = a[0]; bias[1] = a[1]; bias[2] = a[2]; bias[3] = a[3]; bias[4] = b[0]; bias[5] = b[1]; bias[6] = b[2]; bias[7] = b[3]; }
        float xr[7][8];
#pragma unroll
        for (int k = 0; k < 7; ++k) { const int t = c * 128 + rg * 4 - 2 + k;
            u32x4 v = {0u, 0u, 0u, 0u};
            if (t >= 0 && t < S) v = *(const u32x4*)(ZU + (size_t)(nb >> 1) * S * 256 + (size_t)t * 256 + (nb & 1) * 128 + cgp * 8);
#pragma unroll
            for (int i = 0; i < 4; ++i) { xr[k][2 * i] = bflo(v[i]); xr[k][2 * i + 1] = bfhi(v[i]); } }
#pragma unroll
        for (int o = 0; o < 4; ++o) { float u8[8];
#pragma unroll
            for (int i = 0; i < 8; ++i) { float a = bias[i];
#pragma unroll
                for (int tp = 0; tp < 4; ++tp) a += xr[o + tp][i] * w[tp][i];
                u8[i] = a; }
            *(u32x4*)(UB + (rg * 4 + o) * LDU + cgp * 8) = (u32x4){cvtpk(u8[0], u8[1]), cvtpk(u8[2], u8[3]), cvtpk(u8[4], u8[5]), cvtpk(u8[6], u8[7])};
        }
    }
    __syncthreads();
    const int col = lane & 15, q = lane >> 4;
    const int chl = wid * 16 + col, chg = nb * 128 + chl;
    float hsum[8][4]; unsigned ppk[8][2];
    f32x2* AGG = (f32x2*)(p.ws + WS_AGG);
    const bf16_t* LWT = (const bf16_t*)(p.ws + WS_LWT);
#pragma unroll
    for (int d = 0; d < 2; ++d) {
        f32x4 acc[2][8];
#pragma unroll
        for (int a = 0; a < 2; ++a)
#pragma unroll
            for (int b = 0; b < 8; ++b) acc[a][b] = (f32x4){0.f, 0.f, 0.f, 0.f};
        bf16x8 bfr[4][2];
#pragma unroll
        for (int s = 0; s < 4; ++s)
#pragma unroll
            for (int gt = 0; gt < 2; ++gt) bfr[s][gt] = *(const bf16x8*)(LWT + ((size_t)((d * 2 + gt) * 16 + nb) * 128 + chl) * 128 + s * 32 + q * 8);
#pragma unroll
        for (int s = 0; s < 4; ++s) {
#pragma unroll
            for (int rt = 0; rt < 8; ++rt) {
                const bf16x8 af = *(const bf16x8*)(UB + (rt * 16 + col) * LDU + s * 32 + q * 8);
#pragma unroll
                for (int gt = 0; gt < 2; ++gt) acc[gt][rt] = __builtin_amdgcn_mfma_f32_16x16x32_bf16(af, bfr[s][gt], acc[gt][rt], 0, 0, 0);
            }
            __builtin_amdgcn_sched_barrier(0);
        }
        const f32x2 nl2 = {-LOG2E, -LOG2E}, nbr2 = {par.nbr[d], par.nbr[d]}, nbi2 = {par.nbi[d], par.nbi[d]}, cd2 = {par.cdec[d], par.cdec[d]}, one2 = {1.f, 1.f};
        float hl[8][4], pc[8][4];
#pragma unroll
        for (int rt = 0; rt < 8; ++rt) {
            float av[4], bv[4];
#pragma unroll
            for (int jp = 0; jp < 2; ++jp) {
                const f32x2 xr = {acc[0][rt][2 * jp], acc[0][rt][2 * jp + 1]}, xi = {acc[1][rt][2 * jp], acc[1][rt][2 * jp + 1]};
                f32x2 er = xr * nl2 + nbr2, ei = xi * nl2 + nbi2;
                er = (f32x2){ex2(er[0]), ex2(er[1])} + one2; ei = (f32x2){ex2(ei[0]), ex2(ei[1])} + one2;
                const f32x2 r = {rcpf_(er[0]), rcpf_(er[1])}, ig = {rcpf_(ei[0]), rcpf_(ei[1])};
                const f32x2 la = r * cd2;
                const f32x2 a = {ex2(la[0]), ex2(la[1])};
                const f32x2 om = one2 - a * a;
                const f32x2 sc = {__builtin_amdgcn_sqrtf(om[0]), __builtin_amdgcn_sqrtf(om[1])};
                const f32x2 u2 = {bf2f(UB[(rt * 16 + 4 * q + 2 * jp) * LDU + chl]), bf2f(UB[(rt * 16 + 4 * q + 2 * jp + 1) * LDU + chl])};
                const f32x2 b2 = sc * ig * u2;
                av[2 * jp] = a[0]; av[2 * jp + 1] = a[1]; bv[2 * jp] = b2[0]; bv[2 * jp + 1] = b2[1];
            }
            float h = 0.f, P = 1.f;
            if (d == 0) {
#pragma unroll
                for (int j = 0; j < 4; ++j) { h = fmaf(av[j], h, bv[j]); P *= av[j]; hl[rt][j] = h; pc[rt][j] = P; }
            } else {
#pragma unroll
                for (int j = 3; j >= 0; --j) { h = fmaf(av[j], h, bv[j]); P *= av[j]; hl[rt][j] = h; pc[rt][j] = P; }
            }
            AG[(rt * 4 + q) * 16 + col] = (f32x2){P, h};
            __builtin_amdgcn_sched_barrier(0);
        }
        asm volatile("s_waitcnt lgkmcnt(0)" ::: "memory");
        float carry[8], pref[8]; float cin = 0.f, pa = 1.f;
#pragma unroll
        for (int gi = 0; gi < 32; ++gi) {
            const int G = d == 0 ? gi : 31 - gi; const int rt = G >> 2, qq = G & 3;
            const f32x2 ah = AG[G * 16 + col];
            if (qq == q) { carry[rt] = cin; pref[rt] = pa; }
            cin = fmaf(ah[0], cin, ah[1]); pa *= ah[0];
        }
        if (q == 0) AGG[((size_t)d * 128 + c) * 2048 + chg] = (f32x2){pa, cin};
#pragma unroll
        for (int rt = 0; rt < 8; ++rt) {
            const f32x2 cr2 = {carry[rt], carry[rt]}, pf2 = {pref[rt] * 255.f, pref[rt] * 255.f}, half2 = {0.5f, 0.5f};
#pragma unroll
            for (int jp = 0; jp < 2; ++jp) {
                const f32x2 pc2 = {pc[rt][2 * jp], pc[rt][2 * jp + 1]}, hl2 = {hl[rt][2 * jp], hl[rt][2 * jp + 1]};
                const f32x2 hf = pc2 * cr2 + hl2, pq = pc2 * pf2 + half2;
                const unsigned q0 = (unsigned)pq[0], q1 = (unsigned)pq[1];
                if (d == 0) { hsum[rt][2 * jp] = hf[0]; hsum[rt][2 * jp + 1] = hf[1]; ppk[rt][jp] = q0 | (q1 << 16); }
                else {
                    const int lo = (rt * 16 + 4 * q + 2 * jp) * LDU + chl;
                    const unsigned w = cvtpk(hsum[rt][2 * jp] + hf[0], hsum[rt][2 * jp + 1] + hf[1]);
                    OS[lo] = (unsigned short)(w & 0xffffu); OS[lo + LDU] = (unsigned short)(w >> 16);
                    const unsigned pw = ppk[rt][jp] | (q0 << 8) | (q1 << 24);
                    PS[lo] = (unsigned short)(pw & 0xffffu); PS[lo + LDU] = (unsigned short)(pw >> 16);
                }
            }
            __builtin_amdgcn_sched_barrier(0);
        }
    }
    __syncthreads();
    lru_copy_out(OS, (bf16_t*)((unsigned char*)p.out + DO_ACF) + (size_t)c * 128 * 2048 + nb * 128, tid);
    lru_copy_out(PS, (bf16_t*)((unsigned char*)p.out + DO_ACB) + (size_t)c * 128 * 2048 + nb * 128, tid);
}

namespace att {
constexpr float SCALE = 0.088388347648318440f, THR = 8.f;
constexpr int SHM_V = 64 * 128 * 2, SHM_K = SHM_V, LDK = 3072;
#define KSWZ(row, colB) ((row) * 256 + ((colB) ^ (((row) & 7) << 4)))
#define SBAR() __builtin_amdgcn_sched_barrier(0)
DI int crow(int r, int hi) { return (r & 3) + 8 * (r >> 2) + 4 * hi; }
DI void maskT(f32x16& p0, f32x16& p1, int kt, int qw, int r32, int hi) {
    if ((kt - qw - 31 < -128) || (kt + 63 - qw > 128)) {
        const int db = kt - (qw + r32) + 4 * hi;
#pragma unroll
        for (int r = 0; r < 16; ++r) { const int d = db + (r & 3) + 8 * (r >> 2);
            p0[r] = (d >= -128 && d <= 128) ? p0[r] : -1e30f; p1[r] = (d + 32 >= -128 && d + 32 <= 128) ? p1[r] : -1e30f; }
    }
}
DI void partialSM(f32x16& p0, f32x16& p1, float& m_reg, float& mn, float& alpha) {
    constexpr float C = SCALE * 1.4426950408889634f;
    float pmax = p0[0];
#pragma unroll
    for (int r = 1; r < 16; ++r) pmax = fmaxf(pmax, p0[r]);
#pragma unroll
    for (int r = 0; r < 16; ++r) pmax = fmaxf(pmax, p1[r]);
    { auto rr = __builtin_amdgcn_permlane32_swap(__float_as_uint(pmax), __float_as_uint(pmax), false, false);
      pmax = fmaxf(__uint_as_float(rr[0]), __uint_as_float(rr[1])); }
    if (__builtin_expect(__all(pmax - m_reg <= THR / SCALE), 1)) { mn = m_reg; alpha = 1.f; }
    else { mn = fmaxf(m_reg, pmax); alpha = __builtin_amdgcn_exp2f((m_reg - mn) * C); m_reg = mn; }
    const float mnC = -mn * C;
#pragma unroll
    for (int r = 0; r < 16; ++r) p0[r] = fmaf(p0[r], C, mnC);
#pragma unroll
    for (int r = 0; r < 16; ++r) p1[r] = fmaf(p1[r], C, mnC);
#pragma unroll
    for (int r = 0; r < 16; ++r) p0[r] = __builtin_amdgcn_exp2f(p0[r]);
}
DI void finishSM(f32x16& p0, f32x16& p1, float alpha, float& l_reg, bf16x8& pa0, bf16x8& pa1, bf16x8& pa2, bf16x8& pa3) {
#pragma unroll
    for (int r = 0; r < 16; ++r) p1[r] = __builtin_amdgcn_exp2f(p1[r]);
    float ps = 0;
#pragma unroll
    for (int r = 0; r < 16; ++r) ps += p0[r];
#pragma unroll
    for (int r = 0; r < 16; ++r) ps += p1[r];
    { auto rr = __builtin_amdgcn_permlane32_swap(__float_as_uint(ps), __float_as_uint(ps), false, false);
      ps = __uint_as_float(rr[0]) + __uint_as_float(rr[1]); }
    l_reg = l_reg * alpha + ps;
#define PK4(P, BASE, OUT) do { unsigned a0 = cvtpk(P[BASE + 0], P[BASE + 1]), a1 = cvtpk(P[BASE + 2], P[BASE + 3]);   \
    unsigned b0 = cvtpk(P[BASE + 4], P[BASE + 5]), b1 = cvtpk(P[BASE + 6], P[BASE + 7]);                              \
    auto r0 = __builtin_amdgcn_permlane32_swap(a0, b0, false, false); auto r1 = __builtin_amdgcn_permlane32_swap(a1, b1, false, false); \
    u32x4 w = {r0[0], r1[0], r0[1], r1[1]}; OUT = __builtin_bit_cast(bf16x8, w); } while (0)
    PK4(p0, 0, pa0); PK4(p0, 8, pa1); PK4(p1, 0, pa2); PK4(p1, 8, pa3);
#undef PK4
}
DI void qkt(f32x16& p0, f32x16& p1, const char* Ks, const bf16x8* qr, int r32, int hi) {
#pragma unroll
    for (int i = 0; i < 16; ++i) { p0[i] = 0.f; p1[i] = 0.f; }
#pragma unroll
    for (int d0 = 0; d0 < 8; ++d0) { const int cb = (d0 * 16 + hi * 8) * 2;
        const bf16x8 b0 = *reinterpret_cast<const bf16x8*>(Ks + KSWZ(r32, cb));
        const bf16x8 b1 = *reinterpret_cast<const bf16x8*>(Ks + KSWZ(32 + r32, cb));
        p0 = __builtin_amdgcn_mfma_f32_32x32x16_bf16(b0, qr[d0], p0, 0, 0, 0);
        p1 = __builtin_amdgcn_mfma_f32_32x32x16_bf16(b1, qr[d0], p1, 0, 0, 0); }
}
DI int v_st(int k, int c) { const int kk = (k & ~0xC) | ((k & 4) << 1) | ((k & 8) >> 1); return ((kk >> 3) * 4 + (c >> 5)) * 512 + ((kk & 7) * 32 + (c & 31)) * 2; }
DI int v_rd_base(int lane) { return ((lane & 3) << 3) | (((lane >> 2) & 3) << 6) | (((lane >> 4) & 1) << 5) | (((lane >> 5) & 1) << 8); }
constexpr int v_rd_off(int d0, int ks, int half) { return d0 * 512 + ks * 4096 + half * 2048; }
template <int OFF> DI s16x4 tr_read(int vb) {
    s16x4 r; asm volatile("ds_read_b64_tr_b16 %0, %1 offset:%2" : "=&v"(r) : "v"(vb), "i"(OFF) : "memory"); return r;
}
template <int D0> DI void pv_one(f32x16& od, int vb, bf16x8 pa0, bf16x8 pa1, bf16x8 pa2, bf16x8 pa3) {
    const s16x4 l0 = tr_read<v_rd_off(D0, 0, 0)>(vb), h0 = tr_read<v_rd_off(D0, 0, 1)>(vb), l1 = tr_read<v_rd_off(D0, 1, 0)>(vb), h1 = tr_read<v_rd_off(D0, 1, 1)>(vb);
    const s16x4 l2 = tr_read<v_rd_off(D0, 2, 0)>(vb), h2 = tr_read<v_rd_off(D0, 2, 1)>(vb), l3 = tr_read<v_rd_off(D0, 3, 0)>(vb), h3 = tr_read<v_rd_off(D0, 3, 1)>(vb);
    asm volatile("s_waitcnt lgkmcnt(0)" ::: "memory"); SBAR();
#define PK(L, H) (bf16x8){L[0], L[1], L[2], L[3], H[0], H[1], H[2], H[3]}
    od = __builtin_amdgcn_mfma_f32_32x32x16_bf16(pa0, PK(l0, h0), od, 0, 0, 0);
    od = __builtin_amdgcn_mfma_f32_32x32x16_bf16(pa1, PK(l1, h1), od, 0, 0, 0);
    od = __builtin_amdgcn_mfma_f32_32x32x16_bf16(pa2, PK(l2, h2), od, 0, 0, 0);
    od = __builtin_amdgcn_mfma_f32_32x32x16_bf16(pa3, PK(l3, h3), od, 0, 0, 0);
#undef PK
}
DI void pv_d0(f32x16* o, int vb, bf16x8 pa0, bf16x8 pa1, bf16x8 pa2, bf16x8 pa3) {
    pv_one<0>(o[0], vb, pa0, pa1, pa2, pa3); pv_one<1>(o[1], vb, pa0, pa1, pa2, pa3); pv_one<2>(o[2], vb, pa0, pa1, pa2, pa3); pv_one<3>(o[3], vb, pa0, pa1, pa2, pa3);
}
DI void attn_item(const bf16_t* __restrict__ Qw_, const bf16_t* __restrict__ Kh, const bf16_t* __restrict__ Vh, const bf16_t* Gw, bf16_t* Ow,
                  int NT, int kt0, int qw, float sinkv, char* lds) {
    const int tid = threadIdx.x, wid = __builtin_amdgcn_readfirstlane(tid >> 6), lane = tid & 63, r32 = lane & 31, hi = lane >> 5;
    char* V_lds = lds; char* K_lds = lds + 2 * SHM_V;
    float* wsp = (float*)(lds + 2 * SHM_V + 2 * SHM_K) + wid * 64; float* li_l = wsp; float* al_l = wsp + 32;
    float m_reg = sinkv * (1.f / SCALE), l_reg = 1.f; f32x16 o[4]; bf16x8 qr[8];
#pragma unroll
    for (int d = 0; d < 4; ++d)
#pragma unroll
        for (int r = 0; r < 16; ++r) o[d][r] = 0.f;
    const bf16_t* Qw = Qw_ + (size_t)r32 * LDK + hi * 8;
#pragma unroll
    for (int d0 = 0; d0 < 8; ++d0) qr[d0] = *(const bf16x8*)(Qw + d0 * 16);
    const int sr = tid >> 4, sc = (tid & 15) * 8, vst0 = v_st(sr, sc), vst1 = v_st(32 + sr, sc);
    const int vb0 = (int)(uintptr_t)V_lds + v_rd_base(lane);
    struct { bf16x8 vs0, vs1, ks0, ks1; } sr_[2];
#define SLOAD(i, k0) do { sr_[i].vs0 = *(const bf16x8*)(&Vh[(size_t)((k0) + sr) * LDK + sc]); sr_[i].vs1 = *(const bf16x8*)(&Vh[(size_t)((k0) + 32 + sr) * LDK + sc]); \
    sr_[i].ks0 = *(const bf16x8*)(&Kh[(size_t)((k0) + sr) * LDK + sc]); sr_[i].ks1 = *(const bf16x8*)(&Kh[(size_t)((k0) + 32 + sr) * LDK + sc]); } while (0)
#define SWRITE(b, i) do { *(bf16x8*)(V_lds + (b) * SHM_V + vst0) = sr_[i].vs0;          \
    *(bf16x8*)(V_lds + (b) * SHM_V + vst1) = sr_[i].vs1; const int kc = sc * 2;               \
    *(bf16x8*)(K_lds + (b) * SHM_K + KSWZ(sr, kc)) = sr_[i].ks0;                       \
    *(bf16x8*)(K_lds + (b) * SHM_K + KSWZ(32 + sr, kc)) = sr_[i].ks1; } while (0)
#define SWAIT() asm volatile("s_waitcnt vmcnt(4)" ::: "memory")
#define RESC(a) do { if (__any((a) < 1.f)) { if (hi == 0) al_l[r32] = (a); asm volatile("s_waitcnt lgkmcnt(0)" ::: "memory"); \
    _Pragma("unroll") for (int d = 0; d < 4; ++d) _Pragma("unroll") for (int r = 0; r < 16; ++r) o[d][r] *= al_l[crow(r, hi)]; } } while (0)
    f32x16 pA0, pA1, pB0, pB1; float mnA, mnB, alA, alB; bf16x8 pa0, pa1, pa2, pa3;
    constexpr int SE = 0, SO = 1;
    SLOAD(SE, 0); asm volatile("s_waitcnt vmcnt(0)" ::: "memory"); SWRITE(0, SE); __syncthreads();
    qkt(pA0, pA1, K_lds, qr, r32, hi); maskT(pA0, pA1, kt0, qw, r32, hi); partialSM(pA0, pA1, m_reg, mnA, alA);
    SLOAD(SO, 64); if (2 < NT) SLOAD(SE, 128);
    SWAIT(); SWRITE(1, SO); __syncthreads();
    for (int j = 1; j + 1 < NT; j += 2) {
        SBAR(); qkt(pB0, pB1, K_lds + SHM_K, qr, r32, hi);
        finishSM(pA0, pA1, alA, l_reg, pa0, pa1, pa2, pa3); SBAR();
        SLOAD(SO, (j + 2) * 64); SBAR();
        pv_d0(o, vb0, pa0, pa1, pa2, pa3); maskT(pB0, pB1, kt0 + 64 * j, qw, r32, hi); partialSM(pB0, pB1, m_reg, mnB, alB);
        __syncthreads(); SWAIT(); SWRITE(0, SE);
        RESC(alB); __syncthreads();
        SBAR(); qkt(pA0, pA1, K_lds, qr, r32, hi);
        finishSM(pB0, pB1, alB, l_reg, pa0, pa1, pa2, pa3); SBAR();
        if (j + 3 < NT) SLOAD(SE, (j + 3) * 64); SBAR();
        pv_d0(o, vb0 + SHM_V, pa0, pa1, pa2, pa3); maskT(pA0, pA1, kt0 + 64 * (j + 1), qw, r32, hi); partialSM(pA0, pA1, m_reg, mnA, alA);
        __syncthreads(); SWAIT(); SWRITE(1, SO);
        RESC(alA); __syncthreads();
    }
    SBAR(); qkt(pB0, pB1, K_lds + SHM_K, qr, r32, hi);
    finishSM(pA0, pA1, alA, l_reg, pa0, pa1, pa2, pa3); SBAR();
    pv_d0(o, vb0, pa0, pa1, pa2, pa3); maskT(pB0, pB1, kt0 + 64 * (NT - 1), qw, r32, hi); partialSM(pB0, pB1, m_reg, mnB, alB);
    __syncthreads(); RESC(alB);
    finishSM(pB0, pB1, alB, l_reg, pa0, pa1, pa2, pa3); SBAR();
    pv_d0(o, vb0 + SHM_V, pa0, pa1, pa2, pa3);
    int lane2 = threadIdx.x & 63; asm volatile("" : "+v"(lane2));
    const int ec = lane2 & 15, er = lane2 >> 4;
    if (hi == 0) li_l[r32] = l_reg; asm volatile("s_waitcnt lgkmcnt(0)" ::: "memory");
    bf16_t* OT = (bf16_t*)(lds + 67584 + wid * 8704);
#pragma unroll
    for (int r = 0; r < 16; ++r) { const int orow = crow(r, hi); const float rl = __builtin_amdgcn_rcpf(li_l[orow]);
#pragma unroll
        for (int d0 = 0; d0 < 4; ++d0) OT[orow * 136 + d0 * 32 + r32] = f2bf(o[d0][r] * rl); }
    __builtin_amdgcn_sched_barrier(0);
    u32x4 gv[8];
#pragma unroll
    for (int k = 0; k < 8; ++k) gv[k] = __builtin_nontemporal_load((const u32x4*)(Gw + (size_t)(er + 4 * k) * 2048 + ec * 8));
    asm volatile("s_waitcnt lgkmcnt(0)" ::: "memory");
#pragma unroll
    for (int k = 0; k < 8; ++k) {
        const u32x4 ov = *(const u32x4*)(OT + (er + 4 * k) * 136 + ec * 8); u32x4 w;
#pragma unroll
        for (int i = 0; i < 4; ++i) { const float g0 = bflo(gv[k][i]), g1 = bfhi(gv[k][i]); w[i] = cvtpk(bflo(ov[i]) * g0 * sigm(g0), bfhi(ov[i]) * g1 * sigm(g1)); }
        __builtin_nontemporal_store(w, (u32x4*)(Ow + (size_t)(er + 4 * k) * 2048 + ec * 8));
    }
#undef SLOAD
#undef SWRITE
#undef SWAIT
#undef RESC
}
}

DI void phase_lru(const Params& p, unsigned char* shm) {
    int nbp = -1; LruPar par;
    for (int it = blockIdx.x; it < 2048; it += gridDim.x) { const int nb = it & 15; if (nb != nbp) { par = lru_params(p, nb); nbp = nb; } lru_tile(p, shm, it >> 4, nb, par); }
    __syncthreads();
}
DI void phase_att(const Params& p, unsigned char* shm) {
    const int wid = __builtin_amdgcn_readfirstlane(threadIdx.x >> 6);
    const bf16_t* Z = (const bf16_t*)(p.ws + WS_ZQKV); const bf16_t* GA = (const bf16_t*)(p.ws + WS_ZGA); bf16_t* YB = (bf16_t*)(p.ws + WS_YB);
    for (int it = blockIdx.x; it < 1024; it += gridDim.x) {
        const int hp = it & 1, g = (it >> 1) & 3, n = it >> 3;
        const int head = g * 4 + hp * 2 + (wid >> 2), qw = 32 * (wid & 3);
        const int kfirst = n == 0 ? 0 : (n - 1) * 128, NT = (n == 0 || n == 127) ? 4 : 6, kt0 = kfirst - n * 128;
        __syncthreads();
        const size_t go = (size_t)(n * 128 + qw) * 2048 + head * 128;
        att::attn_item(Z + (size_t)(n * 128 + qw) * 3072 + head * 128, Z + (size_t)kfirst * 3072 + 2048 + g * 128, Z + (size_t)kfirst * 3072 + 2560 + g * 128,
                       GA + go, YB + go, NT, kt0, qw, p.in[10][head], (char*)shm);
    }
    __syncthreads();
}
DI void phase_mixers(const Params& p, unsigned char* shm) { if (p.mix_mask & 1) phase_lru(p, shm); if (p.mix_mask & 2) phase_att(p, shm); }

DI void phase_carry(const Params& p) {
    const int tid = threadIdx.x;
    if (tid >= 64) return;
    const f32x2* AGG = (const f32x2*)(p.ws + WS_AGG); float* CAR = (float*)(p.ws + WS_CAR);
    for (int w = blockIdx.x; w < 64; w += gridDim.x) {
        const int id = w * 64 + tid, d = id >> 11, ch = id & 2047;
        const f32x2* ag = AGG + (size_t)d * 128 * 2048 + ch; float* car = CAR + (size_t)d * 128 * 2048 + ch;
        float cin = 0.f;
        for (int b = 0; b < 4; ++b) {
            f32x2 v[32];
#pragma unroll
            for (int u = 0; u < 32; ++u) { const int k = b * 32 + u, cc = d == 0 ? k : 127 - k; v[u] = ag[(size_t)cc * 2048]; }
#pragma unroll
            for (int u = 0; u < 32; ++u) { const int k = b * 32 + u, cc = d == 0 ? k : 127 - k; car[(size_t)cc * 2048] = cin; cin = fmaf(v[u][0], cin, v[u][1]); }
        }
    }
}
DI void phase_fixup(const Params& p) {
    const int tid = threadIdx.x, ch = (tid & 255) * 8, r2 = tid >> 8;
    const float* CAR = (const float*)(p.ws + WS_CAR);
    bf16_t* ZG = (bf16_t*)(p.ws + WS_ZG);
    const bf16_t* HLp = (const bf16_t*)((unsigned char*)p.out + DO_ACF); const bf16_t* PPp = (const bf16_t*)((unsigned char*)p.out + DO_ACB);
    for (int it = blockIdx.x; it < 512; it += gridDim.x) {
        const int c = it >> 2, rq = it & 3;
        float cf[8], cb[8];
        { const f32x4 a0 = *(const f32x4*)(CAR + (size_t)c * 2048 + ch), a1 = *(const f32x4*)(CAR + (size_t)c * 2048 + ch + 4);
          const f32x4 b0 = *(const f32x4*)(CAR + (size_t)(128 + c) * 2048 + ch), b1 = *(const f32x4*)(CAR + (size_t)(128 + c) * 2048 + ch + 4);
#pragma unroll
          for (int i = 0; i < 4; ++i) { cf[i] = a0[i] * (1.f / 255.f); cf[4 + i] = a1[i] * (1.f / 255.f); cb[i] = b0[i] * (1.f / 255.f); cb[4 + i] = b1[i] * (1.f / 255.f); } }
#pragma unroll 8
        for (int i = 0; i < 16; ++i) {
            const size_t off = (size_t)(c * 128 + rq * 32 + 2 * i + r2) * 2048 + ch;
            const u32x4 g = __builtin_nontemporal_load((const u32x4*)(ZG + off)), h = __builtin_nontemporal_load((const u32x4*)(HLp + off)), pp = __builtin_nontemporal_load((const u32x4*)(PPp + off));
            u32x4 o;
#pragma unroll
            for (int k = 0; k < 4; ++k) {
                const float g0 = bflo(g[k]), g1 = bfhi(g[k]);
                const float y0 = (bflo(h[k]) + ub(pp[k], 0) * cf[2 * k] + ub(pp[k], 1) * cb[2 * k]) * g0 * sigm(g0);
                const float y1 = (bfhi(h[k]) + ub(pp[k], 2) * cf[2 * k + 1] + ub(pp[k], 3) * cb[2 * k + 1]) * g1 * sigm(g1);
                o[k] = cvtpk(y0, y1);
            }
            *(u32x4*)(ZG + off) = o;
        }
    }
}

DI void phase_final(const Params& p) {
    const int tid = threadIdx.x, wid = tid >> 6, lane = tid & 63;
    const float* x = p.in[0]; const float* nw = p.in[14]; const bf16_t* o2 = (const bf16_t*)(p.ws + WS_OUT2); const float* ssq = (const float*)(p.ws + WS_SSQ);
    f32x4 w[8];
#pragma unroll
    for (int i = 0; i < 8; ++i) w[i] = *(const f32x4*)(nw + i * 256 + lane * 4);
    for (int row = (blockIdx.x * 8 + wid) * 2; row < S; row += gridDim.x * 16) {
        f32x4 xv[2][8]; u32x2 yv[2][8]; float sq[2];
#pragma unroll
        for (int r = 0; r < 2; ++r) {
            sq[r] = lane < 32 ? ssq[(size_t)(row + r) * 32 + lane] : 0.f;
#pragma unroll
            for (int i = 0; i < 8; ++i) { const size_t off = (size_t)(row + r) * DM + i * 256 + lane * 4; xv[r][i] = __builtin_nontemporal_load((const f32x4*)(x + off)); yv[r][i] = __builtin_nontemporal_load((const u32x2*)(o2 + off)); }
        }
#pragma unroll
        for (int r = 0; r < 2; ++r) {
            const float rs = rsqrtf(wave_sum(sq[r]) * (1.f / DM) + EPS);
#pragma unroll
            for (int i = 0; i < 8; ++i) { const size_t off = (size_t)(row + r) * DM + i * 256 + lane * 4;
                const f32x4 ov = {xv[r][i][0] + bflo(yv[r][i][0]) * rs * w[i][0], xv[r][i][1] + bfhi(yv[r][i][0]) * rs * w[i][1],
                                  xv[r][i][2] + bflo(yv[r][i][1]) * rs * w[i][2], xv[r][i][3] + bfhi(yv[r][i][1]) * rs * w[i][3]};
                __builtin_nontemporal_store(ov, (f32x4*)(p.out + off)); }
        }
    }
}

#define XB_TMO      128
#define XB_XCNT(j)  (256  + 64 * (j))
#define XB_XSUB(j)  (1280 + 64 * (j))
#define XB_XGEN(j)  (2304 + 64 * (j))
#define XB_TOP      3328
#define XB_TOPGEN   3392
#define XCD_BAR_WORDS 3456
#define XB_SPIN_CAP (1u << 18)

__device__ __forceinline__ unsigned xb_ld(unsigned* p)              { return __hip_atomic_load(p, __ATOMIC_RELAXED, __HIP_MEMORY_SCOPE_AGENT); }
__device__ __forceinline__ unsigned xb_add(unsigned* p, unsigned v) { return __hip_atomic_fetch_add(p, v, __ATOMIC_RELAXED, __HIP_MEMORY_SCOPE_AGENT); }
__device__ __forceinline__ unsigned xb_xcc_id() { return (unsigned)__builtin_amdgcn_s_getreg((3 << 11) | 20) & 0xFu; }
#define XB_SPIN(cond, bar) do { unsigned _sp = 0; while (cond) { __builtin_amdgcn_s_sleep(1); \
    if ((++_sp & 255u) == 0u) { if (xb_ld(&(bar)[XB_TMO])) break; if (_sp > XB_SPIN_CAP) { atomicAdd(&(bar)[XB_TMO], 1u); break; } } } } while (0)

struct XcdBarrier {
    unsigned* bar; unsigned x;
    volatile LAS unsigned* st;
};

__device__ __forceinline__ XcdBarrier xcd_barrier_post(unsigned* bar, volatile LAS unsigned* st) {
    XcdBarrier b; b.bar = bar; b.x = xb_xcc_id(); b.st = st;
    if (threadIdx.x == 0) (void)xb_add(&bar[XB_XCNT(b.x)], 1u);
    return b;
}
__device__ __forceinline__ void xcd_barrier_complete(unsigned* bar, unsigned x, unsigned& nloc, unsigned& nx) {
    const unsigned G = gridDim.x * gridDim.y * gridDim.z;
    unsigned sum, cnt, mine, sp = 0u;
    for (;;) {
        sum = 0u; cnt = 0u; mine = 0u;
#pragma unroll
        for (unsigned j = 0; j < 16; ++j) { const unsigned c = xb_ld(&bar[XB_XCNT(j)]); sum += c; cnt += (c > 0u) ? 1u : 0u; mine = (j == x) ? c : mine; }
        if (sum == G) break;
        __builtin_amdgcn_s_sleep(1);
        if ((++sp & 255u) == 0u) { if (xb_ld(&bar[XB_TMO])) break; if (sp > XB_SPIN_CAP) { atomicAdd(&bar[XB_TMO], 1u); break; } }
    }
    nloc = mine > 0u ? mine : 1u; nx = cnt > 0u ? cnt : 1u;
}

__device__ __forceinline__ void xcd_barrier(const XcdBarrier& b) {
    asm volatile("s_waitcnt vmcnt(0)" ::: "memory");
    __syncthreads();
    if (threadIdx.x == 0) {
        unsigned* bar = b.bar;
        __builtin_amdgcn_s_waitcnt(0);
        unsigned nloc = b.st[0], nx = b.st[1];
        if (nloc == 0u) { xcd_barrier_complete(bar, b.x, nloc, nx); b.st[0] = nloc; b.st[1] = nx; }
        const unsigned old = xb_add(&bar[XB_XSUB(b.x)], 1u);
        const unsigned gen = old / nloc;
        if (old + 1u == (gen + 1u) * nloc) {
            __builtin_amdgcn_fence(__ATOMIC_RELEASE, "agent");
            asm volatile("s_waitcnt vmcnt(0)" ::: "memory");
            const unsigned og = xb_add(&bar[XB_TOP], 1u);
            const unsigned tg = og / nx;
            if (og + 1u == (tg + 1u) * nx) xb_add(&bar[XB_TOPGEN], 1u);
            else XB_SPIN(xb_ld(&bar[XB_TOPGEN]) == tg, bar);
            __builtin_amdgcn_fence(__ATOMIC_ACQUIRE, "agent");
            xb_add(&bar[XB_XGEN(b.x)], 1u);
            asm volatile("s_waitcnt vmcnt(0)" ::: "memory");
        } else {
            XB_SPIN(xb_ld(&bar[XB_XGEN(b.x)]) == gen, bar);
            __builtin_amdgcn_fence(__ATOMIC_ACQUIRE, "agent");
            asm volatile("s_waitcnt vmcnt(0)" ::: "memory");
        }
    }
    __syncthreads();
}

__global__ void __launch_bounds__(512, 2) mega(Params p) {
    extern __shared__ __attribute__((aligned(16))) unsigned char shm[];
    cg::grid_group grid = cg::this_grid();
    volatile LAS unsigned* bst = (volatile LAS unsigned*)((LAS unsigned char*)shm + LDS_BAR_ST);
    if (threadIdx.x < 4) bst[threadIdx.x] = 0u;
    __syncthreads();
    XcdBarrier xbar; xbar.bar = (unsigned*)(p.ws + WS_BAR); xbar.x = 0; xbar.st = bst;
    if (p.ph_hi - p.ph_lo > 1) xbar = xcd_barrier_post((unsigned*)(p.ws + WS_BAR), bst);
    if (p.ph_lo > 64) grid.sync();
#ifndef PHMASK
#define PHMASK 0xff
#endif
#define PH(i) (((PHMASK >> (i)) & 1) && p.ph_lo <= (i) && (i) < p.ph_hi)
#define SEAM(i) do { if (p.ph_lo <= (i) && (i) + 1 < p.ph_hi) xcd_barrier(xbar); } while (0)
    if (PH(0)) phase_prep(p, shm);
    SEAM(0);
    if (PH(1)) {
        pg8::Gemm g; g.A0 = (const bf16_t*)((unsigned char*)p.out + DO_XN); g.A1 = g.A0; g.B0 = (const bf16_t*)((unsigned char*)p.out + DO_WINT); g.B1 = g.B0;
        g.lda = DM; g.ldb = DM; g.M = S; g.N = NIN; g.K = DM; g.ksplit = DM / 64;
        pg8::StaticOrder so; so.init(g.M, g.N, (int)gridDim.x, (int)blockIdx.x);
        EpiZ e; e.ws = p.ws;
        if (gridDim.x >= 16 && (gridDim.x & 15) == 0) { if ((blockIdx.x >> 3) & 1) prep_small_weights(p, shm, (int)((blockIdx.x >> 4) * 8 + (blockIdx.x & 7)), (int)(gridDim.x / 2)); }
        else prep_small_weights(p, shm, (int)blockIdx.x, (int)gridDim.x);
        pg8::gemm_phase<EpiZ>((LAS unsigned char*)shm, g, so, e);
    }
    SEAM(1);
#if PROBE_SPLIT
    if (PH(2)) phase_lru(p, shm);
    if (p.ph_lo == 8) phase_att(p, shm);
#else
    if (PH(2)) phase_mixers(p, shm);
#endif
    SEAM(2);
    if (PH(3)) phase_carry(p);
    SEAM(3);
    if (PH(4)) phase_fixup(p);
    SEAM(4);
    if (PH(5)) {
        pg8::Gemm g; g.A0 = (const bf16_t*)(p.ws + WS_ZG); g.A1 = (const bf16_t*)(p.ws + WS_YB) - 2048; g.B0 = (const bf16_t*)(p.ws + WS_WAT); g.B1 = (const bf16_t*)(p.ws + WS_WBT) - 2048;
        g.lda = DM; g.ldb = DM; g.M = S; g.N = DM; g.K = 2 * DM; g.ksplit = DM / 64;
        pg8::StaticOrder so; so.init(g.M, g.N, (int)gridDim.x, (int)blockIdx.x);
        EpiMergeMid e; e.ws = p.ws;
        pg8::gemm_phase<EpiMergeMid>((LAS unsigned char*)shm, g, so, e);
    }
    SEAM(5);
    if (PH(6)) {
        pg8::Gemm g; g.A0 = (const bf16_t*)(p.ws + WS_MRG); g.A1 = g.A0; g.B0 = (const bf16_t*)(p.ws + WS_WOT); g.B1 = g.B0;
        g.lda = DM; g.ldb = DM; g.M = S; g.N = DM; g.K = DM; g.ksplit = DM / 64;
        pg8::StaticOrder so; so.init(g.M, g.N, (int)gridDim.x, (int)blockIdx.x);
        EpiOut e; e.ws = p.ws;
        pg8::gemm_phase<EpiOut>((LAS unsigned char*)shm, g, so, e);
    }
    SEAM(6);
    if (PH(7)) phase_final(p);
}

extern "C" void kernel_launch(void* const* d_in, const int* in_sizes, int n_in, void* d_out, int out_size, void* d_ws, size_t ws_size, hipStream_t stream) {
    static int grid = 0;
    if (grid == 0) {
        if (n_in != 15 || in_sizes[0] != S * DM || out_size != S * DM || ws_size < WS_END) {
            fprintf(stderr, "kernel_launch: unexpected shapes (n_in %d, in0 %d, out %d, ws %zu; need ws >= %zu)\n", n_in, n_in > 0 ? in_sizes[0] : -1, out_size, ws_size, (size_t)WS_END); grid = -1; return; }
        int dev = 0, cus = 0, per_cu = 0;
        (void)hipGetDevice(&dev); (void)hipDeviceGetAttribute(&cus, hipDeviceAttributeMultiprocessorCount, dev);
        if (hipFuncSetAttribute((const void*)mega, hipFuncAttributeMaxDynamicSharedMemorySize, LDS_BYTES) != hipSuccess) { fprintf(stderr, "kernel_launch: hipFuncSetAttribute failed\n"); grid = -1; return; }
        if (hipOccupancyMaxActiveBlocksPerMultiprocessor(&per_cu, (const void*)mega, 512, LDS_BYTES) != hipSuccess || per_cu < 1) { fprintf(stderr, "kernel_launch: occupancy query gave %d\n", per_cu); per_cu = 1; }
        (void)hipGetLastError();
        grid = cus * per_cu;
    }
    if (grid < 0) return;
    Params p{};
    for (int i = 0; i < 15; ++i) p.in[i] = (const float*)d_in[i];
    p.out = (float*)d_out; p.ws = (unsigned char*)d_ws;
    for (int j = 0; j < 16; ++j) p.inv_freq[j] = (float)pow(500000.0, -(double)j / 16.0);
    p.mix_mask = 3;
#if MK_SINGLE
    p.ph_lo = 0; p.ph_hi = 8;
    if (hipMemsetAsync((unsigned char*)d_ws + WS_BAR, 0, XCD_BAR_WORDS * sizeof(unsigned), stream) != hipSuccess) { fprintf(stderr, "kernel_launch: memset of barrier words failed\n"); return; }
    void* args[] = {&p};
    hipError_t e = hipLaunchCooperativeKernel((const void*)mega, dim3(grid), dim3(512), args, LDS_BYTES, stream);
    if (e != hipSuccess) fprintf(stderr, "kernel_launch: cooperative launch failed: %s (grid %d)\n", hipGetErrorString(e), grid);
#else
#ifndef REPMASK
#define REPMASK 0
#endif
#ifndef HALFMASK
#define HALFMASK 0
#endif
    static const int lph[9] = {0, 1, 2, 2, 3, 4, 5, 6, 7}; static const int lmix[9] = {3, 3, 1, 2, 3, 3, 3, 3, 3};
    for (int li = 0; li < 9; ++li) {
        p.ph_lo = lph[li]; p.ph_hi = lph[li] + 1; p.mix_mask = lmix[li];
#ifndef REPMASK
#define REPMASK 0
#endif
        for (int rep = 0; rep < (((REPMASK >> li) & 1) ? 2 : 1); ++rep)
        hipLaunchKernelGGL(mega, dim3(((HALFMASK >> li) & 1) ? grid / 2 : grid), dim3(512), LDS_BYTES, stream, p);
    }
#endif
}
```
